# Optimizing an MI355X kernel written in HIP

```python
import jax, jax.numpy as jnp
from jax import lax
import numpy as np

D_MODEL = 1024
BATCH = 2
SEQ = 16384
DEPTH = 2

CTX_LEN = 256
GRID_W = 64
MIX_WIDTH = D_MODEL
RET_HEADS = 4
RET_WIDTH = MIX_WIDTH // 4
RET_DV = RET_WIDTH // RET_HEADS
RET_DK = RET_DV // 2
GLA_HEADS = 4
GLA_WIDTH = MIX_WIDTH // 4
GLA_DV = GLA_WIDTH // GLA_HEADS
GLA_DK = GLA_DV // 2
GLA_RANK = 16
GLA_TAU = 16.0
GQA_WIDTH = MIX_WIDTH - RET_WIDTH - GLA_WIDTH
GQA_HEAD_DIM = 64
GQA_HEADS = GQA_WIDTH // GQA_HEAD_DIM
GQA_KV_HEADS = 2
GQA_GROUP = GQA_HEADS // GQA_KV_HEADS
D_FF = 4 * D_MODEL
SCAN_CHUNK = 64
Q_BLOCK = 128
ROPE_BASE = 10000.0
NORM_EPS = 1e-6
IN_SPLIT_SIZES = (RET_HEADS * RET_DK, RET_HEADS * RET_DK, RET_WIDTH, RET_WIDTH,
                  GLA_HEADS * GLA_DK, GLA_HEADS * GLA_DK, GLA_WIDTH, GLA_WIDTH, 2 * GLA_RANK,
                  GQA_WIDTH, GQA_KV_HEADS * GQA_HEAD_DIM, GQA_KV_HEADS * GQA_HEAD_DIM)
IN_WIDTH = sum(IN_SPLIT_SIZES)

kernel_name = 'hybrid_ret_gla_gqa_prefix_dit_block'


def rms_norm(x, g):
    xf = x.astype(jnp.float32)
    y = xf * lax.rsqrt(jnp.mean(xf * xf, axis=-1, keepdims=True) + NORM_EPS)
    return (y * g.astype(jnp.float32)).astype(x.dtype)


def head_rms(x):
    xf = x.astype(jnp.float32)
    return (xf * lax.rsqrt(jnp.mean(xf * xf, axis=-1, keepdims=True) + NORM_EPS)).astype(x.dtype)


def head_layernorm(x):
    xf = x.astype(jnp.float32)
    mu = jnp.mean(xf, axis=-1, keepdims=True)
    xc = xf - mu
    return (xc * lax.rsqrt(jnp.mean(xc * xc, axis=-1, keepdims=True) + NORM_EPS)).astype(x.dtype)


def modulate(h, shift, scale):
    return h * (1.0 + scale) + shift


def split_heads(a, n_heads):
    return a.reshape(a.shape[:-1] + (n_heads, a.shape[-1] // n_heads))


def _rotate(x, ang):
    x1, x2 = jnp.split(x, 2, axis=-1)
    cos = jnp.cos(ang)[:, None, :]
    sin = jnp.sin(ang)[:, None, :]
    return jnp.concatenate([x1 * cos - x2 * sin, x1 * sin + x2 * cos], axis=-1)


def axial_rope(x, row, col):
    d = x.shape[-1]
    n_freq = d // 4
    inv_freq = ROPE_BASE ** (-jnp.arange(n_freq, dtype=jnp.float32) / n_freq)
    xf = x.astype(jnp.float32)
    x_row, x_col = jnp.split(xf, 2, axis=-1)
    out = jnp.concatenate([_rotate(x_row, row[:, None] * inv_freq),
                           _rotate(x_col, col[:, None] * inv_freq)], axis=-1)
    return out.astype(x.dtype)


def chunk_scan(q, k, v, g, s0, inclusive):
    bsz, length, heads, _ = q.shape
    dv = v.shape[-1]
    n_chunks = length // SCAN_CHUNK

    def to_chunks(a):
        a = a.astype(jnp.float32).reshape(bsz, n_chunks, SCAN_CHUNK, heads, a.shape[-1])
        return a.transpose(1, 0, 3, 2, 4)

    mask = jnp.tril(jnp.ones((SCAN_CHUNK, SCAN_CHUNK), dtype=bool), 0 if inclusive else -1)

    def step(state, inp):
        qc, kc, vc, gc = inp
        b = jnp.cumsum(gc, axis=-2)
        b_last = b[..., -1:, :]
        q_dec = qc * jnp.exp(b)
        scores = jnp.einsum('bhid,bhjd->bhij', q_dec, kc * jnp.exp(-b))
        scores = jnp.where(mask, scores, 0.0)
        out = (jnp.einsum('bhij,bhje->bhie', scores, vc)
               + jnp.einsum('bhid,bhde->bhie', q_dec, state))
        state = (jnp.exp(b_last)[..., 0, :, None] * state
                 + jnp.einsum('bhjd,bhje->bhde', kc * jnp.exp(b_last - b), vc))
        return state, out

    s_final, o = lax.scan(step, s0.astype(jnp.float32),
                          (to_chunks(q), to_chunks(k), to_chunks(v), to_chunks(g)))
    o = o.transpose(1, 0, 3, 2, 4).reshape(bsz, length, heads, dv)
    return o.astype(v.dtype), s_final


def bidir_prefix_scan(q_l, k_l, v_l, gf_l, gb_l, q_c, k_c, v_c, gf_c, gb_c):
    bsz, _, heads, dk = q_l.shape
    dv = v_l.shape[-1]
    zero = jnp.zeros((bsz, heads, dk, dv), jnp.float32)
    rev = lambda a: a[:, ::-1]
    oc_f, sc_f = chunk_scan(q_c, k_c, v_c, gf_c, zero, True)
    ol_f, _ = chunk_scan(q_l, k_l, v_l, gf_l, sc_f, True)
    oc_b, sc_b = chunk_scan(rev(q_c), rev(k_c), rev(v_c), rev(gb_c), zero, False)
    ol_b, _ = chunk_scan(rev(q_l), rev(k_l), rev(v_l), rev(gb_l), sc_b, False)
    return ol_f + rev(ol_b), oc_f + rev(oc_b)


def _attend(q, keys, vals):
    s = jnp.einsum('bkgqd,bksd->bkgqs', q, keys).astype(jnp.float32) * (GQA_HEAD_DIM ** -0.5)
    p = jax.nn.softmax(s, axis=-1).astype(vals.dtype)
    return jnp.einsum('bkgqs,bksd->bkgqd', p, vals)


def gqa_latent(q, k_lat, v_lat, k_ctx, v_ctx):
    bsz, length = q.shape[:2]
    keys = jnp.concatenate([k_ctx, k_lat], axis=1).transpose(0, 2, 1, 3)
    vals = jnp.concatenate([v_ctx, v_lat], axis=1).transpose(0, 2, 1, 3)
    n_blocks = length // Q_BLOCK
    qb = q.reshape(bsz, n_blocks, Q_BLOCK, GQA_KV_HEADS, GQA_GROUP, GQA_HEAD_DIM).transpose(1, 0, 3, 4, 2, 5)
    o = lax.map(lambda qblk: _attend(qblk, keys, vals), qb)
    return o.transpose(1, 0, 4, 2, 3, 5).reshape(bsz, length, GQA_WIDTH)


def gqa_context(q, k, v):
    bsz, n = q.shape[:2]
    qg = q.reshape(bsz, n, GQA_KV_HEADS, GQA_GROUP, GQA_HEAD_DIM).transpose(0, 2, 3, 1, 4)
    o = _attend(qg, k.transpose(0, 2, 1, 3), v.transpose(0, 2, 1, 3))
    return o.transpose(0, 3, 1, 2, 4).reshape(bsz, n, GQA_WIDTH)


def token_mix(h_lat, h_ctx, w_in, w_out, ret_decay_logit, gla_gate_w, gla_gate_b, qk_norm_g, row, col, need_ctx):
    cuts = [int(v) for v in np.cumsum(IN_SPLIT_SIZES)[:-1]]
    pl = jnp.split(h_lat @ w_in, cuts, axis=-1)
    pc = jnp.split(h_ctx @ w_in, cuts, axis=-1)
    bsz, n_lat = h_lat.shape[:2]
    n_ctx = h_ctx.shape[1]

    k_scale = RET_DK ** -0.5
    rq_l = axial_rope(split_heads(pl[0], RET_HEADS), row, col)
    rk_l = axial_rope(split_heads(pl[1], RET_HEADS), row, col) * k_scale
    rv_l = split_heads(pl[2], RET_HEADS)
    rq_c = split_heads(pc[0], RET_HEADS)
    rk_c = split_heads(pc[1], RET_HEADS) * k_scale
    rv_c = split_heads(pc[2], RET_HEADS)
    log_gamma = jax.nn.log_sigmoid(ret_decay_logit.astype(jnp.float32))
    gf_l = jnp.broadcast_to(log_gamma[0][:, None], rq_l.shape)
    gb_l = jnp.broadcast_to(log_gamma[1][:, None], rq_l.shape)
    gf_c = jnp.broadcast_to(log_gamma[0][:, None], rq_c.shape)
    gb_c = jnp.broadcast_to(log_gamma[1][:, None], rq_c.shape)
    ro_l, ro_c = bidir_prefix_scan(rq_l, rk_l, rv_l, gf_l, gb_l, rq_c, rk_c, rv_c, gf_c, gb_c)
    y_ret_l = jax.nn.silu(pl[3]) * head_layernorm(ro_l).reshape(bsz, n_lat, RET_WIDTH)

    def gla_gates(a):
        z_f = a[..., :GLA_RANK] @ gla_gate_w[0] + gla_gate_b[0]
        z_b = a[..., GLA_RANK:] @ gla_gate_w[1] + gla_gate_b[1]
        g_f = jax.nn.log_sigmoid(z_f.astype(jnp.float32)) / GLA_TAU
        g_b = jax.nn.log_sigmoid(z_b.astype(jnp.float32)) / GLA_TAU
        return split_heads(g_f, GLA_HEADS), split_heads(g_b, GLA_HEADS)

    q_scale = GLA_DK ** -0.5
    gq_l = split_heads(pl[4], GLA_HEADS) * q_scale
    gk_l = split_heads(pl[5], GLA_HEADS)
    gv_l = split_heads(pl[6], GLA_HEADS)
    gq_c = split_heads(pc[4], GLA_HEADS) * q_scale
    gk_c = split_heads(pc[5], GLA_HEADS)
    gv_c = split_heads(pc[6], GLA_HEADS)
    ggf_l, ggb_l = gla_gates(pl[8])
    ggf_c, ggb_c = gla_gates(pc[8])
    go_l, go_c = bidir_prefix_scan(gq_l, gk_l, gv_l, ggf_l, ggb_l, gq_c, gk_c, gv_c, ggf_c, ggb_c)
    y_gla_l = jax.nn.silu(pl[7]) * head_rms(go_l).reshape(bsz, n_lat, GLA_WIDTH)

    aq_l = axial_rope(rms_norm(split_heads(pl[9], GQA_HEADS), qk_norm_g[0]), row, col)
    ak_l = axial_rope(rms_norm(split_heads(pl[10], GQA_KV_HEADS), qk_norm_g[1]), row, col)
    av_l = split_heads(pl[11], GQA_KV_HEADS)
    ak_c = rms_norm(split_heads(pc[10], GQA_KV_HEADS), qk_norm_g[1])
    av_c = split_heads(pc[11], GQA_KV_HEADS)
    y_gqa_l = gqa_latent(aq_l, ak_l, av_l, ak_c, av_c)

    y_lat = jnp.concatenate([y_ret_l, y_gla_l, y_gqa_l], axis=-1) @ w_out
    if not need_ctx:
        return y_lat, None
    aq_c = rms_norm(split_heads(pc[9], GQA_HEADS), qk_norm_g[0])
    y_ret_c = jax.nn.silu(pc[3]) * head_layernorm(ro_c).reshape(bsz, n_ctx, RET_WIDTH)
    y_gla_c = jax.nn.silu(pc[7]) * head_rms(go_c).reshape(bsz, n_ctx, GLA_WIDTH)
    y_gqa_c = gqa_context(aq_c, ak_c, av_c)
    y_ctx = jnp.concatenate([y_ret_c, y_gla_c, y_gqa_c], axis=-1) @ w_out
    return y_lat, y_ctx


def sq_relu_mlp(h, w1, w2):
    return jnp.square(jax.nn.relu(h @ w1)) @ w2


def setup_inputs(seed: int = 0) -> dict:
    key = jax.random.key(seed)
    ks = jax.random.split(key, 20)
    nrm = lambda k, shape, s: jax.random.normal(k, shape, jnp.float32) * s
    ret_logit0 = jnp.asarray(np.log(2.0 ** (5.0 + np.arange(RET_HEADS)) - 1.0), dtype=jnp.float32)
    return {
        'x': nrm(ks[0], (BATCH, SEQ, D_MODEL), 1.0),
        'c': nrm(ks[1], (BATCH, D_MODEL), 1.0),
        'ctx': nrm(ks[2], (BATCH, CTX_LEN, D_MODEL), 1.0),
        'c_ctx': nrm(ks[3], (D_MODEL,), 1.0),
        'mod_w': nrm(ks[4], (DEPTH, D_MODEL, 6 * D_MODEL), 0.5 * D_MODEL ** -0.5),
        'mod_b': nrm(ks[5], (DEPTH, 6 * D_MODEL), 0.01),
        'attn_norm_g': 1.0 + nrm(ks[6], (DEPTH, D_MODEL), 0.05),
        'mlp_norm_g': 1.0 + nrm(ks[7], (DEPTH, D_MODEL), 0.05),
        'w_in': nrm(ks[8], (DEPTH, D_MODEL, IN_WIDTH), D_MODEL ** -0.5),
        'w_out': nrm(ks[9], (DEPTH, MIX_WIDTH, D_MODEL), MIX_WIDTH ** -0.5),
        'ret_decay_logit': ret_logit0 + nrm(ks[10], (DEPTH, 2, RET_HEADS), 0.01),
        'gla_gate_w': nrm(ks[11], (DEPTH, 2, GLA_RANK, GLA_HEADS * GLA_DK), GLA_RANK ** -0.5),
        'gla_gate_b': nrm(ks[12], (DEPTH, 2, GLA_HEADS * GLA_DK), 0.1),
        'qk_norm_g': 1.0 + nrm(ks[13], (DEPTH, 2, GQA_HEAD_DIM), 0.05),
        'mlp_w1': nrm(ks[14], (DEPTH, D_MODEL, D_FF), D_MODEL ** -0.5),
        'mlp_w2': nrm(ks[15], (DEPTH, D_FF, D_MODEL), D_FF ** -0.5),
        'final_norm_g': 1.0 + nrm(ks[16], (D_MODEL,), 0.05),
    }


def reference(x, c, ctx, c_ctx, mod_w, mod_b, attn_norm_g, mlp_norm_g, w_in, w_out, ret_decay_logit,
              gla_gate_w, gla_gate_b, qk_norm_g, mlp_w1, mlp_w2, final_norm_g):
    n_lat = x.shape[1]
    rows = n_lat // GRID_W
    row = jnp.repeat(jnp.arange(rows, dtype=jnp.float32), GRID_W)
    col = (jnp.arange(rows * GRID_W) % GRID_W).astype(jnp.float32)
    silu_c = jax.nn.silu(c)
    silu_cc = jax.nn.silu(c_ctx)
    for i in range(DEPTH):
        need_ctx = i < DEPTH - 1
        sh_a, sc_a, gt_a, sh_m, sc_m, gt_m = [m[:, None, :] for m in
                                              jnp.split(silu_c @ mod_w[i] + mod_b[i], 6, axis=-1)]
        csh_a, csc_a, cgt_a, csh_m, csc_m, cgt_m = jnp.split(silu_cc @ mod_w[i] + mod_b[i], 6, axis=-1)
        h_lat = modulate(rms_norm(x, attn_norm_g[i]), sh_a, sc_a)
        h_ctx = modulate(rms_norm(ctx, attn_norm_g[i]), csh_a, csc_a)
        y_lat, y_ctx = token_mix(h_lat, h_ctx, w_in[i], w_out[i], ret_decay_logit[i], gla_gate_w[i],
                                 gla_gate_b[i], qk_norm_g[i], row, col, need_ctx)
        x = x + gt_a * y_lat
        x = x + gt_m * sq_relu_mlp(modulate(rms_norm(x, mlp_norm_g[i]), sh_m, sc_m), mlp_w1[i], mlp_w2[i])
        if need_ctx:
            ctx = ctx + cgt_a * y_ctx
            ctx = ctx + cgt_m * sq_relu_mlp(modulate(rms_norm(ctx, mlp_norm_g[i]), csh_m, csc_m),
                                            mlp_w1[i], mlp_w2[i])
    return rms_norm(x, final_norm_g)
```

```cpp
#include <hip/hip_runtime.h>
#include <hip/hip_cooperative_groups.h>
#include <cstdio>
#include <cstdint>
namespace cg = cooperative_groups;
namespace pg8 {
#define PG8_LAS __attribute__((address_space(3)))
typedef unsigned short bf16_t;
typedef short bf16x8 __attribute__((ext_vector_type(8)));
typedef float f32x4 __attribute__((ext_vector_type(4)));
typedef unsigned u32x4 __attribute__((ext_vector_type(4)));
constexpr int BM = 256, BK = 64, HALF = 128, HTB = HALF * BK * 2  , STAGE_BYTES = 8 * HTB, NXCD = 8, WGM = 8;

__host__ __device__ __forceinline__ int lds_byte(int r, int c) { const int st = (r >> 4) * 2 + (c >> 5), rr = r & 15, cc = c & 31, ob = rr * 64 + cc * 2; return st * 1024 + (ob ^ (((ob >> 9) & 1) << 5)); }
__host__ __device__ __forceinline__ void stage_rc(int b, int& R, int& C) { const int st = b / 1024, sb = b % 1024, swz = sb ^ (((sb >> 9) & 1) << 5); R = (st >> 1) * 16 + swz / 64; C = (st & 1) * 32 + (swz % 64) / 2; }
__host__ __device__ __forceinline__ int perm32(int rho) { const int n = rho >> 4, i = rho & 15; return 8 * (i >> 2) + 4 * n + (i & 3); }

struct Unit { int pm, pn; };
struct Gemm { const bf16_t* A; const bf16_t* Bt; int M, N, K; };

struct StaticOrder {
    int nM, nN, nwg, G, c;
    __host__ __device__ void init(int M, int N, int G_, int c_) { nM = M / BM; nN = N / BM; nwg = nM * nN; G = G_; c = c_; }
    __host__ __device__ bool next(int i, Unit& u) const {
        const long L = (long)i * G + c; if (L >= nwg) return false;
        int wgid = (int)L; { const int q = nwg / NXCD, r = nwg % NXCD, xcd = wgid % NXCD, off = wgid / NXCD; wgid = (xcd < r ? xcd * (q + 1) : r * (q + 1) + (xcd - r) * q) + off; }
        const int nig = WGM * nN, gid = wgid / nig, fm = gid * WGM, gsz = (nM - fm) < WGM ? (nM - fm) : WGM;
        u.pm = fm + ((wgid % nig) % gsz); u.pn = (wgid % nig) / gsz; return true;
    }
    __device__ __forceinline__ void a_ready(const Unit&) const {}
    __device__ __forceinline__ void done(const Unit&) const {}
};

__device__ __forceinline__ unsigned cvt_pk_bf16(float lo, float hi) { unsigned r; asm volatile("v_cvt_pk_bf16_f32 %0, %1, %2" : "=v"(r) : "v"(lo), "v"(hi)); return r; }
typedef float f32x2 __attribute__((ext_vector_type(2)));
__device__ __forceinline__ void st16_wt(void* p, u32x4 v) { asm volatile("global_store_dwordx4 %0, %1, off sc1\n\ts_nop 1" :: "v"(p), "v"(v) : "memory"); }
struct EpiStoreBf16 {
    static constexpr bool PERM = true, AFTER_DRAIN = false;
    bf16_t* O; int ldc; int act; const float* gate;
    __device__ __forceinline__ void operator()(const f32x4 (&acc)[2][2][4][2], const Unit& u, int wr, int wc, int fr, int fq) const {
        const int row0 = u.pm * BM + wr * 64 + fr; const int col0 = u.pn * BM + wc * 32 + 8 * fq;
        f32x4 gv[2][2];
        if (gate) { const float* g = gate + (u.pm >> 6) * 6144 + col0;
#pragma unroll
            for (int bj = 0; bj < 2; ++bj) { gv[bj][0] = *(const f32x4*)(g + bj * HALF); gv[bj][1] = *(const f32x4*)(g + bj * HALF + 4); } }
#pragma unroll
        for (int ai = 0; ai < 2; ++ai)
#pragma unroll
            for (int m = 0; m < 4; ++m) { bf16_t* rowp = O + (size_t)(row0 + ai * HALF + m * 16) * ldc + col0;
#pragma unroll
                for (int bj = 0; bj < 2; ++bj) { f32x4 v0 = acc[ai][bj][m][0], v1 = acc[ai][bj][m][1];
                    if (gate) { v0 = v0 * gv[bj][0]; v1 = v1 * gv[bj][1]; }
                    if (act == 1) {
#pragma unroll
                        for (int e = 0; e < 4; ++e) { float a = fmaxf(v0[e], 0.f), b = fmaxf(v1[e], 0.f); v0[e] = a * a; v1[e] = b * b; } }
                    u32x4 w; w.x = cvt_pk_bf16(v0[0], v0[1]); w.y = cvt_pk_bf16(v0[2], v0[3]); w.z = cvt_pk_bf16(v1[0], v1[1]); w.w = cvt_pk_bf16(v1[2], v1[3]);
                    st16_wt(rowp + bj * HALF, w); } }
    }
};
struct EpiResid {
    static constexpr bool PERM = false, AFTER_DRAIN = false;
    float* xlat; float* xctx; const float* gt; float* dummy;
    __device__ __forceinline__ void operator()(const f32x4 (&acc)[2][2][4][2], const Unit& u, int wr, int wc, int fr, int fq) const {
        const int cond = (u.pm < 128) ? (u.pm >> 6) : 2; const float* g = gt + cond * 6144;
        const int col0 = u.pn * BM + wc * 32 + 4 * fq;
        f32x4 gv[2][2];
#pragma unroll
        for (int bj = 0; bj < 2; ++bj)
#pragma unroll
            for (int n = 0; n < 2; ++n) gv[bj][n] = *(const f32x4*)(g + col0 + bj * HALF + n * 16);
#pragma unroll
        for (int ai = 0; ai < 2; ++ai)
#pragma unroll
            for (int m = 0; m < 4; ++m) { const int r = u.pm * BM + ai * HALF + wr * 64 + m * 16 + fr;
                float* rowp = (r < 32768) ? (xlat + (size_t)r * 1024) : (xctx + (size_t)(r - 32768) * 1024);
#pragma unroll
                for (int bj = 0; bj < 2; ++bj)
#pragma unroll
                    for (int n = 0; n < 2; ++n) { float* p = rowp + col0 + bj * HALF + n * 16; f32x4 x = *(const f32x4*)p; x = x + gv[bj][n] * acc[ai][bj][m][n]; float* q = dummy ? (dummy + (size_t)(r & 16383) * 1024 + col0 + bj * HALF + n * 16) : p; *(f32x4*)q = x; } }
    }
};
template <class Epi, class Sched, bool ALIGN_EPI = false, bool SP2 = false>
__device__ __forceinline__ void gemm_phase(PG8_LAS unsigned char* lds, const Gemm g, const Sched& S, const Epi& E) {
    int tid_l = threadIdx.x; asm volatile("" : "+v"(tid_l));
    const int tid = tid_l, wid = __builtin_amdgcn_readfirstlane(tid >> 6), lane = tid & 63, wr = wid >> 2, wc = wid & 3, fr = lane & 15, fq = lane >> 4;
    const int K = g.K, nt = K / BK;
    unsigned voffA[2], voffB[2];
#pragma unroll
    for (int i = 0; i < 2; ++i) { int R, C; stage_rc(tid * 16 + i * 8192, R, C); const int Rb = Epi::PERM ? ((R & ~31) + perm32(R & 31)) : R;
        voffA[i] = (unsigned)(R * K + C) * 2u; voffB[i] = (unsigned)(Rb * K + C) * 2u; }
    const size_t kstep = (size_t)(BK * 2);
    const size_t hstep = (size_t)HALF * K * 2;
    const size_t tstep = 2 * hstep;
    const unsigned ldsw = (unsigned)wid * 1024u;
    const int aoff = lds_byte(wr * 64 + fr, fq * 8), boff = lds_byte(wc * 32 + fr, fq * 8);
#define PG8_SA(b, h) (((b) * 2 + (h)) * HTB)
#define PG8_SB(b, h) ((4 + (b) * 2 + (h)) * HTB)
#define PG8_STAGE(bufoff, gbase, voff) do { _Pragma("unroll") for (int _i = 0; _i < 2; ++_i) \
        __builtin_amdgcn_global_load_lds((const unsigned*)((const char*)(gbase) + (voff)[_i]), (PG8_LAS unsigned*)(lds + (bufoff) + ldsw + _i * 8192), 16, 0, 0); } while (0)
#define PG8_LDA(dst, b, h) do { _Pragma("unroll") for (int m = 0; m < 4; ++m) _Pragma("unroll") for (int k = 0; k < 2; ++k) dst[m][k] = *(const PG8_LAS bf16x8*)(lds + PG8_SA(b, h) + aoff + m * 2048 + k * 1024); } while (0)
#define PG8_LDB(dst, b, h) do { _Pragma("unroll") for (int n = 0; n < 2; ++n) _Pragma("unroll") for (int k = 0; k < 2; ++k) dst[n][k] = *(const PG8_LAS bf16x8*)(lds + PG8_SB(b, h) + boff + n * 2048 + k * 1024); } while (0)
#define PG8_MMA(ai, bj, At, Bt) do { __builtin_amdgcn_s_setprio(1); _Pragma("unroll") for (int m = 0; m < 4; ++m) _Pragma("unroll") for (int n = 0; n < 2; ++n) _Pragma("unroll") for (int k = 0; k < 2; ++k) \
        acc[ai][bj][m][n] = __builtin_amdgcn_mfma_f32_16x16x32_bf16(Bt[n][k], At[m][k], acc[ai][bj][m][n], 0, 0, 0); __builtin_amdgcn_s_setprio(0); } while (0)
#define PG8_WAIT_V(n) asm volatile("s_waitcnt vmcnt(" #n ")" ::: "memory")
#define PG8_WAIT_L(n) asm volatile("s_waitcnt lgkmcnt(" #n ")" ::: "memory")
#define PG8_BAR __builtin_amdgcn_s_barrier()
#define PG8_SCHED __builtin_amdgcn_sched_barrier(0)
    Unit cur, nxt; int ui = 0;
    if (!S.next(0, cur)) return;
    f32x4 acc[2][2][4][2];
#pragma unroll
    for (int a = 0; a < 2; ++a)
#pragma unroll
        for (int b = 0; b < 2; ++b)
#pragma unroll
            for (int m = 0; m < 4; ++m)
#pragma unroll
                for (int n = 0; n < 2; ++n) acc[a][b][m][n] = (f32x4){0.f, 0.f, 0.f, 0.f};
    bf16x8 At[4][2], B0[2][2], B1[2][2];
    const char* cA = (const char*)g.A + (size_t)cur.pm * tstep; const char* cB = (const char*)g.Bt + (size_t)cur.pn * tstep;
    S.a_ready(cur);
    if constexpr (SP2) {
        PG8_STAGE(PG8_SB(0, 0), cB, voffB); PG8_STAGE(PG8_SB(0, 1), cB + hstep, voffB); PG8_STAGE(PG8_SA(0, 0), cA, voffA); PG8_STAGE(PG8_SA(0, 1), cA + hstep, voffA);
        if (wr == 1) PG8_BAR;
        PG8_WAIT_V(2); PG8_BAR;
        PG8_STAGE(PG8_SB(1, 0), cB + kstep, voffB); PG8_STAGE(PG8_SA(1, 0), cA + kstep, voffA); PG8_STAGE(PG8_SB(1, 1), cB + hstep + kstep, voffB);
        PG8_WAIT_V(6); PG8_BAR;
    } else {
        PG8_STAGE(PG8_SB(0, 0), cB, voffB); PG8_STAGE(PG8_SA(0, 0), cA, voffA); PG8_STAGE(PG8_SB(0, 1), cB + hstep, voffB); PG8_STAGE(PG8_SA(0, 1), cA + hstep, voffA);
        if (wr == 1) PG8_BAR;
        PG8_WAIT_V(4); PG8_BAR;
        PG8_STAGE(PG8_SB(1, 0), cB + kstep, voffB); PG8_STAGE(PG8_SA(1, 0), cA + kstep, voffA); PG8_STAGE(PG8_SB(1, 1), cB + hstep + kstep, voffB);
        PG8_WAIT_V(6); PG8_BAR;
    }
    for (;;) {
        const bool has_next = S.next(ui + 1, nxt);
        const char* nA = has_next ? (const char*)g.A + (size_t)nxt.pm * tstep : cA; const char* nB = has_next ? (const char*)g.Bt + (size_t)nxt.pn * tstep : cB;
        for (int t = 0; t < nt; t += 2) {
            const bool last = (t == nt - 2);
            const char* a1 = cA + (size_t)(t + 1) * kstep;
            const char* a2 = last ? nA : cA + (size_t)(t + 2) * kstep; const char* b2 = last ? nB : cB + (size_t)(t + 2) * kstep;
            const char* a3 = a2 + kstep; const char* b3 = b2 + kstep;
            if (last && has_next) S.a_ready(nxt);
            if constexpr (SP2) {
            PG8_LDB(B0, 0, 0); PG8_LDB(B1, 0, 1); PG8_SCHED; PG8_LDA(At, 0, 0); PG8_STAGE(PG8_SA(1, 1), a1 + hstep, voffA);
            PG8_WAIT_V(8); PG8_WAIT_L(0); PG8_BAR; PG8_MMA(0, 0, At, B0); PG8_MMA(0, 1, At, B1); PG8_BAR; PG8_SCHED;
            PG8_LDA(At, 0, 1); PG8_STAGE(PG8_SB(0, 0), b2, voffB); PG8_STAGE(PG8_SB(0, 1), b2 + hstep, voffB); PG8_STAGE(PG8_SA(0, 0), a2, voffA);
            PG8_WAIT_V(8); PG8_WAIT_L(0); PG8_BAR; PG8_MMA(1, 0, At, B0); PG8_MMA(1, 1, At, B1); PG8_BAR; PG8_SCHED;
            PG8_LDB(B0, 1, 0); PG8_LDB(B1, 1, 1); PG8_SCHED; PG8_LDA(At, 1, 0); PG8_STAGE(PG8_SA(0, 1), a2 + hstep, voffA);
            PG8_WAIT_V(8); PG8_WAIT_L(0); PG8_BAR; PG8_MMA(0, 0, At, B0); PG8_MMA(0, 1, At, B1); PG8_BAR; PG8_SCHED;
            PG8_LDA(At, 1, 1); PG8_STAGE(PG8_SB(1, 0), b3, voffB); PG8_STAGE(PG8_SB(1, 1), b3 + hstep, voffB); PG8_STAGE(PG8_SA(1, 0), a3, voffA);
            PG8_WAIT_V(8); PG8_WAIT_L(0); PG8_BAR; PG8_MMA(1, 0, At, B0); PG8_MMA(1, 1, At, B1); PG8_BAR; PG8_SCHED;
            } else {
            PG8_LDB(B0, 0, 0); PG8_SCHED; PG8_LDA(At, 0, 0); PG8_STAGE(PG8_SA(1, 1), a1 + hstep, voffA);
            PG8_WAIT_L(8); PG8_BAR; PG8_WAIT_L(0); PG8_MMA(0, 0, At, B0); PG8_BAR; PG8_SCHED;
            PG8_LDB(B1, 0, 1); PG8_STAGE(PG8_SB(0, 0), b2, voffB);
            PG8_BAR; PG8_WAIT_L(0); PG8_MMA(0, 1, At, B1); PG8_BAR;
            PG8_LDA(At, 0, 1); PG8_STAGE(PG8_SA(0, 0), a2, voffA);
            PG8_BAR; PG8_WAIT_L(0); PG8_MMA(1, 0, At, B0); PG8_BAR; PG8_SCHED;
            PG8_STAGE(PG8_SB(0, 1), b2 + hstep, voffB);
            PG8_WAIT_V(6); PG8_BAR; PG8_MMA(1, 1, At, B1); PG8_BAR;
            PG8_LDB(B0, 1, 0); PG8_SCHED; PG8_LDA(At, 1, 0); PG8_STAGE(PG8_SA(0, 1), a2 + hstep, voffA);
            PG8_WAIT_L(8); PG8_BAR; PG8_WAIT_L(0); PG8_MMA(0, 0, At, B0); PG8_BAR; PG8_SCHED;
            PG8_LDB(B1, 1, 1); PG8_STAGE(PG8_SB(1, 0), b3, voffB);
            PG8_BAR; PG8_WAIT_L(0); PG8_MMA(0, 1, At, B1); PG8_BAR;
            PG8_LDA(At, 1, 1); PG8_STAGE(PG8_SA(1, 0), a3, voffA);
            PG8_BAR; PG8_WAIT_L(0); PG8_MMA(1, 0, At, B0); PG8_BAR; PG8_SCHED;
            PG8_STAGE(PG8_SB(1, 1), b3 + hstep, voffB);
            PG8_WAIT_V(6); PG8_BAR; PG8_MMA(1, 1, At, B1); PG8_BAR;
            }
        }
        if constexpr (ALIGN_EPI) { if (wr == 0) PG8_BAR; }
        if constexpr (!Epi::AFTER_DRAIN) { E(acc, cur, wr, wc, fr, fq); S.done(cur); }
        if (!has_next) break;
#pragma unroll
        for (int a = 0; a < 2; ++a)
#pragma unroll
            for (int b = 0; b < 2; ++b)
#pragma unroll
                for (int m = 0; m < 4; ++m)
#pragma unroll
                    for (int n = 0; n < 2; ++n) acc[a][b][m][n] = (f32x4){0.f, 0.f, 0.f, 0.f};
        cur = nxt; cA = nA; cB = nB; ++ui;
        if constexpr (ALIGN_EPI) { if (wr == 1) PG8_BAR; }
    }
    PG8_WAIT_V(0);
    if constexpr (!ALIGN_EPI) { if (wr == 0) PG8_BAR; }
    PG8_BAR;
    if constexpr (Epi::AFTER_DRAIN) { E.fused(acc, cur, wr, wc, fr, fq, lds, wid, lane); S.done(cur); }
#undef PG8_SA
#undef PG8_SB
#undef PG8_STAGE
#undef PG8_LDA
#undef PG8_LDB
#undef PG8_MMA
#undef PG8_WAIT_V
#undef PG8_WAIT_L
#undef PG8_BAR
#undef PG8_SCHED
}
}
#include <hip/hip_bf16.h>
#include <cmath>
namespace attn_body {
using bf16=__hip_bfloat16;
using bf16x8=__attribute__((ext_vector_type(8)))short;
using s16x4=__attribute__((ext_vector_type(4)))short;
using f32x16=__attribute__((ext_vector_type(16)))float;
using u32x4=__attribute__((ext_vector_type(4)))unsigned;
constexpr int D=64,QP=2560,KP=128,OP=1024;
constexpr int NW=8,QBLK=32,QB=QBLK*NW,KVBLK=64;
constexpr int ATTN_UNIT_ROWS=QB;
__device__ __forceinline__ int crow(int r,int hi){return (r&3)+8*(r>>2)+4*hi;}
#define SBAR() __builtin_amdgcn_sched_barrier(0)
__device__ __forceinline__ void cmask(f32x16&p0,f32x16&p1,int jb,int qrel,int hi){
  const float NEG=-INFINITY; int kb=64*jb+4*hi;
  #pragma unroll
  for(int r=0;r<16;++r){int kv=kb+(r&3)+8*(r>>2); if(kv>qrel)p0[r]=NEG; if(kv+32>qrel)p1[r]=NEG;}
}

constexpr int NSLOT=3, SLOTB=8192;
constexpr int LDS_K=0, LDS_V=NSLOT*SLOTB, LDS_WS=2*NSLOT*SLOTB, LDS_OST=LDS_WS+NW*64*4, LDS_BYTES=LDS_OST+NW*4096;
constexpr float C2=0.125f*1.4426950408889634f;
__device__ __forceinline__ void glds16(const void*gsrc,unsigned lds_dst){unsigned keep;
  asm volatile("s_mov_b32 %0, m0\n\ts_mov_b32 m0, %2\n\ts_nop 0\n\tglobal_load_lds_dwordx4 %1, off\n\ts_mov_b32 m0, %0":"=&s"(keep):"v"(gsrc),"s"(lds_dst):"memory");}
__device__ __forceinline__ float max3f(float a,float b,float c){float r;asm("v_max3_f32 %0, %1, %2, %3":"=v"(r):"v"(a),"v"(b),"v"(c));return r;}
__device__ __forceinline__ float max2f(float a,float b){float r;asm("v_max_f32_e32 %0, %1, %2":"=v"(r):"v"(a),"v"(b));return r;}
__device__ __forceinline__ float fadd_s(float a,float b){float r;asm("v_add_f32_e32 %0, %1, %2":"=v"(r):"v"(a),"v"(b));return r;}
__device__ __forceinline__ float fsub_s(float a,float b){float r;asm("v_sub_f32_e32 %0, %1, %2":"=v"(r):"v"(a),"v"(b));return r;}
typedef float f32x2_t __attribute__((ext_vector_type(2))); typedef __bf16 bf16x2_t __attribute__((ext_vector_type(2)));
__device__ __forceinline__ unsigned cvtpk_s(float lo,float hi){f32x2_t v={lo,hi};bf16x2_t b=__builtin_convertvector(v,bf16x2_t);return __builtin_bit_cast(unsigned,b);}
#define WAIT_BAR(N) asm volatile("s_waitcnt vmcnt(" #N ") lgkmcnt(0)\n\ts_barrier":::"memory")

__device__ __forceinline__ void qkt(f32x16&p0,f32x16&p1,const char*Kslot,const bf16x8*qr,const f32x16&negm,int r32,int hi){
  const char*kb=Kslot+hi*1024+r32*16;
  #pragma unroll
  for(int d0=0;d0<4;++d0){
    const bf16x8 b0=*reinterpret_cast<const bf16x8*>(kb+d0*2048);
    const bf16x8 b1=*reinterpret_cast<const bf16x8*>(kb+d0*2048+512);
    if(d0==0){p0=__builtin_amdgcn_mfma_f32_32x32x16_bf16(b0,qr[0],negm,0,0,0);p1=__builtin_amdgcn_mfma_f32_32x32x16_bf16(b1,qr[0],negm,0,0,0);}
    else{p0=__builtin_amdgcn_mfma_f32_32x32x16_bf16(b0,qr[d0],p0,0,0,0);p1=__builtin_amdgcn_mfma_f32_32x32x16_bf16(b1,qr[d0],p1,0,0,0);}}
}
typedef __attribute__((address_space(3))) const char* lds_cptr;
typedef short v4i16_t __attribute__((ext_vector_type(4)));
__device__ __forceinline__ void kload8(bf16x8*kf,lds_cptr kp){
  kf[0]=*(const __attribute__((address_space(3))) bf16x8*)(kp);      kf[1]=*(const __attribute__((address_space(3))) bf16x8*)(kp+512);
  kf[2]=*(const __attribute__((address_space(3))) bf16x8*)(kp+2048); kf[3]=*(const __attribute__((address_space(3))) bf16x8*)(kp+2560);
  kf[4]=*(const __attribute__((address_space(3))) bf16x8*)(kp+4096); kf[5]=*(const __attribute__((address_space(3))) bf16x8*)(kp+4608);
  kf[6]=*(const __attribute__((address_space(3))) bf16x8*)(kp+6144); kf[7]=*(const __attribute__((address_space(3))) bf16x8*)(kp+6656);
}
__device__ __forceinline__ void kload2(bf16x8*kf,lds_cptr kp,int j){ kf[2*j]=*(const __attribute__((address_space(3))) bf16x8*)(kp+j*2048); kf[2*j+1]=*(const __attribute__((address_space(3))) bf16x8*)(kp+j*2048+512); }
__device__ __forceinline__ s16x4 vtr(lds_cptr p){ return __builtin_bit_cast(s16x4,__builtin_amdgcn_ds_read_tr16_b64_v4i16((__attribute__((address_space(3))) v4i16_t*)p)); }
__device__ __forceinline__ float rowmax(const f32x16&p0,const f32x16&p1){
  float a=max3f(p0[0],p0[1],p1[0]),b=max3f(p0[2],p0[3],p1[1]);a=max3f(a,p1[2],p1[3]);
  #pragma unroll
  for(int r=4;r<16;r+=4){a=max3f(a,p0[r],p0[r+1]);b=max3f(b,p0[r+2],p0[r+3]);a=max3f(a,p1[r],p1[r+1]);b=max3f(b,p1[r+2],p1[r+3]);}
  const float m=max2f(a,b);
  auto rr=__builtin_amdgcn_permlane32_swap(__float_as_uint(m),__float_as_uint(m),false,false);
  return max2f(__uint_as_float(rr[0]),__uint_as_float(rr[1]));
}
__device__ __forceinline__ void pv(f32x16*o,int vb,bf16x8 pa0,bf16x8 pa1,bf16x8 pa2,bf16x8 pa3){
  #pragma unroll
  for(int d0=0;d0<2;++d0){s16x4 lo[4],hi[4];
    #pragma unroll
    for(int ks=0;ks<4;++ks){
      asm volatile("ds_read_b64_tr_b16 %0,%1 offset:%c2":"=&v"(lo[ks]):"v"(vb),"i"(d0*4096+ks*1024):"memory");
      asm volatile("ds_read_b64_tr_b16 %0,%1 offset:%c2":"=&v"(hi[ks]):"v"(vb),"i"(d0*4096+ks*1024+512):"memory");}
    asm volatile("s_waitcnt lgkmcnt(0)":::"memory");SBAR();
    #define PK(k) (bf16x8){lo[k][0],lo[k][1],lo[k][2],lo[k][3],hi[k][0],hi[k][1],hi[k][2],hi[k][3]}
    o[d0]=__builtin_amdgcn_mfma_f32_32x32x16_bf16(pa0,PK(0),o[d0],0,0,0);
    o[d0]=__builtin_amdgcn_mfma_f32_32x32x16_bf16(pa1,PK(1),o[d0],0,0,0);
    o[d0]=__builtin_amdgcn_mfma_f32_32x32x16_bf16(pa2,PK(2),o[d0],0,0,0);
    o[d0]=__builtin_amdgcn_mfma_f32_32x32x16_bf16(pa3,PK(3),o[d0],0,0,0);
    #undef PK
  }
}

#ifndef ATTN_STORE16
#define ATTN_STORE16(p,v) asm volatile("global_store_dwordx4 %0, %1, off sc1\n\ts_nop 1"::"v"(p),"v"(v):"memory")
#endif
template<int THRL,bool FIXREF> __device__ __forceinline__ void attn_unit(const float*gq,const float*tab,const int tq0,const bf16*Qw0,const bf16*__restrict__ Kl,const bf16*__restrict__ Vl,const int NT,bf16*Ow0,char*shm){
  int tid_l=threadIdx.x; asm volatile("":"+v"(tid_l)); const int tid=tid_l,lane=tid&63,r32=lane&31,hi=lane>>5; const int wid=__builtin_amdgcn_readfirstlane(tid>>6);
  const bf16*Qw=Qw0+(long)(wid*QBLK)*QP;
  const unsigned lds0=(unsigned)(uintptr_t)shm;
  float*wsf=(float*)(shm+LDS_WS)+wid*64;
  const bf16*ksrc=Kl+wid*512+lane*8;
  const bf16*vsrc=Vl+wid*512+lane*8;
  const unsigned kdst=lds0+LDS_K+wid*1024, vdst=lds0+LDS_V+wid*1024;
  #define DMA_K(t,slot) glds16(ksrc+(long)(t)*4096,(unsigned)__builtin_amdgcn_readfirstlane(kdst+(slot)))
  #define DMA_V(t,slot) glds16(vsrc+(long)(t)*4096,(unsigned)__builtin_amdgcn_readfirstlane(vdst+(slot)))
  const int vb0=(int)(lds0+LDS_V)+((lane>>4)&1)*32+(lane&3)*8+(4*hi+((lane&15)>>2))*64;
  const char*Kbase=shm+LDS_K; bf16x8 kf[8];
  const lds_cptr shm3=(lds_cptr)shm; const lds_cptr kp0=shm3+LDS_K+hi*1024+r32*16; const lds_cptr vp0=shm3+LDS_V+((lane>>4)&1)*32+(lane&3)*8+(4*hi+((lane&15)>>2))*64;
  DMA_K(0,0);DMA_V(0,0);DMA_K(1,SLOTB);
  bf16x8 qr[4];
  {
    float xq[4][8]; float ss=0.f;
    #pragma unroll
    for(int d0=0;d0<4;++d0){ const u32x4 w=*reinterpret_cast<const u32x4*>(&Qw[(long)r32*QP+d0*16+hi*8]); const unsigned ww[4]={w.x,w.y,w.z,w.w};
      #pragma unroll
      for(int c=0;c<4;++c){ xq[d0][2*c]=__uint_as_float(ww[c]<<16); xq[d0][2*c+1]=__uint_as_float(ww[c]&0xffff0000u); ss+=xq[d0][2*c]*xq[d0][2*c]+xq[d0][2*c+1]*xq[d0][2*c+1]; } }
    { auto rr=__builtin_amdgcn_permlane32_swap(__float_as_uint(ss),__float_as_uint(ss),false,false); ss=__uint_as_float(rr[0])+__uint_as_float(rr[1]); }
    const float rstd=__builtin_amdgcn_rsqf(ss*(1.f/64.f)+1e-6f)*C2;
    #pragma unroll
    for(int d0=0;d0<4;++d0){ const float*gp=gq+d0*16+hi*8;
      #pragma unroll
      for(int j=0;j<8;++j)xq[d0][j]*=rstd*gp[j]; }
    if(tab){ const int tpos=(tq0+wid*QBLK+r32)&16383; const float*tr_=tab+((tpos>>6)*16+hi*8)*2; const float*tc_=tab+((tpos&63)*16+hi*8)*2;
      #pragma unroll
      for(int j=0;j<8;++j){ const float cr=tr_[2*j],sr=tr_[2*j+1],cc=tc_[2*j],sc=tc_[2*j+1];
        const float a0=xq[0][j],b0=xq[1][j],a1=xq[2][j],b1=xq[3][j];
        xq[0][j]=a0*cr-b0*sr; xq[1][j]=a0*sr+b0*cr; xq[2][j]=a1*cc-b1*sc; xq[3][j]=a1*sc+b1*cc; } }
    #pragma unroll
    for(int d0=0;d0<4;++d0){ u32x4 p; p.x=cvtpk_s(xq[d0][0],xq[d0][1]); p.y=cvtpk_s(xq[d0][2],xq[d0][3]); p.z=cvtpk_s(xq[d0][4],xq[d0][5]); p.w=cvtpk_s(xq[d0][6],xq[d0][7]); qr[d0]=__builtin_bit_cast(bf16x8,p); } }
  float mhat=0.f,l_reg=0.f;f32x16 o[2];o[0]=f32x16{};o[1]=f32x16{};f32x16 negm=f32x16{};asm volatile("":"+v"(negm));
  #define CMASK(P0,P1,t) do{}while(0)
  bool resc=false;
  #define START(P0,P1) do{ resc=false; \
    if(!FIXREF){ const float rm=rowmax(P0,P1); const float dl=rm; mhat=fadd_s(mhat,dl); \
      _Pragma("unroll") for(int r=0;r<16;++r){P0[r]=fsub_s(P0[r],dl);P1[r]=fsub_s(P1[r],dl);} \
      _Pragma("unroll") for(int r=0;r<16;++r)negm[r]=-mhat; asm volatile("":"+v"(negm)); } \
    _Pragma("unroll") for(int r=0;r<16;++r)P0[r]=__builtin_amdgcn_exp2f(P0[r]); }while(0)
  #define RESC() do{ if(resc){ asm volatile("s_waitcnt lgkmcnt(0)":::"memory"); \
      _Pragma("unroll") for(int d_=0;d_<2;++d_) _Pragma("unroll") for(int r=0;r<16;++r)o[d_][r]*=wsf[crow(r,hi)]; } }while(0)
  f32x16 pA0,pA1,pB0,pB1;
  int sl_prev=0,sl_cur=0,sl_next=SLOTB;
  #define ROT() do{sl_prev=sl_cur;sl_cur=sl_next;sl_next=(sl_next==(NSLOT-1)*SLOTB)?0:sl_next+SLOTB;}while(0)
  DMA_K(2,2*SLOTB);
  WAIT_BAR(3);
  qkt(pA0,pA1,Kbase,qr,negm,r32,hi);asm volatile("s_nop 15\n\ts_nop 7":"+v"(pA0),"+v"(pA1));CMASK(pA0,pA1,0);
  START(pA0,pA1);
  _Pragma("unroll") for(int r=0;r<16;++r)pA1[r]=__builtin_amdgcn_exp2f(pA1[r]);
  WAIT_BAR(0);
  DMA_K(3,0);DMA_V(1,SLOTB);
  ROT();
  kload8(kf,kp0+sl_cur);
  WAIT_BAR(2);
  s16x4 vlo[8],vhi[8]; u32x4 pw0,pw1,pw2,pw3;
  #define PKW(P,B) cvtpk_s(P[B],P[B+1])
  #define PAF(k) __builtin_bit_cast(bf16x8,pw##k)
  #define VFR(i) (bf16x8){vlo[i][0],vlo[i][1],vlo[i][2],vlo[i][3],vhi[i][0],vhi[i][1],vhi[i][2],vhi[i][3]}
  #define PIN(x) asm volatile("":"+v"(x))
  #define MX3(a,b,c) __builtin_fmaxf(__builtin_fmaxf((a),(b)),(c))
  #define GAPA(MF,A0,A1,A2,A3,W0,W1,PW) do{ MF; sacc+=A0; sacc+=A1; sacc+=A2; sacc+=A3; PIN(sacc); W0; W1; PIN(PW); SBAR(); }while(0)
  #define EX(v) __builtin_amdgcn_exp2f(v)
  #define GAPB(MF,X,B) do{ MF; X[B]=EX(X[B]); X[B+1]=EX(X[B+1]); X[B+2]=EX(X[B+2]); X[B+3]=EX(X[B+3]); PIN(X); SBAR(); }while(0)
  #define VRD(i) do{ vlo[i]=vtr(vp_+(((i)>>2)*4096+((i)&3)*1024)); vhi[i]=vtr(vp_+(((i)>>2)*4096+((i)&3)*1024+512)); }while(0)
  #define KRD(G,j) do{ if(G){ kload2(kf,kp0+sl_next,j); SBAR(); } }while(0)
  #define STEP(C0,C1,P0,P1,t,GK,GV,GL) do{ SBAR(); \
    const lds_cptr vp_=vp0+sl_prev; \
    VRD(0); SBAR(); float sacc=(P0[0]+P0[1]); \
    GAPA(C0=__builtin_amdgcn_mfma_f32_32x32x16_bf16(kf[0],qr[0],negm,0,0,0), P0[2],P0[3],P0[4],P0[5],     pw0[0]=PKW(P0,0), pw0[1]=PKW(P0,2), pw0); \
    VRD(4); SBAR(); GAPA(C1=__builtin_amdgcn_mfma_f32_32x32x16_bf16(kf[1],qr[0],negm,0,0,0), P0[6],P0[7],P0[8],P0[9],     pw0[2]=PKW(P0,4), pw0[3]=PKW(P0,6), pw0); \
    VRD(1); SBAR(); GAPA(C0=__builtin_amdgcn_mfma_f32_32x32x16_bf16(kf[2],qr[1],C0,0,0,0),   P0[10],P0[11],P0[12],P0[13], pw1[0]=PKW(P0,8), pw1[1]=PKW(P0,10), pw1); \
    VRD(5); SBAR(); GAPA(C1=__builtin_amdgcn_mfma_f32_32x32x16_bf16(kf[3],qr[1],C1,0,0,0),   P0[14],P0[15],P1[0],P1[1],   pw1[2]=PKW(P0,12),pw1[3]=PKW(P0,14), pw1); \
    VRD(2); SBAR(); GAPA(C0=__builtin_amdgcn_mfma_f32_32x32x16_bf16(kf[4],qr[2],C0,0,0,0),   P1[2],P1[3],P1[4],P1[5],     pw2[0]=PKW(P1,0), pw2[1]=PKW(P1,2), pw2); \
    VRD(6); SBAR(); GAPA(C1=__builtin_amdgcn_mfma_f32_32x32x16_bf16(kf[5],qr[2],C1,0,0,0),   P1[6],P1[7],P1[8],P1[9],     pw2[2]=PKW(P1,4), pw2[3]=PKW(P1,6), pw2); \
    VRD(3); SBAR(); GAPA(C0=__builtin_amdgcn_mfma_f32_32x32x16_bf16(kf[6],qr[3],C0,0,0,0),   P1[10],P1[11],P1[12],P1[13], pw3[0]=PKW(P1,8), pw3[1]=PKW(P1,10), pw3); \
    VRD(7); SBAR(); GAPA(C1=__builtin_amdgcn_mfma_f32_32x32x16_bf16(kf[7],qr[3],C1,0,0,0),   P1[14],P1[15],0.f,0.f,       pw3[2]=PKW(P1,12),pw3[3]=PKW(P1,14), pw3); \
    l_reg+=sacc; \
    if(GK){DMA_K((t)+3,sl_cur);} if(GV){DMA_V((t)+1,sl_next);} \
    CMASK(C0,C1,t); \
    if(!FIXREF){ float a=MX3(C0[0],C0[1],C1[0]),b=MX3(C0[2],C0[3],C1[1]); a=MX3(a,C1[2],C1[3]); \
      _Pragma("unroll") for(int r=4;r<16;r+=4){a=MX3(a,C0[r],C0[r+1]);b=MX3(b,C0[r+2],C0[r+3]);a=MX3(a,C1[r],C1[r+1]);b=MX3(b,C1[r+2],C1[r+3]);} \
      float rm=__builtin_fmaxf(a,b); { auto rr=__builtin_amdgcn_permlane32_swap(__float_as_uint(rm),__float_as_uint(rm),false,false); rm=__builtin_fmaxf(__uint_as_float(rr[0]),__uint_as_float(rr[1])); } \
      resc=false; \
      if(__builtin_expect(__any(rm>(float)THRL),0)){ const float dl=__builtin_fmaxf(rm,0.f); mhat+=dl; \
        _Pragma("unroll") for(int r=0;r<16;++r){C0[r]-=dl;C1[r]-=dl;} \
        _Pragma("unroll") for(int r=0;r<16;++r)negm[r]=-mhat; asm volatile("":"+v"(negm)); \
        const float f=__builtin_amdgcn_exp2f(-dl); l_reg*=f; if(hi==0)wsf[r32]=f; resc=true; } } \
    SBAR(); \
    GAPB(o[0]=__builtin_amdgcn_mfma_f32_32x32x16_bf16(PAF(0),VFR(0),o[0],0,0,0), C0,0); \
    GAPB(o[1]=__builtin_amdgcn_mfma_f32_32x32x16_bf16(PAF(0),VFR(4),o[1],0,0,0), C0,4); \
    KRD(GL,0); GAPB(o[0]=__builtin_amdgcn_mfma_f32_32x32x16_bf16(PAF(1),VFR(1),o[0],0,0,0), C0,8); \
    KRD(GL,1); GAPB(o[1]=__builtin_amdgcn_mfma_f32_32x32x16_bf16(PAF(1),VFR(5),o[1],0,0,0), C0,12); \
    KRD(GL,2); GAPB(o[0]=__builtin_amdgcn_mfma_f32_32x32x16_bf16(PAF(2),VFR(2),o[0],0,0,0), C1,0); \
    KRD(GL,3); GAPB(o[1]=__builtin_amdgcn_mfma_f32_32x32x16_bf16(PAF(2),VFR(6),o[1],0,0,0), C1,4); \
    GAPB(o[0]=__builtin_amdgcn_mfma_f32_32x32x16_bf16(PAF(3),VFR(3),o[0],0,0,0), C1,8); \
    GAPB(o[1]=__builtin_amdgcn_mfma_f32_32x32x16_bf16(PAF(3),VFR(7),o[1],0,0,0), C1,12); \
    }while(0)
  int t=1;
  #undef CMASK
  #define CMASK(P0,P1,t) do{}while(0)
  for(;t+5<NT;t+=2){
    STEP(pB0,pB1,pA0,pA1,t,true,true,true);     WAIT_BAR(2); RESC(); ROT();
    STEP(pA0,pA1,pB0,pB1,t+1,true,true,true);   WAIT_BAR(2); RESC(); ROT();
  }
  #undef CMASK
  #define CMASK(P0,P1,t) do{}while(0)
  #define ENDW(tt) do{ if((tt)+3<NT){WAIT_BAR(2);} else if((tt)+2<NT){WAIT_BAR(1);} else {WAIT_BAR(0);} }while(0)
  for(;t+1<NT;t+=2){
    STEP(pB0,pB1,pA0,pA1,t,(t+3<NT),(t+1<NT),(t+1<NT));       ENDW(t);   RESC(); ROT();
    STEP(pA0,pA1,pB0,pB1,t+1,(t+4<NT),(t+2<NT),(t+2<NT));     ENDW(t+1); RESC(); ROT();
  }
  STEP(pB0,pB1,pA0,pA1,NT-1,false,false,false); RESC();
  { float sacc=pB0[0]+pB0[1]; _Pragma("unroll") for(int r=2;r<16;++r)sacc+=pB0[r]; _Pragma("unroll") for(int r=0;r<16;++r)sacc+=pB1[r]; l_reg+=sacc;
    pw0=(u32x4){PKW(pB0,0),PKW(pB0,2),PKW(pB0,4),PKW(pB0,6)};pw1=(u32x4){PKW(pB0,8),PKW(pB0,10),PKW(pB0,12),PKW(pB0,14)};pw2=(u32x4){PKW(pB1,0),PKW(pB1,2),PKW(pB1,4),PKW(pB1,6)};pw3=(u32x4){PKW(pB1,8),PKW(pB1,10),PKW(pB1,12),PKW(pB1,14)};
    SBAR(); pv(o,vb0+sl_cur,PAF(0),PAF(1),PAF(2),PAF(3)); }
  #undef PKW
  #undef PAF
  #undef VFR
  #undef PIN
  #undef MX3
  #undef GAPA
  #undef GAPB
  #undef EX
  #undef VRD
  #undef KRD
  #undef STEP
  #undef ENDW
  {auto rr=__builtin_amdgcn_permlane32_swap(__float_as_uint(l_reg),__float_as_uint(l_reg),false,false);l_reg=__uint_as_float(rr[0])+__uint_as_float(rr[1]);}
  if(hi==0)wsf[32+r32]=l_reg;asm volatile("s_waitcnt lgkmcnt(0)":::"memory");
  float rli[16];
  #pragma unroll
  for(int r=0;r<16;++r)rli[r]=__builtin_amdgcn_rcpf(wsf[32+crow(r,hi)]);
  bf16*Ow=Ow0+(long)(wid*QBLK)*OP;
  { bf16*stg=(bf16*)(shm+LDS_OST)+wid*2048;
    #pragma unroll
    for(int r=0;r<16;++r){const int orow=crow(r,hi);
      #pragma unroll
      for(int d0=0;d0<2;++d0)stg[orow*64+d0*32+r32]=__float2bfloat16(o[d0][r]*rli[r]);}
    asm volatile("s_waitcnt lgkmcnt(0)":::"memory");
    #pragma unroll
    for(int i=0;i<4;++i){const int row=i*8+(lane>>3),ch=lane&7; const u32x4 v=*(const u32x4*)(stg+row*64+ch*8); ATTN_STORE16(Ow+(long)row*OP+ch*8,v);} }
  asm volatile("s_waitcnt lgkmcnt(0)\n\ts_barrier":::"memory");
  #undef DMA_K
  #undef DMA_V
  #undef CMASK
  #undef START
  #undef RESC
  #undef ROT
}
constexpr int ATTN_LDS_BYTES=LDS_BYTES;
#undef SBAR
#undef WAIT_BAR
}
#ifndef REP_SYNC
#define REP_SYNC 1
#endif
#ifndef REP_PRO
#define REP_PRO 1
#endif
#ifndef REP_S2
#define REP_S2 1
#endif
#ifndef REP_NORM
#define REP_NORM 1
#endif
#ifndef REP_G1
#define REP_G1 1
#endif
#ifndef REP_S1
#define REP_S1 1
#endif
#ifndef REP_S3
#define REP_S3 1
#endif
#ifndef REP_ATT
#define REP_ATT 1
#endif
#ifndef REP_POST0
#define REP_POST0 1
#endif
#define LAS __attribute__((address_space(3)))
typedef unsigned short u16;
typedef float f32x4 __attribute__((ext_vector_type(4)));
typedef float f32x2 __attribute__((ext_vector_type(2)));
typedef unsigned u32x4 __attribute__((ext_vector_type(4)));
typedef unsigned u32x2 __attribute__((ext_vector_type(2)));

constexpr int M_LAT = 32768, M_CTXR = 512, M_ALL = 33280, DM_ = 1024, NPAD = 2560, IN_W = 2336, FF_ = 4096;
constexpr int C_RQ = 0, C_RK = 128, C_RV = 256, C_RG = 512, C_GQ = 768, C_GK = 896, C_GV = 1024, C_GG = 1280, C_AQ = 1536, C_AK = 2048, C_AV = 2176, C_Z = 2304;
constexpr int SRC_GA = 1536;
constexpr float NEPS = 1e-6f;
constexpr int N_ITEM1 = 8320;
constexpr int N_ITEM3 = 4160;
constexpr size_t MiB = 1u << 20, KiB = 1u << 10;
constexpr size_t WS_MOD = 0;
constexpr size_t WS_BAR = 256 * KiB, WS_BAR_BYTES = 16 * KiB;
constexpr size_t WS_TAB = 512 * KiB;
constexpr size_t WS_CTXRES = 1 * MiB;
constexpr size_t WS_DEC = 3 * MiB;
constexpr size_t WS_W = 5 * MiB, W_LAYER = 23 * MiB, W_IN = 0, W_OUT = 5 * MiB, W_1 = 7 * MiB, W_2 = 15 * MiB;
constexpr size_t WS_XNY = 51 * MiB;
constexpr size_t WS_P = 116 * MiB;
constexpr size_t WS_QB = WS_P + (size_t)M_ALL * NPAD * 2;
constexpr size_t WS_KB = WS_QB + (size_t)M_ALL * 512 * 2;
constexpr size_t WS_VB = WS_KB + (size_t)M_ALL * 128 * 2;
constexpr size_t WS_G = WS_VB + (size_t)M_ALL * 128 * 2;
constexpr size_t WS_AS = WS_G + (size_t)M_ALL * 256 * 4;
constexpr size_t WS_END1 = WS_AS + (size_t)N_ITEM1 * 2048 * 4;
constexpr size_t WS_H = WS_P;
constexpr size_t WS_END2 = WS_H + (size_t)M_ALL * FF_ * 2;
constexpr size_t WS_YA = 430 * MiB;
static_assert(WS_YA >= WS_END1 && WS_YA >= WS_END2 && WS_YA + (size_t)M_ALL * 1024 * 2 <= 512 * MiB, "YA");
static_assert(WS_END1 <= 512 * MiB && WS_END2 <= 512 * MiB, "d_ws map");
constexpr int LDS_BYTES = 147456;

__device__ __forceinline__ float bf2f(unsigned h) { return __uint_as_float(h << 16); }
__device__ __forceinline__ float bflo(unsigned w) { return __uint_as_float(w << 16); }
__device__ __forceinline__ float bfhi(unsigned w) { return __uint_as_float(w & 0xffff0000u); }
__device__ __forceinline__ unsigned pk2(float lo, float hi) { return pg8::cvt_pk_bf16(lo, hi); }
template <int X> __device__ __forceinline__ float xor_lane(float v) { static_assert(X >= 1 && X <= 16, "xor_lane"); return __int_as_float(__builtin_amdgcn_ds_swizzle(__float_as_int(v), (X << 10) | 0x1F)); }
__device__ __forceinline__ float sum_halves(float v) { auto rr = __builtin_amdgcn_permlane32_swap(__float_as_uint(v), __float_as_uint(v), false, false); return __uint_as_float(rr[0]) + __uint_as_float(rr[1]); }
__device__ __forceinline__ float other_half(float v) { auto rr = __builtin_amdgcn_permlane32_swap(__float_as_uint(v), __float_as_uint(v), false, false); return (rr[0] == __float_as_uint(v)) ? __uint_as_float(rr[1]) : __uint_as_float(rr[0]); }
__device__ __forceinline__ float wave_sum(float v) {
    v += xor_lane<1>(v); v += xor_lane<2>(v); v += xor_lane<4>(v); v += xor_lane<8>(v); v += xor_lane<16>(v);
    return sum_halves(v);
}
__device__ __forceinline__ float logsig(float z) { return fminf(z, 0.f) - __logf(1.f + __expf(-fabsf(z))); }
#define LDS_WAIT() asm volatile("s_waitcnt lgkmcnt(0)" ::: "memory")
__device__ __forceinline__ void st8_wt(void* p, u32x2 v) { asm volatile("global_store_dwordx2 %0, %1, off sc1" :: "v"(p), "v"(v) : "memory"); }
__device__ __forceinline__ void st16f_wt(void* p, f32x4 v) { asm volatile("global_store_dwordx4 %0, %1, off sc1\n\ts_nop 1" :: "v"(p), "v"(v) : "memory"); }

__device__ __forceinline__ void p0_transpose_item(const float* W, int K, int N, u16* WT, LAS float* scr, int item, int lane, int row_off = 0) {
    const int nblk = N / 32, kb = item / nblk, nb = item % nblk, k0 = 64 * kb, n0 = 32 * nb;
#pragma unroll 8
    for (int i = 0; i < 32; ++i) { const int kk = 2 * i + (lane >> 5); scr[kk * 33 + (lane & 31)] = W[(size_t)(k0 + kk) * N + n0 + (lane & 31)]; }
    LDS_WAIT(); asm volatile("" ::: "memory");
    const int c = lane & 7;
#pragma unroll
    for (int j = 0; j < 4; ++j) { const int n = (lane >> 3) + 8 * j; const LAS float* s = scr + (8 * c) * 33 + n;
        u32x4 o; o.x = pk2(s[0 * 33], s[1 * 33]); o.y = pk2(s[2 * 33], s[3 * 33]); o.z = pk2(s[4 * 33], s[5 * 33]); o.w = pk2(s[6 * 33], s[7 * 33]);
        *(u32x4*)(WT + (size_t)(n0 + n + row_off) * K + k0 + 8 * c) = o; }
    LDS_WAIT(); asm volatile("" ::: "memory");
}

#define XB_TMO      128
#define XB_XCNT(j)  (256  + 64 * (j))
#define XB_XSUB(j)  (1280 + 64 * (j))
#define XB_XGEN(j)  (2304 + 64 * (j))
#define XB_TOP      3328
#define XB_TOPGEN   3392
#define XCD_BAR_WORDS 3456
#define XB_SPIN_CAP (1u << 18)

__device__ __forceinline__ unsigned xb_ld(unsigned* p)              { return __hip_atomic_load(p, __ATOMIC_RELAXED, __HIP_MEMORY_SCOPE_AGENT); }
__device__ __forceinline__ unsigned xb_add(unsigned* p, unsigned v) { return __hip_atomic_fetch_add(p, v, __ATOMIC_RELAXED, __HIP_MEMORY_SCOPE_AGENT); }
__device__ __forceinline__ unsigned xb_xcc_id() { return (unsigned)__builtin_amdgcn_s_getreg((3 << 11) | 20) & 0xFu; }
#define XB_SPIN(cond, bar) do { unsigned _sp = 0; while (cond) { __builtin_amdgcn_s_sleep(1); \
    if ((++_sp & 255u) == 0u) { if (xb_ld(&(bar)[XB_TMO])) break; if (_sp > XB_SPIN_CAP) { atomicAdd(&(bar)[XB_TMO], 1u); break; } } } } while (0)

struct XcdBarrier {
    unsigned* bar; unsigned x;
    volatile LAS unsigned* st;
};

__device__ __forceinline__ XcdBarrier xcd_barrier_post(unsigned* bar, volatile LAS unsigned* st) {
    XcdBarrier b; b.bar = bar; b.x = xb_xcc_id(); b.st = st;
    if (threadIdx.x == 0) (void)xb_add(&bar[XB_XCNT(b.x)], 1u);
    return b;
}
__device__ __forceinline__ void xcd_barrier_complete(unsigned* bar, unsigned x, unsigned& nloc, unsigned& nx) {
    const unsigned G = gridDim.x * gridDim.y * gridDim.z;
    unsigned sum, cnt, mine, sp = 0u;
    for (;;) {
        sum = 0u; cnt = 0u; mine = 0u;
#pragma unroll
        for (unsigned j = 0; j < 16; ++j) { const unsigned c = xb_ld(&bar[XB_XCNT(j)]); sum += c; cnt += (c > 0u) ? 1u : 0u; mine = (j == x) ? c : mine; }
        if (sum == G) break;
        __builtin_amdgcn_s_sleep(1);
        if ((++sp & 255u) == 0u) { if (xb_ld(&bar[XB_TMO])) break; if (sp > XB_SPIN_CAP) { atomicAdd(&bar[XB_TMO], 1u); break; } }
    }
    nloc = mine > 0u ? mine : 1u; nx = cnt > 0u ? cnt : 1u;
}

__device__ __forceinline__ void xcd_barrier(const XcdBarrier& b) {
    asm volatile("s_waitcnt vmcnt(0)" ::: "memory");
    __syncthreads();
    if (threadIdx.x == 0) {
        unsigned* bar = b.bar;
        __builtin_amdgcn_s_waitcnt(0);
        unsigned nloc = b.st[0], nx = b.st[1];
        if (nloc == 0u) { xcd_barrier_complete(bar, b.x, nloc, nx); b.st[0] = nloc; b.st[1] = nx; }
        const unsigned old = xb_add(&bar[XB_XSUB(b.x)], 1u);
        const unsigned gen = old / nloc;
        if (old + 1u == (gen + 1u) * nloc) {
            __builtin_amdgcn_fence(__ATOMIC_RELEASE, "agent");
            asm volatile("s_waitcnt vmcnt(0)" ::: "memory");
            const unsigned og = xb_add(&bar[XB_TOP], 1u);
            const unsigned tg = og / nx;
            if (og + 1u == (tg + 1u) * nx) xb_add(&bar[XB_TOPGEN], 1u);
            else XB_SPIN(xb_ld(&bar[XB_TOPGEN]) == tg, bar);
            __builtin_amdgcn_fence(__ATOMIC_ACQUIRE, "agent");
            xb_add(&bar[XB_XGEN(b.x)], 1u);
            asm volatile("s_waitcnt vmcnt(0)" ::: "memory");
        } else {
            XB_SPIN(xb_ld(&bar[XB_XGEN(b.x)]) == gen, bar);
            __builtin_amdgcn_fence(__ATOMIC_ACQUIRE, "agent");
            asm volatile("s_waitcnt vmcnt(0)" ::: "memory");
        }
    }
    __syncthreads();
}


typedef short mbf16x8 __attribute__((ext_vector_type(8)));
template <int MODE> __device__ __forceinline__ void mini_gemm_ctx(const u16* A, const u16* Bt, int N, int K, u16* Ob, int ldo, int act, const float* gate, LAS unsigned char* L, int vb, int G_, int wave, int lane) {
    const int ncg = (N + 63) >> 6, ntiles = 8 * ncg, kslice = K >> 3;
    const int fr = lane & 15, fq = lane >> 4;
    LAS f32x4* red = (LAS f32x4*)L;
    for (int tile = vb; tile < ntiles; tile += G_) {
        const int r0 = (tile & 7) * 64, n0 = (tile >> 3) * 64;
        f32x4 acc[4][4];
#pragma unroll
        for (int a = 0; a < 4; ++a)
#pragma unroll
            for (int c = 0; c < 4; ++c) acc[a][c] = (f32x4){0.f, 0.f, 0.f, 0.f};
        const u16* ap = A + (size_t)(r0 + fr) * K + wave * kslice + 8 * fq; const u16* bp = Bt + (size_t)(n0 + fr) * K + wave * kslice + 8 * fq;
#pragma unroll 1
        for (int kc = 0; kc < kslice; kc += 64) {
            mbf16x8 fa[4][2], fb[4][2];
#pragma unroll
            for (int s = 0; s < 2; ++s)
#pragma unroll
                for (int q = 0; q < 4; ++q) { fa[q][s] = *(const mbf16x8*)(ap + (size_t)(16 * q) * K + kc + 32 * s); fb[q][s] = *(const mbf16x8*)(bp + (size_t)(16 * q) * K + kc + 32 * s); }
#pragma unroll
            for (int s = 0; s < 2; ++s)
#pragma unroll
                for (int mi = 0; mi < 4; ++mi)
#pragma unroll
                    for (int ni = 0; ni < 4; ++ni) acc[mi][ni] = __builtin_amdgcn_mfma_f32_16x16x32_bf16(fa[mi][s], fb[ni][s], acc[mi][ni], 0, 0, 0);
        }
#pragma unroll
        for (int ti = 0; ti < 16; ++ti) red[(wave * 16 + ti) * 64 + lane] = acc[ti >> 2][ti & 3];
        __syncthreads();
#pragma unroll
        for (int q = 0; q < 2; ++q) { const int ti = 2 * wave + q, mi = ti >> 2, ni = ti & 3;
            f32x4 s = red[ti * 64 + lane];
#pragma unroll
            for (int w = 1; w < 8; ++w) s += red[(w * 16 + ti) * 64 + lane];
            const int c = n0 + 16 * ni + fr;
            if (c < N) {
                const float gv = (MODE == 1) ? gate[c] : 1.f;
#pragma unroll
                for (int i = 0; i < 4; ++i) { const int r = r0 + 16 * mi + 4 * fq + i; float v = s[i] * gv;
                    if (act) { v = fmaxf(v, 0.f); v = v * v; } Ob[(size_t)r * ldo + c] = (u16)(pk2(v, 0.f) & 0xffffu); }
            }
        }
        __syncthreads();
    }
}

struct Args { const float* in[17]; float* out; unsigned char* ws; };

__global__ void __launch_bounds__(512, 2) fwd_megakernel(Args args) {
    extern __shared__ __attribute__((aligned(16))) unsigned char lds[];
    cg::grid_group grid = cg::this_grid();
    LAS unsigned char* L = (LAS unsigned char*)lds;
    const int G_ = gridDim.x, bx = blockIdx.x, NGW = G_ * 8;
#define PHASE_IDS int tid_l = threadIdx.x; asm volatile("" : "+v"(tid_l)); const int tid = tid_l, lane = tid & 63, wave = __builtin_amdgcn_readfirstlane(tid >> 6), gw = bx * 8 + wave; (void)gw; (void)lane;
    const int vcu = (G_ % 8 == 0) ? (bx % 8) * (G_ / 8) + bx / 8 : bx;
#define PHASE_PTRS \
    const __attribute__((address_space(4))) Args* ka_ = (const __attribute__((address_space(4))) Args*)__builtin_amdgcn_kernarg_segment_ptr(); asm volatile("" : "+s"(ka_)); \
    unsigned char* ws = ka_->ws; \
    const float* in_x = ka_->in[0]; const float* in_c = ka_->in[1]; const float* in_ctx = ka_->in[2]; const float* in_cctx = ka_->in[3]; \
    const float* in_modw = ka_->in[4]; const float* in_modb = ka_->in[5]; const float* in_ang = ka_->in[6]; const float* in_mng = ka_->in[7]; \
    const float* in_win = ka_->in[8]; const float* in_wout = ka_->in[9]; const float* in_retl = ka_->in[10]; const float* in_ggw = ka_->in[11]; \
    const float* in_ggb = ka_->in[12]; const float* in_qkg = ka_->in[13]; const float* in_w1 = ka_->in[14]; const float* in_w2 = ka_->in[15]; const float* in_fng = ka_->in[16]; \
    float* xlat = ka_->out; float* xctx = (float*)(ws + WS_CTXRES); \
    float* MOD = (float*)(ws + WS_MOD); float* DEC = (float*)(ws + WS_DEC); \
    u16* XNY = (u16*)(ws + WS_XNY); u16* P = (u16*)(ws + WS_P); u16* QB = (u16*)(ws + WS_QB); u16* KB = (u16*)(ws + WS_KB); u16* VB = (u16*)(ws + WS_VB); \
    float* GT = (float*)(ws + WS_G); float* AS = (float*)(ws + WS_AS); u16* HB = (u16*)(ws + WS_H); \
    (void)in_x; (void)in_c; (void)in_ctx; (void)in_cctx; (void)in_modw; (void)in_modb; (void)in_ang; (void)in_mng; (void)in_win; (void)in_wout; (void)in_retl; (void)in_ggw; (void)in_ggb; (void)in_qkg; (void)in_w1; (void)in_w2; (void)in_fng; \
    (void)xlat; (void)xctx; (void)MOD; (void)DEC; (void)XNY; (void)P; (void)QB; (void)KB; (void)VB; (void)GT; (void)AS; (void)HB;
    volatile LAS unsigned* MISC = (volatile LAS unsigned*)(L + LDS_BYTES - 256);
    if (threadIdx.x < 16) MISC[threadIdx.x] = 0u;
    __syncthreads();
    XcdBarrier bar = xcd_barrier_post((unsigned*)(args.ws + WS_BAR), MISC + 8);
    for (int rep_ = 0; rep_ < REP_PRO; ++rep_) {
    PHASE_IDS
    PHASE_PTRS
    if (bx < 192) {
        LAS float* sl = (LAS float*)L;
        for (int i = tid; i < 3072; i += 512) { const int cond = i >> 10, k = i & 1023; const float cv = cond < 2 ? in_c[cond * 1024 + k] : in_cctx[k]; sl[i] = cv / (1.f + expf(-cv)); }
        __syncthreads();
        const int layer = bx / 96, cn = tid & 63, col = (bx % 96) * 64 + cn, kg = tid >> 6;
        const float* wp = in_modw + (size_t)layer * 1024 * 6144 + (size_t)(kg * 128) * 6144 + col;
        float a0 = 0.f, a1 = 0.f, a2 = 0.f;
#pragma unroll 16
        for (int q = 0; q < 128; ++q) { const float w = wp[(size_t)q * 6144]; const int k = kg * 128 + q; a0 += sl[k] * w; a1 += sl[1024 + k] * w; a2 += sl[2048 + k] * w; }
        LAS float* red = sl + 3072;
        red[(kg * 3 + 0) * 64 + cn] = a0; red[(kg * 3 + 1) * 64 + cn] = a1; red[(kg * 3 + 2) * 64 + cn] = a2;
        __syncthreads();
        if (tid < 192) { const int cond = tid >> 6, c2 = tid & 63; float s = 0.f;
#pragma unroll
            for (int g = 0; g < 8; ++g) s += red[(g * 3 + cond) * 64 + c2];
            const int cc = (bx % 96) * 64 + c2; MOD[(size_t)(layer * 3 + cond) * 6144 + cc] = s + in_modb[layer * 6144 + cc]; }
        __syncthreads();
    }
    for (int i = bx * 512 + tid; i < 4096; i += G_ * 512) {
        const int pos = i >> 4, j = i & 15; const float invf = exp2f(-(float)j * 0.8304820237218406f); float sn, cs; sincosf((float)pos * invf, &sn, &cs);
        ((f32x2*)(ws + WS_TAB))[i] = (f32x2){cs, sn}; }
    {
        LAS float* scr = (LAS float*)(L + wave * 16384);
        for (int it = gw; it < 11552; it += NGW) {
            const int l = it / 5776; int r = it % 5776; unsigned char* wl = ws + WS_W + (size_t)l * W_LAYER;
            if (r < 1168) { const int nb = r % 73; if (nb != 48) p0_transpose_item(in_win + (size_t)l * 1024 * IN_W, 1024, IN_W, (u16*)(wl + W_IN), scr, r, lane, nb > 48 ? -32 : 0); continue; } r -= 1168;
            if (r < 512) { p0_transpose_item(in_wout + (size_t)l * 1024 * 1024, 1024, 1024, (u16*)(wl + W_OUT), scr, r, lane); continue; } r -= 512;
            if (r < 2048) { p0_transpose_item(in_w1 + (size_t)l * 1024 * 4096, 1024, 4096, (u16*)(wl + W_1), scr, r, lane); continue; } r -= 2048;
            p0_transpose_item(in_w2 + (size_t)l * 4096 * 1024, 4096, 1024, (u16*)(wl + W_2), scr, r, lane);
        }
        for (int idx = bx * 512 + tid; idx < 2 * 256 * 128; idx += G_ * 512) {
            const int l = idx >> 15, rem = idx & 32767, n = rem >> 7, k0 = (rem & 127) * 8, dirn = n >> 7, np = n & 127;
            const float* gwp = in_ggw + (size_t)l * 4096 + dirn * 2048 + np; const float* wp = in_win + (size_t)l * 1024 * IN_W + (size_t)k0 * IN_W + SRC_GA + dirn * 16;
            float o[8];
#pragma unroll
            for (int q = 0; q < 8; ++q) { float s = 0.f;
#pragma unroll
                for (int i = 0; i < 16; ++i) s += wp[(size_t)q * IN_W + i] * gwp[i * 128];
                o[q] = s; }
            u32x4 w; w.x = pk2(o[0], o[1]); w.y = pk2(o[2], o[3]); w.z = pk2(o[4], o[5]); w.w = pk2(o[6], o[7]);
            *(u32x4*)((u16*)(ws + WS_W + (size_t)l * W_LAYER + W_IN) + (size_t)(C_Z + n) * 1024 + k0) = w; }
    }
    __syncthreads();
    }
    if (args.ws == nullptr) grid.sync();
    xcd_barrier(bar);

    for (int step = 0; step < 20; ++step) {
        const int layer = step / 10, ph = step % 10;
        PHASE_IDS
        PHASE_PTRS
        unsigned char* wl = ws + WS_W + (size_t)layer * W_LAYER;
        const float* modl = MOD + (size_t)layer * 3 * 6144;
        if (ph == 0 || ph == 7) {
            for (int rep_ = 0; rep_ < REP_NORM; ++rep_) {

            const bool from_in = (layer == 0) || (ph == 0);
            const float* sl_ = from_in ? in_x : xlat; const float* sc_ = from_in ? in_ctx : xctx;
            const u16* ya = (layer == 0 && ph == 0) ? nullptr : (const u16*)(ws + WS_YA);
            const u16* yb = (layer == 1 && ph == 0) ? XNY : nullptr;
            const bool wx = (layer == 1 && ph == 0);
            const float* gvec = (ph == 0 ? in_ang : in_mng) + layer * 1024;
            const int sh_off = (ph == 0) ? 0 : 3072, sc_off = sh_off + 1024;
            const int Mn = (layer == 1 && ph == 7) ? M_LAT : M_ALL;
            for (int m = gw; m < Mn; m += NGW) {
                const float* src = (m < M_LAT) ? sl_ + (size_t)m * 1024 : sc_ + (size_t)(m - M_LAT) * 1024;
                const int cond = (m < M_LAT) ? (m >> 14) : 2;
                f32x4 v[4]; float ss = 0.f;
#pragma unroll
                for (int j = 0; j < 4; ++j) v[j] = *(const f32x4*)(src + 4 * lane + 256 * j);
                if (ya) {
#pragma unroll
                    for (int j = 0; j < 4; ++j) { const u32x2 y = *(const u32x2*)(ya + (size_t)m * 1024 + 4 * lane + 256 * j); v[j] = v[j] + (f32x4){bflo(y.x), bfhi(y.x), bflo(y.y), bfhi(y.y)}; } }
                if (yb) {
#pragma unroll
                    for (int j = 0; j < 4; ++j) { const u32x2 y = *(const u32x2*)(yb + (size_t)m * 1024 + 4 * lane + 256 * j); v[j] = v[j] + (f32x4){bflo(y.x), bfhi(y.x), bflo(y.y), bfhi(y.y)}; } }
#pragma unroll
                for (int j = 0; j < 4; ++j) ss += (v[j].x * v[j].x + v[j].y * v[j].y) + (v[j].z * v[j].z + v[j].w * v[j].w);
                if (wx) { float* dst = (m < M_LAT) ? xlat + (size_t)m * 1024 : xctx + (size_t)(m - M_LAT) * 1024;
#pragma unroll
                    for (int j = 0; j < 4; ++j) st16f_wt(dst + 4 * lane + 256 * j, v[j]); }
                const float rstd = 1.0f / sqrtf(wave_sum(ss) * (1.f / 1024.f) + NEPS);
                const float* mc = modl + cond * 6144;
#pragma unroll
                for (int j = 0; j < 4; ++j) { const int col = 4 * lane + 256 * j;
                    const f32x4 gv = *(const f32x4*)(gvec + col), sc = *(const f32x4*)(mc + sc_off + col), sh = *(const f32x4*)(mc + sh_off + col);
                    const f32x4 hv = (v[j] * rstd) * gv * (sc + 1.0f) + sh;
                    u32x2 o; o.x = pk2(hv.x, hv.y); o.y = pk2(hv.z, hv.w); st8_wt(XNY + (size_t)m * 1024 + col, o); }
            }
            __syncthreads(); }
        } else if (ph == 1 || ph == 8 || ph == 6 || ph == 9) {
            for (int rep_ = 0; rep_ < REP_G1; ++rep_) {

            const u16* Aop = (ph == 9) ? HB : XNY; const int Kop = (ph == 9) ? FF_ : 1024;
            const u16* Bop = (const u16*)(wl + (ph == 1 ? W_IN : ph == 8 ? W_1 : ph == 6 ? W_OUT : W_2));
            const int Nmain = (ph == 1) ? NPAD : (ph == 8 ? FF_ : 1024), Nctx = Nmain;
            u16* Oop = (ph == 1) ? P : (ph == 8 ? HB : (ph == 6 ? (u16*)(ws + WS_YA) : XNY));
            const float* gate = (ph == 6) ? modl + 2048 : (ph == 9 ? modl + 5120 : (const float*)nullptr);
            if (ph == 1 || layer == 0) {
                if (gate) mini_gemm_ctx<1>(Aop + (size_t)M_LAT * Kop, Bop, Nctx, Kop, Oop + (size_t)M_LAT * Nmain, Nmain, 0, gate + 2 * 6144, L, vcu, G_, wave, lane);
                else mini_gemm_ctx<0>(Aop + (size_t)M_LAT * Kop, Bop, Nctx, Kop, Oop + (size_t)M_LAT * Nmain, Nmain, ph == 8 ? 1 : 0, nullptr, L, vcu, G_, wave, lane);
            }
            pg8::Gemm g{Aop, Bop, M_LAT, Nmain, Kop};
            pg8::StaticOrder S; S.init(g.M, g.N, G_, bx);
            pg8::EpiStoreBf16 E{Oop, Nmain, ph == 8 ? 1 : 0, gate};
            pg8::gemm_phase<pg8::EpiStoreBf16, pg8::StaticOrder, true, true>(L, g, S, E);
            __syncthreads(); }
        } else if (ph == 2) {
            LAS float* gw_s = (LAS float*)L; LAS float* gb_s = gw_s + 4096; LAS float* qg_s = gb_s + 256;
            if (tid < 256) gb_s[tid] = in_ggb[layer * 256 + tid];
            if (tid < 128) qg_s[tid] = in_qkg[layer * 128 + tid];
            __syncthreads();
            const float C2 = 0.125f * 1.4426950408889634f, KSC = 0.17677669529663687f;
            const f32x2* TAB = (const f32x2*)(ws + WS_TAB);
            const int r_head = lane >> 4, r_pi = lane & 15, r_j = r_pi & 7; const bool r_isrow = r_pi < 8; const int r_da = r_isrow ? r_j : 16 + r_j, r_db = r_da + 8;
            const int a_sub = lane & 7, a_hh = lane >> 3; const bool a_isrow = a_sub < 4; const int a_jb = a_isrow ? 4 * a_sub : 4 * a_sub - 16, a_da = a_isrow ? 4 * a_sub : 4 * a_sub + 16, a_db = a_da + 16;
            struct PostRaw { unsigned rq0, rq1, rk0, rk1; u32x2 gz; u32x2 aq0, aq1, ak0, ak1; u32x4 av; f32x2 t2; f32x4 t0, t1; };
#define POST_LOAD(R, mm) do { const u16* rp_ = P + (size_t)(mm) * NPAD; const int t_ = (mm) & 16383; const bool lat_ = (mm) < M_LAT; \
                R.rq0 = rp_[C_RQ + r_head * 32 + r_da]; R.rq1 = rp_[C_RQ + r_head * 32 + r_db]; R.rk0 = rp_[C_RK + r_head * 32 + r_da]; R.rk1 = rp_[C_RK + r_head * 32 + r_db]; \
                R.gz = *(const u32x2*)(rp_ + C_Z + 4 * lane); \
                R.aq0 = (u32x2){0u, 0u}; R.aq1 = (u32x2){0u, 0u}; \
                R.ak0 = *(const u32x2*)(rp_ + C_AK + (a_hh & 1) * 64 + a_da); R.ak1 = *(const u32x2*)(rp_ + C_AK + (a_hh & 1) * 64 + a_db); \
                R.av = *(const u32x4*)(rp_ + C_AV + (lane & 15) * 8); \
                R.t2 = (f32x2){1.f, 0.f}; R.t0 = (f32x4){1.f, 0.f, 1.f, 0.f}; R.t1 = (f32x4){1.f, 0.f, 1.f, 0.f}; \
                if (lat_) { R.t2 = TAB[(r_isrow ? (t_ >> 6) : (t_ & 63)) * 16 + 2 * r_j]; const f32x4* tp_ = (const f32x4*)(TAB + (a_isrow ? (t_ >> 6) : (t_ & 63)) * 16 + a_jb); R.t0 = tp_[0]; R.t1 = tp_[1]; } } while (0)
            PostRaw cur{};
            POST_LOAD(cur, gw);
            for (int m = gw; m < M_ALL; m += NGW) {
                PostRaw nxt = cur; const int mn = m + NGW;
                if (mn < M_ALL) POST_LOAD(nxt, mn);
                u16* rowp = P + (size_t)m * NPAD;
                const int kvb = m < M_LAT ? (m >> 14) : ((m - M_LAT) >> 8), kvt = m < M_LAT ? ((m & 16383) >> 6) : 256 + (((m - M_LAT) & 255) >> 6), kvr = m & 63;
                const size_t kvbase = ((size_t)(kvb * 2) * 260 + kvt) * 4096;
                {   const float cs = cur.t2.x, sn = cur.t2.y;
                    const float qa = bf2f(cur.rq0), qb_ = bf2f(cur.rq1), ka = bf2f(cur.rk0), kb_ = bf2f(cur.rk1);
                    const unsigned qo = pk2(qa * cs - qb_ * sn, qa * sn + qb_ * cs), ko = pk2((ka * cs - kb_ * sn) * KSC, (ka * sn + kb_ * cs) * KSC);
                    u16* qs = rowp + C_RQ + r_head * 32; u16* ks_ = rowp + C_RK + r_head * 32;
                    qs[r_da] = (u16)(qo & 0xffffu); qs[r_db] = (u16)(qo >> 16); ks_[r_da] = (u16)(ko & 0xffffu); ks_[r_db] = (u16)(ko >> 16);
                }
                {   const f32x4 bv = *(const LAS f32x4*)(gb_s + 4 * lane);
                    f32x4 g; g.x = logsig(bflo(cur.gz.x) + bv.x) * (1.f / 16.f); g.y = logsig(bfhi(cur.gz.x) + bv.y) * (1.f / 16.f); g.z = logsig(bflo(cur.gz.y) + bv.z) * (1.f / 16.f); g.w = logsig(bfhi(cur.gz.y) + bv.w) * (1.f / 16.f);
                    *(f32x4*)(GT + (size_t)m * 256 + 4 * lane) = g; }
                {   const float cs[4] = {cur.t0.x, cur.t0.z, cur.t1.x, cur.t1.z}, sn[4] = {cur.t0.y, cur.t0.w, cur.t1.y, cur.t1.w};
#pragma unroll
                    for (int pass = 1; pass < 2; ++pass) {
                        const int hd = pass == 0 ? a_hh : (a_hh & 1);
                        const u32x2 wa = pass == 0 ? cur.aq0 : cur.ak0, wb = pass == 0 ? cur.aq1 : cur.ak1;
                        float xa[4] = {bflo(wa.x), bfhi(wa.x), bflo(wa.y), bfhi(wa.y)}, xb[4] = {bflo(wb.x), bfhi(wb.x), bflo(wb.y), bfhi(wb.y)};
                        float ss = 0.f;
#pragma unroll
                        for (int e = 0; e < 4; ++e) ss += xa[e] * xa[e] + xb[e] * xb[e];
                        ss += xor_lane<1>(ss); ss += xor_lane<2>(ss); ss += xor_lane<4>(ss);
                        const float rstd = rsqrtf(ss * (1.f / 64.f) + NEPS); const float osc = pass == 0 ? C2 : 1.f;
                        float oa[4], ob[4];
#pragma unroll
                        for (int e = 0; e < 4; ++e) { const float ya = xa[e] * rstd * qg_s[pass * 64 + a_da + e], yb = xb[e] * rstd * qg_s[pass * 64 + a_db + e];
                            oa[e] = (ya * cs[e] - yb * sn[e]) * osc; ob[e] = (ya * sn[e] + yb * cs[e]) * osc; }
                        u32x2 pa, pb; pa.x = pk2(oa[0], oa[1]); pa.y = pk2(oa[2], oa[3]); pb.x = pk2(ob[0], ob[1]); pb.y = pk2(ob[2], ob[3]);
                        if (pass == 0) { u16* dp = QB + (size_t)m * 512 + hd * 64; *(u32x2*)(dp + a_da) = pa; *(u32x2*)(dp + a_db) = pb; }
                        else if (lane < 16) { u16* dp = KB + kvbase + (size_t)hd * (260 * 4096) + kvr * 8;
                            *(u32x2*)(dp + (a_da >> 3) * 512 + (a_da & 7)) = pa; *(u32x2*)(dp + (a_db >> 3) * 512 + (a_db & 7)) = pb; }
                    }
                    if (lane < 16) { const int cc = (lane & 7) * 8, vw_ = (cc >> 5) * 4 + (kvr >> 4), vl_ = (kvr & 15) * 4 + ((cc & 31) >> 3);
                        *(u32x4*)(VB + kvbase + (size_t)(lane >> 3) * (260 * 4096) + (vw_ * 64 + vl_) * 8) = cur.av; }
                }
                cur = nxt;
            }
#undef POST_LOAD
        } else if (ph == 3) {
            for (int rep_ = 0; rep_ < REP_S1; ++rep_) {

            LAS unsigned char* Lw = L + wave * 18048;
            LAS float* Bc = (LAS float*)Lw; LAS u16* KT = (LAS u16*)Lw;
            LAS u16* VT = (LAS u16*)(Lw + 8704); LAS float* tot = (LAS float*)(Lw + 8704 + 9216);
            const int nn = lane & 15, kk = lane >> 4;
            for (int item = gw; item < N_ITEM1; item += NGW) {
                const int cidx = item % 260, t = item / 260, h = t & 3, b = (t >> 2) & 1, dir = (t >> 3) & 1, grp = t >> 4;
                const int row0 = cidx < 4 ? M_LAT + b * 256 + cidx * 64 : b * 16384 + (cidx - 4) * 64;
                const u16* Pr = P + (size_t)(row0 + lane) * NPAD;
                const int kcol = (grp ? C_GK : C_RK) + h * 32, vcol = (grp ? C_GV : C_RV) + h * 64;
                u32x4 kr[4], vr[8];
#pragma unroll
                for (int q = 0; q < 4; ++q) kr[q] = *(const u32x4*)(Pr + kcol + 8 * q);
#pragma unroll
                for (int q = 0; q < 8; ++q) vr[q] = *(const u32x4*)(Pr + vcol + 8 * q);
                float lg = 0.f;
                if (grp == 0) lg = logsig(in_retl[layer * 8 + dir * 4 + h]);
                else {
                    const int d = lane & 31, half = lane >> 5; float* gp = GT + (size_t)row0 * 256 + dir * 128 + h * 32 + d; float run = 0.f;
                    float gv[32];
#pragma unroll
                    for (int i = 0; i < 32; ++i) gv[i] = gp[(size_t)(32 * half + i) * 256];
                    if (dir == 0) {
#pragma unroll
                        for (int i = 0; i < 32; ++i) { run += gv[i]; gv[i] = run; }
                    } else {
#pragma unroll
                        for (int i = 31; i >= 0; --i) { run += gv[i]; gv[i] = run; }
                    }
                    const float other = other_half(run);
                    const float addv = (dir == 0) ? (half == 1 ? other : 0.f) : (half == 0 ? other : 0.f);
#pragma unroll
                    for (int i = 0; i < 32; ++i) { const float full = gv[i] + addv; Bc[(32 * half + i) * 34 + d] = full; gp[(size_t)(32 * half + i) * 256] = full; }
                    if (half == 0) tot[d] = run + other;
                    LDS_WAIT(); asm volatile("" ::: "memory");
                }
                float fac[32];
                if (grp == 0) { const float f = __expf((dir == 0 ? (float)(63 - lane) : (float)lane) * lg);
#pragma unroll
                    for (int d = 0; d < 32; ++d) fac[d] = f;
                } else {
#pragma unroll
                    for (int q = 0; q < 16; ++q) { const f32x2 bc = *(const LAS f32x2*)(Bc + lane * 34 + 2 * q); const f32x2 tt = *(const LAS f32x2*)(tot + 2 * q);
                        fac[2 * q] = __expf(tt.x - bc.x); fac[2 * q + 1] = __expf(tt.y - bc.y); }
                    LDS_WAIT(); asm volatile("" ::: "memory");
                }
#pragma unroll
                for (int q = 0; q < 4; ++q) { const unsigned w[4] = {kr[q].x, kr[q].y, kr[q].z, kr[q].w};
#pragma unroll
                    for (int c = 0; c < 4; ++c) { const int d = 8 * q + 2 * c; const unsigned pk = pk2(bflo(w[c]) * fac[d], bfhi(w[c]) * fac[d + 1]);
                        KT[d * 72 + lane] = (u16)(pk & 0xffffu); KT[(d + 1) * 72 + lane] = (u16)(pk >> 16); } }
#pragma unroll
                for (int q = 0; q < 8; ++q) { const unsigned w[4] = {vr[q].x, vr[q].y, vr[q].z, vr[q].w};
#pragma unroll
                    for (int c = 0; c < 4; ++c) { const int e = 8 * q + 2 * c; VT[e * 72 + lane] = (u16)(w[c] & 0xffffu); VT[(e + 1) * 72 + lane] = (u16)(w[c] >> 16); } }
                LDS_WAIT(); asm volatile("" ::: "memory");
                f32x4 acc[4][2];
#pragma unroll
                for (int a = 0; a < 4; ++a) { acc[a][0] = (f32x4){0.f, 0.f, 0.f, 0.f}; acc[a][1] = (f32x4){0.f, 0.f, 0.f, 0.f}; }
#pragma unroll
                for (int ks = 0; ks < 2; ++ks) {
                    const mbf16x8 b0 = *(const LAS mbf16x8*)(KT + nn * 72 + 32 * ks + 8 * kk), b1 = *(const LAS mbf16x8*)(KT + (16 + nn) * 72 + 32 * ks + 8 * kk);
#pragma unroll
                    for (int mt = 0; mt < 4; ++mt) { const mbf16x8 a = *(const LAS mbf16x8*)(VT + (16 * mt + nn) * 72 + 32 * ks + 8 * kk);
                        acc[mt][0] = __builtin_amdgcn_mfma_f32_16x16x32_bf16(a, b0, acc[mt][0], 0, 0, 0); acc[mt][1] = __builtin_amdgcn_mfma_f32_16x16x32_bf16(a, b1, acc[mt][1], 0, 0, 0); }
                }
                float* o = AS + (size_t)item * 2048;
#pragma unroll
                for (int mt = 0; mt < 4; ++mt)
#pragma unroll
                    for (int nt = 0; nt < 2; ++nt)
#pragma unroll
                        for (int r = 0; r < 4; ++r) o[(16 * mt + 4 * kk + r) * 32 + 16 * nt + nn] = acc[mt][nt][r];
                if (lane < 32) DEC[(size_t)item * 32 + lane] = grp == 0 ? __expf(64.f * lg) : __expf(tot[lane]);
                LDS_WAIT(); asm volatile("" ::: "memory");
            }
            __syncthreads(); }
        } else if (ph == 4) {
            const int gt_ = bx * 512 + tid;
            for (int rep_ = 0; rep_ < REP_S2; ++rep_)
            if (gt_ < 32 * 2048) {
                const int seq = gt_ >> 11, elem = gt_ & 2047, d = elem & 31, dir = (seq >> 3) & 1;
                float* base = AS + (size_t)seq * 260 * 2048 + elem; const float* dbase = DEC + (size_t)seq * 260 * 32 + d;
                float S = 0.f;
                for (int n0 = 0; n0 < 260; n0 += 52) {
                    float a[52], dc[52];
#pragma unroll
                    for (int q = 0; q < 52; ++q) { const int n = n0 + q; const int ci = dir == 0 ? n : (n < 4 ? 3 - n : 263 - n); a[q] = base[(size_t)ci * 2048]; dc[q] = dbase[(size_t)ci * 32]; }
#pragma unroll
                    for (int q = 0; q < 52; ++q) { const int n = n0 + q; const int ci = dir == 0 ? n : (n < 4 ? 3 - n : 263 - n); (rep_ + 1 < REP_S2 ? base + 17039360 : base)[(size_t)ci * 2048] = S; S = dc[q] * S + a[q]; }
                }
            }
        } else if (ph == 5) {
            for (int rep_ = 0; rep_ < REP_S3; ++rep_) {
                const int slot = wave >> 2, w4 = wave & 3, t4 = tid & 255;
                LAS u16* KFs = (LAS u16*)(L + slot * 32768); LAS u16* KBs = KFs + 64 * 40; LAS u16* VT = KBs + 64 * 40; LAS u16* ST = VT + 64 * 72;
                const int nn = lane & 15, kk = lane >> 4;
                for (int pr = bx; pr < N_ITEM3 / 2; pr += G_) {
                    const int item = pr * 2 + slot;
                    const int cidx = item % 260, t = item / 260, h = t & 3, b = (t >> 2) & 1, grp = t >> 3;
                    const int row0 = cidx < 4 ? M_LAT + b * 256 + cidx * 64 : b * 16384 + (cidx - 4) * 64;
                    const u16* Pr = P + (size_t)row0 * NPAD;
                    const int qcol = (grp ? C_GQ : C_RQ) + h * 32, kcol = (grp ? C_GK : C_RK) + h * 32, vcol = (grp ? C_GV : C_RV) + h * 64, gcol = (grp ? C_GG : C_RG) + h * 64;
                    const size_t itF = (size_t)((((grp * 2 + 0) * 2 + b) * 4 + h) * 260 + cidx), itB = (size_t)((((grp * 2 + 1) * 2 + b) * 4 + h) * 260 + cidx);
                    const float lgf = logsig(in_retl[layer * 8 + h]), lgb = logsig(in_retl[layer * 8 + 4 + h]);
                    const int jr = t4 >> 2, d0 = (t4 & 3) * 8, iq = 16 * w4 + nn;
                    const u32x4 qw = *(const u32x4*)(Pr + (size_t)iq * NPAD + qcol + 8 * kk);
                    const u32x4 kw = *(const u32x4*)(Pr + (size_t)jr * NPAD + kcol + d0);
                    const u32x4 va = *(const u32x4*)(Pr + (size_t)jr * NPAD + vcol + (t4 & 3) * 16), vb = *(const u32x4*)(Pr + (size_t)jr * NPAD + vcol + (t4 & 3) * 16 + 8);
                    const f32x4 sf0 = *(const f32x4*)(AS + itF * 2048 + t4 * 8), sf1 = *(const f32x4*)(AS + itF * 2048 + t4 * 8 + 4);
                    const f32x4 sb0 = *(const f32x4*)(AS + itB * 2048 + t4 * 8), sb1 = *(const f32x4*)(AS + itB * 2048 + t4 * 8 + 4);
                    u16 graw[4][4];
#pragma unroll
                    for (int r = 0; r < 4; ++r)
#pragma unroll
                        for (int et = 0; et < 4; ++et) graw[r][et] = Pr[(size_t)(16 * w4 + 4 * kk + r) * NPAD + gcol + nn + 16 * et];
                    f32x4 bq[4], bk[4];
#pragma unroll
                    for (int s = 0; s < 4; ++s) { bq[s] = (f32x4){0.f, 0.f, 0.f, 0.f}; bk[s] = (f32x4){0.f, 0.f, 0.f, 0.f}; }
                    if (grp == 1) { const float* gq = GT + (size_t)(row0 + iq) * 256 + h * 32 + 8 * kk; const float* gk = GT + (size_t)(row0 + jr) * 256 + h * 32 + d0;
                        bq[0] = *(const f32x4*)gq; bq[1] = *(const f32x4*)(gq + 4); bq[2] = *(const f32x4*)(gq + 128); bq[3] = *(const f32x4*)(gq + 132);
                        bk[0] = *(const f32x4*)gk; bk[1] = *(const f32x4*)(gk + 4); bk[2] = *(const f32x4*)(gk + 128); bk[3] = *(const f32x4*)(gk + 132); }
                    else { const float ef = (float)(iq + 1) * lgf, eb = (float)(64 - iq) * lgb, kf = (float)(jr + 1) * lgf, kb = (float)(64 - jr) * lgb;
                        bq[0] = bq[1] = (f32x4){ef, ef, ef, ef}; bq[2] = bq[3] = (f32x4){eb, eb, eb, eb}; bk[0] = bk[1] = (f32x4){kf, kf, kf, kf}; bk[2] = bk[3] = (f32x4){kb, kb, kb, kb}; }
                    mbf16x8 qfr_f, qfr_b;
                    {   const float qs = grp ? 0.17677669529663687f : 1.f;
                        const float qx[8] = {bflo(qw.x) * qs, bfhi(qw.x) * qs, bflo(qw.y) * qs, bfhi(qw.y) * qs, bflo(qw.z) * qs, bfhi(qw.z) * qs, bflo(qw.w) * qs, bfhi(qw.w) * qs};
                        u32x4 pf, pb;
                        pf.x = pk2(qx[0] * __expf(bq[0].x), qx[1] * __expf(bq[0].y)); pf.y = pk2(qx[2] * __expf(bq[0].z), qx[3] * __expf(bq[0].w));
                        pf.z = pk2(qx[4] * __expf(bq[1].x), qx[5] * __expf(bq[1].y)); pf.w = pk2(qx[6] * __expf(bq[1].z), qx[7] * __expf(bq[1].w));
                        pb.x = pk2(qx[0] * __expf(bq[2].x), qx[1] * __expf(bq[2].y)); pb.y = pk2(qx[2] * __expf(bq[2].z), qx[3] * __expf(bq[2].w));
                        pb.z = pk2(qx[4] * __expf(bq[3].x), qx[5] * __expf(bq[3].y)); pb.w = pk2(qx[6] * __expf(bq[3].z), qx[7] * __expf(bq[3].w));
                        qfr_f = __builtin_bit_cast(mbf16x8, pf); qfr_b = __builtin_bit_cast(mbf16x8, pb); }
                    {   const float kx[8] = {bflo(kw.x), bfhi(kw.x), bflo(kw.y), bfhi(kw.y), bflo(kw.z), bfhi(kw.z), bflo(kw.w), bfhi(kw.w)};
                        u32x4 pf, pb;
                        pf.x = pk2(kx[0] * __expf(-bk[0].x), kx[1] * __expf(-bk[0].y)); pf.y = pk2(kx[2] * __expf(-bk[0].z), kx[3] * __expf(-bk[0].w));
                        pf.z = pk2(kx[4] * __expf(-bk[1].x), kx[5] * __expf(-bk[1].y)); pf.w = pk2(kx[6] * __expf(-bk[1].z), kx[7] * __expf(-bk[1].w));
                        pb.x = pk2(kx[0] * __expf(-bk[2].x), kx[1] * __expf(-bk[2].y)); pb.y = pk2(kx[2] * __expf(-bk[2].z), kx[3] * __expf(-bk[2].w));
                        pb.z = pk2(kx[4] * __expf(-bk[3].x), kx[5] * __expf(-bk[3].y)); pb.w = pk2(kx[6] * __expf(-bk[3].z), kx[7] * __expf(-bk[3].w));
                        *(LAS u32x4*)(KFs + jr * 40 + d0) = pf; *(LAS u32x4*)(KBs + jr * 40 + d0) = pb;
                        u32x4 s0, s1; s0.x = pk2(sf0.x, sf0.y); s0.y = pk2(sf0.z, sf0.w); s0.z = pk2(sf1.x, sf1.y); s0.w = pk2(sf1.z, sf1.w);
                        s1.x = pk2(sb0.x, sb0.y); s1.y = pk2(sb0.z, sb0.w); s1.z = pk2(sb1.x, sb1.y); s1.w = pk2(sb1.z, sb1.w);
                        *(LAS u32x4*)(ST + jr * 72 + d0) = s0; *(LAS u32x4*)(ST + jr * 72 + 32 + d0) = s1;
                        const int c0 = (t4 & 3) * 16; const unsigned vw[8] = {va.x, va.y, va.z, va.w, vb.x, vb.y, vb.z, vb.w};
#pragma unroll
                        for (int q = 0; q < 8; ++q) { VT[(c0 + 2 * q) * 72 + jr] = (u16)(vw[q] & 0xffffu); VT[(c0 + 2 * q + 1) * 72 + jr] = (u16)(vw[q] >> 16); } }
                    __syncthreads();
                    const f32x4 z4 = (f32x4){0.f, 0.f, 0.f, 0.f};
                    f32x4 sc[4];
#pragma unroll
                    for (int jt = 0; jt < 4; ++jt) {
                        const mbf16x8 kf_ = *(const LAS mbf16x8*)(KFs + (16 * jt + nn) * 40 + 8 * kk), kb_ = *(const LAS mbf16x8*)(KBs + (16 * jt + nn) * 40 + 8 * kk);
                        if (jt < w4) sc[jt] = __builtin_amdgcn_mfma_f32_16x16x32_bf16(kf_, qfr_f, z4, 0, 0, 0);
                        else if (jt > w4) sc[jt] = __builtin_amdgcn_mfma_f32_16x16x32_bf16(kb_, qfr_b, z4, 0, 0, 0);
                        else { const f32x4 a = __builtin_amdgcn_mfma_f32_16x16x32_bf16(kf_, qfr_f, z4, 0, 0, 0), c = __builtin_amdgcn_mfma_f32_16x16x32_bf16(kb_, qfr_b, z4, 0, 0, 0);
#pragma unroll
                            for (int r = 0; r < 4; ++r) sc[jt][r] = (4 * kk + r <= nn) ? a[r] : c[r]; }
                    }
                    f32x4 O[4];
#pragma unroll
                    for (int et = 0; et < 4; ++et) O[et] = z4;
#pragma unroll
                    for (int p2 = 0; p2 < 2; ++p2) {
                        u32x4 pa; pa.x = pk2(sc[2 * p2][0], sc[2 * p2][1]); pa.y = pk2(sc[2 * p2][2], sc[2 * p2][3]); pa.z = pk2(sc[2 * p2 + 1][0], sc[2 * p2 + 1][1]); pa.w = pk2(sc[2 * p2 + 1][2], sc[2 * p2 + 1][3]);
                        const mbf16x8 af = __builtin_bit_cast(mbf16x8, pa);
#pragma unroll
                        for (int et = 0; et < 4; ++et) { const LAS u16* vp = VT + (16 * et + nn) * 72 + 32 * p2 + 4 * kk;
                            const u32x2 lo = *(const LAS u32x2*)vp, hi = *(const LAS u32x2*)(vp + 16); u32x4 pbv; pbv.x = lo.x; pbv.y = lo.y; pbv.z = hi.x; pbv.w = hi.y;
                            O[et] = __builtin_amdgcn_mfma_f32_16x16x32_bf16(af, __builtin_bit_cast(mbf16x8, pbv), O[et], 0, 0, 0); }
                    }
#pragma unroll
                    for (int et = 0; et < 4; ++et) { const LAS u16* sp = ST + (16 * et + nn) * 72 + 8 * kk;
                        O[et] = __builtin_amdgcn_mfma_f32_16x16x32_bf16(qfr_f, *(const LAS mbf16x8*)sp, O[et], 0, 0, 0);
                        O[et] = __builtin_amdgcn_mfma_f32_16x16x32_bf16(qfr_b, *(const LAS mbf16x8*)(sp + 32), O[et], 0, 0, 0); }
#pragma unroll
                    for (int r = 0; r < 4; ++r) { const int i = 16 * w4 + 4 * kk + r;
                        float x0 = O[0][r], x1 = O[1][r], x2 = O[2][r], x3 = O[3][r];
                        if (grp == 0) { float sm = (x0 + x1) + (x2 + x3); sm += xor_lane<1>(sm); sm += xor_lane<2>(sm); sm += xor_lane<4>(sm); sm += xor_lane<8>(sm);
                            const float mean = sm * (1.f / 64.f); x0 -= mean; x1 -= mean; x2 -= mean; x3 -= mean; }
                        float sq = (x0 * x0 + x1 * x1) + (x2 * x2 + x3 * x3); sq += xor_lane<1>(sq); sq += xor_lane<2>(sq); sq += xor_lane<4>(sq); sq += xor_lane<8>(sq);
                        const float rs = rsqrtf(sq * (1.f / 64.f) + NEPS);
                        const float xs[4] = {x0 * rs, x1 * rs, x2 * rs, x3 * rs};
                        u16* yp = XNY + (size_t)(row0 + i) * 1024 + grp * 256 + h * 64 + nn;
#pragma unroll
                        for (int et = 0; et < 4; ++et) { const float gate = bf2f(graw[r][et]); const float sg = gate * __builtin_amdgcn_rcpf(1.f + __expf(-gate)); yp[16 * et] = (u16)(pk2(sg * xs[et], 0.f) & 0xffffu); } }
                    __syncthreads();
                }
            }
            if (__builtin_amdgcn_readfirstlane(threadIdx.x) >= 256) __builtin_amdgcn_s_setprio(1);
            for (int rep_ = 0; rep_ < REP_ATT; ++rep_) {
                const int per = (1024 + G_ - 1) / G_;
                float gq_ = fabsf(in_qkg[layer * 128 + lane]), gk_ = fabsf(in_qkg[layer * 128 + 64 + lane]);
                gq_ = fmaxf(gq_, xor_lane<1>(gq_)); gq_ = fmaxf(gq_, xor_lane<2>(gq_)); gq_ = fmaxf(gq_, xor_lane<4>(gq_)); gq_ = fmaxf(gq_, xor_lane<8>(gq_)); gq_ = fmaxf(gq_, xor_lane<16>(gq_)); gq_ = fmaxf(gq_, other_half(gq_));
                gk_ = fmaxf(gk_, xor_lane<1>(gk_)); gk_ = fmaxf(gk_, xor_lane<2>(gk_)); gk_ = fmaxf(gk_, xor_lane<4>(gk_)); gk_ = fmaxf(gk_, xor_lane<8>(gk_)); gk_ = fmaxf(gk_, xor_lane<16>(gk_)); gk_ = fmaxf(gk_, other_half(gk_));
                const bool fixref = __builtin_amdgcn_readfirstlane((8.f * 1.4426950408889634f * 1.05f) * gq_ * gk_ < 40.f ? 1 : 0) != 0;
                for (int i = 0; i <= per; ++i) {
                    const u16 *Qw0 = P, *Kl = KB, *Vl = VB; u16* Ow0 = XNY; int NT = 4, tq0 = 0; bool rope = false;
                    if (i < per) { const int U = vcu * per + i; if (U >= 1024) continue;
                        const int bkv = U >> 8, g = (U >> 6) & 3, qb = U & 63, b = bkv >> 1, kvh = bkv & 1, h = kvh * 4 + g; const size_t qrow0 = (size_t)b * 16384 + (size_t)qb * 256;
                        Qw0 = P + qrow0 * NPAD + C_AQ + h * 64; tq0 = (int)qrow0; rope = true; Kl = KB + (size_t)(b * 2 + kvh) * (260 * 4096); Vl = VB + (size_t)(b * 2 + kvh) * (260 * 4096);
                        Ow0 = XNY + qrow0 * 1024 + 512 + h * 64; NT = 260;
                    } else { if (layer != 0 || vcu >= 16) break;
                        const int b = vcu >> 3, h = vcu & 7, kvh = h >> 2; const size_t qrow0 = (size_t)(M_LAT + b * 256);
                        Qw0 = P + qrow0 * NPAD + C_AQ + h * 64; tq0 = 0; rope = false; Kl = KB + ((size_t)(b * 2 + kvh) * 260 + 256) * 4096; Vl = VB + ((size_t)(b * 2 + kvh) * 260 + 256) * 4096;
                        Ow0 = XNY + qrow0 * 1024 + 512 + h * 64; NT = 4; }
                    const float* gqp = in_qkg + layer * 128; const float* tabp = rope ? (const float*)(ws + WS_TAB) : (const float*)nullptr;
                    if (fixref) attn_body::attn_unit<8, true>(gqp, tabp, tq0, (const attn_body::bf16*)Qw0, (const attn_body::bf16*)Kl, (const attn_body::bf16*)Vl, NT, (attn_body::bf16*)Ow0, (char*)lds);
                    else attn_body::attn_unit<8, false>(gqp, tabp, tq0, (const attn_body::bf16*)Qw0, (const attn_body::bf16*)Kl, (const attn_body::bf16*)Vl, NT, (attn_body::bf16*)Ow0, (char*)lds);
                }
            }
            __builtin_amdgcn_s_setprio(0);
        }
        for (int rep_ = 0; rep_ < REP_SYNC; ++rep_) xcd_barrier(bar);
    }
    PHASE_IDS
    PHASE_PTRS
    for (int m = gw; m < M_LAT; m += NGW) {
        float* src = xlat + (size_t)m * 1024; f32x4 v[4]; float ss = 0.f;
        const u16* ya = (const u16*)(ws + WS_YA) + (size_t)m * 1024; const u16* yb = XNY + (size_t)m * 1024;
#pragma unroll
        for (int j = 0; j < 4; ++j) { v[j] = *(const f32x4*)(src + 4 * lane + 256 * j);
            const u32x2 y = *(const u32x2*)(ya + 4 * lane + 256 * j), z = *(const u32x2*)(yb + 4 * lane + 256 * j);
            v[j] = v[j] + (f32x4){bflo(y.x), bfhi(y.x), bflo(y.y), bfhi(y.y)} + (f32x4){bflo(z.x), bfhi(z.x), bflo(z.y), bfhi(z.y)};
            ss += (v[j].x * v[j].x + v[j].y * v[j].y) + (v[j].z * v[j].z + v[j].w * v[j].w); }
        const float rstd = 1.0f / sqrtf(wave_sum(ss) * (1.f / 1024.f) + NEPS);
#pragma unroll
        for (int j = 0; j < 4; ++j) { const f32x4 gv = *(const f32x4*)(in_fng + 4 * lane + 256 * j); *(f32x4*)(src + 4 * lane + 256 * j) = (v[j] * rstd) * gv; }
    }
}

extern "C" void kernel_launch(void* const* d_in, const int* in_sizes, int n_in, void* d_out, int out_size, void* d_ws, size_t ws_size, hipStream_t stream) {
    static int grid_blocks = 0;
    if (grid_blocks == 0) {
        if (n_in != 17 || ws_size < 512 * MiB) { fprintf(stderr, "kernel_launch: unexpected n_in %d / ws %zu\n", n_in, ws_size); grid_blocks = -1; return; }
        int dev = 0, cus = 0, per_cu = 0;
        hipGetDevice(&dev); hipDeviceGetAttribute(&cus, hipDeviceAttributeMultiprocessorCount, dev);
        if (hipFuncSetAttribute((const void*)fwd_megakernel, hipFuncAttributeMaxDynamicSharedMemorySize, LDS_BYTES) != hipSuccess) { fprintf(stderr, "kernel_launch: hipFuncSetAttribute failed\n"); }
        if (hipOccupancyMaxActiveBlocksPerMultiprocessor(&per_cu, (const void*)fwd_megakernel, 512, LDS_BYTES) != hipSuccess || per_cu < 1) { fprintf(stderr, "kernel_launch: occupancy query gave %d\n", per_cu); per_cu = 1; }
        (void)hipGetLastError();
        if (per_cu > 1) per_cu = 1;
        grid_blocks = cus * per_cu;
    }
    if (grid_blocks < 0) return;
    Args a{};
    for (int i = 0; i < 17; ++i) a.in[i] = (const float*)d_in[i];
    a.out = (float*)d_out; a.ws = (unsigned char*)d_ws;
    if (hipMemsetAsync((char*)d_ws + WS_BAR, 0, WS_BAR_BYTES, stream) != hipSuccess) { fprintf(stderr, "kernel_launch: memset failed\n"); return; }
    void* kargs[] = {&a};
    hipError_t e = hipLaunchCooperativeKernel((const void*)fwd_megakernel, dim3(grid_blocks), dim3(512), kargs, LDS_BYTES, stream);
    if (e != hipSuccess) fprintf(stderr, "cooperative launch failed: %s (grid %d)\n", hipGetErrorString(e), grid_blocks);
}
```

```cpp
#include <hip/hip_runtime.h>
#include <hip/hip_cooperative_groups.h>
#include <cstdio>
#include <cstdint>
namespace cg = cooperative_groups;
namespace pg8 {
#define PG8_LAS __attribute__((address_space(3)))
typedef unsigned short bf16_t;
typedef short bf16x8 __attribute__((ext_vector_type(8)));
typedef float f32x4 __attribute__((ext_vector_type(4)));
typedef unsigned u32x4 __attribute__((ext_vector_type(4)));
constexpr int BM = 256, BK = 64, HALF = 128, HTB = HALF * BK * 2  , STAGE_BYTES = 8 * HTB, NXCD = 8, WGM = 8;

__host__ __device__ __forceinline__ int lds_byte(int r, int c) { const int st = (r >> 4) * 2 + (c >> 5), rr = r & 15, cc = c & 31, ob = rr * 64 + cc * 2; return st * 1024 + (ob ^ (((ob >> 9) & 1) << 5)); }
__host__ __device__ __forceinline__ void stage_rc(int b, int& R, int& C) { const int st = b / 1024, sb = b % 1024, swz = sb ^ (((sb >> 9) & 1) << 5); R = (st >> 1) * 16 + swz / 64; C = (st & 1) * 32 + (swz % 64) / 2; }
__host__ __device__ __forceinline__ int perm32(int rho) { const int n = rho >> 4, i = rho & 15; return 8 * (i >> 2) + 4 * n + (i & 3); }

struct Unit { int pm, pn; };
struct Gemm { const bf16_t* A; const bf16_t* Bt; int M, N, K; };

struct StaticOrder {
    int nM, nN, nwg, G, c;
    __host__ __device__ void init(int M, int N, int G_, int c_) { nM = M / BM; nN = N / BM; nwg = nM * nN; G = G_; c = c_; }
    __host__ __device__ bool next(int i, Unit& u) const {
        const long L = (long)i * G + c; if (L >= nwg) return false;
        int wgid = (int)L; { const int q = nwg / NXCD, r = nwg % NXCD, xcd = wgid % NXCD, off = wgid / NXCD; wgid = (xcd < r ? xcd * (q + 1) : r * (q + 1) + (xcd - r) * q) + off; }
        const int nig = WGM * nN, gid = wgid / nig, fm = gid * WGM, gsz = (nM - fm) < WGM ? (nM - fm) : WGM;
        u.pm = fm + ((wgid % nig) % gsz); u.pn = (wgid % nig) / gsz; return true;
    }
    __device__ __forceinline__ void a_ready(const Unit&) const {}
    __device__ __forceinline__ void done(const Unit&) const {}
};

__device__ __forceinline__ unsigned cvt_pk_bf16(float lo, float hi) { unsigned r; asm volatile("v_cvt_pk_bf16_f32 %0, %1, %2" : "=v"(r) : "v"(lo), "v"(hi)); return r; }
typedef float f32x2 __attribute__((ext_vector_type(2)));
struct EpiStoreBf16 {
    static constexpr bool PERM = true, AFTER_DRAIN = false;
    bf16_t* O; int ldc; int act; const float* gate;
    __device__ __forceinline__ void operator()(const f32x4 (&acc)[2][2][4][2], const Unit& u, int wr, int wc, int fr, int fq) const {
        const int row0 = u.pm * BM + wr * 64 + fr; const int col0 = u.pn * BM + wc * 32 + 8 * fq;
        f32x4 gv[2][2];
        if (gate) { const float* g = gate + (u.pm >> 6) * 6144 + col0;
#pragma unroll
            for (int bj = 0; bj < 2; ++bj) { gv[bj][0] = *(const f32x4*)(g + bj * HALF); gv[bj][1] = *(const f32x4*)(g + bj * HALF + 4); } }
#pragma unroll
        for (int ai = 0; ai < 2; ++ai)
#pragma unroll
            for (int m = 0; m < 4; ++m) { bf16_t* rowp = O + (size_t)(row0 + ai * HALF + m * 16) * ldc + col0;
#pragma unroll
                for (int bj = 0; bj < 2; ++bj) { f32x4 v0 = acc[ai][bj][m][0], v1 = acc[ai][bj][m][1];
                    if (gate) { v0 = v0 * gv[bj][0]; v1 = v1 * gv[bj][1]; }
                    if (act == 1) {
#pragma unroll
                        for (int e = 0; e < 4; ++e) { float a = fmaxf(v0[e], 0.f), b = fmaxf(v1[e], 0.f); v0[e] = a * a; v1[e] = b * b; } }
                    u32x4 w; w.x = cvt_pk_bf16(v0[0], v0[1]); w.y = cvt_pk_bf16(v0[2], v0[3]); w.z = cvt_pk_bf16(v1[0], v1[1]); w.w = cvt_pk_bf16(v1[2], v1[3]);
                    *(u32x4*)(rowp + bj * HALF) = w; } }
    }
};
struct EpiResid {
    static constexpr bool PERM = false, AFTER_DRAIN = false;
    float* xlat; float* xctx; const float* gt; float* dummy;
    __device__ __forceinline__ void operator()(const f32x4 (&acc)[2][2][4][2], const Unit& u, int wr, int wc, int fr, int fq) const {
        const int cond = (u.pm < 128) ? (u.pm >> 6) : 2; const float* g = gt + cond * 6144;
        const int col0 = u.pn * BM + wc * 32 + 4 * fq;
        f32x4 gv[2][2];
#pragma unroll
        for (int bj = 0; bj < 2; ++bj)
#pragma unroll
            for (int n = 0; n < 2; ++n) gv[bj][n] = *(const f32x4*)(g + col0 + bj * HALF + n * 16);
#pragma unroll
        for (int ai = 0; ai < 2; ++ai)
#pragma unroll
            for (int m = 0; m < 4; ++m) { const int r = u.pm * BM + ai * HALF + wr * 64 + m * 16 + fr;
                float* rowp = (r < 32768) ? (xlat + (size_t)r * 1024) : (xctx + (size_t)(r - 32768) * 1024);
#pragma unroll
                for (int bj = 0; bj < 2; ++bj)
#pragma unroll
                    for (int n = 0; n < 2; ++n) { float* p = rowp + col0 + bj * HALF + n * 16; f32x4 x = *(const f32x4*)p; x = x + gv[bj][n] * acc[ai][bj][m][n]; float* q = dummy ? (dummy + (size_t)(r & 16383) * 1024 + col0 + bj * HALF + n * 16) : p; *(f32x4*)q = x; } }
    }
};
template <class Epi, class Sched, bool ALIGN_EPI = false, bool SP2 = false>
__device__ __forceinline__ void gemm_phase(PG8_LAS unsigned char* lds, const Gemm g, const Sched& S, const Epi& E) {
    int tid_l = threadIdx.x; asm volatile("" : "+v"(tid_l));
    const int tid = tid_l, wid = __builtin_amdgcn_readfirstlane(tid >> 6), lane = tid & 63, wr = wid >> 2, wc = wid & 3, fr = lane & 15, fq = lane >> 4;
    const int K = g.K, nt = K / BK;
    unsigned voffA[2], voffB[2];
#pragma unroll
    for (int i = 0; i < 2; ++i) { int R, C; stage_rc(tid * 16 + i * 8192, R, C); const int Rb = Epi::PERM ? ((R & ~31) + perm32(R & 31)) : R;
        voffA[i] = (unsigned)(R * K + C) * 2u; voffB[i] = (unsigned)(Rb * K + C) * 2u; }
    const size_t kstep = (size_t)(BK * 2);
    const size_t hstep = (size_t)HALF * K * 2;
    const size_t tstep = 2 * hstep;
    const unsigned ldsw = (unsigned)wid * 1024u;
    const int aoff = lds_byte(wr * 64 + fr, fq * 8), boff = lds_byte(wc * 32 + fr, fq * 8);
#define PG8_SA(b, h) (((b) * 2 + (h)) * HTB)
#define PG8_SB(b, h) ((4 + (b) * 2 + (h)) * HTB)
#define PG8_STAGE(bufoff, gbase, voff) do { _Pragma("unroll") for (int _i = 0; _i < 2; ++_i) \
        __builtin_amdgcn_global_load_lds((const unsigned*)((const char*)(gbase) + (voff)[_i]), (PG8_LAS unsigned*)(lds + (bufoff) + ldsw + _i * 8192), 16, 0, 0); } while (0)
#define PG8_LDA(dst, b, h) do { _Pragma("unroll") for (int m = 0; m < 4; ++m) _Pragma("unroll") for (int k = 0; k < 2; ++k) dst[m][k] = *(const PG8_LAS bf16x8*)(lds + PG8_SA(b, h) + aoff + m * 2048 + k * 1024); } while (0)
#define PG8_LDB(dst, b, h) do { _Pragma("unroll") for (int n = 0; n < 2; ++n) _Pragma("unroll") for (int k = 0; k < 2; ++k) dst[n][k] = *(const PG8_LAS bf16x8*)(lds + PG8_SB(b, h) + boff + n * 2048 + k * 1024); } while (0)
#define PG8_MMA(ai, bj, At, Bt) do { __builtin_amdgcn_s_setprio(1); _Pragma("unroll") for (int m = 0; m < 4; ++m) _Pragma("unroll") for (int n = 0; n < 2; ++n) _Pragma("unroll") for (int k = 0; k < 2; ++k) \
        acc[ai][bj][m][n] = __builtin_amdgcn_mfma_f32_16x16x32_bf16(Bt[n][k], At[m][k], acc[ai][bj][m][n], 0, 0, 0); __builtin_amdgcn_s_setprio(0); } while (0)
#define PG8_WAIT_V(n) asm volatile("s_waitcnt vmcnt(" #n ")" ::: "memory")
#define PG8_WAIT_L(n) asm volatile("s_waitcnt lgkmcnt(" #n ")" ::: "memory")
#define PG8_BAR __builtin_amdgcn_s_barrier()
#define PG8_SCHED __builtin_amdgcn_sched_barrier(0)
    Unit cur, nxt; int ui = 0;
    if (!S.next(0, cur)) return;
    f32x4 acc[2][2][4][2];
#pragma unroll
    for (int a = 0; a < 2; ++a)
#pragma unroll
        for (int b = 0; b < 2; ++b)
#pragma unroll
            for (int m = 0; m < 4; ++m)
#pragma unroll
                for (int n = 0; n < 2; ++n) acc[a][b][m][n] = (f32x4){0.f, 0.f, 0.f, 0.f};
    bf16x8 At[4][2], B0[2][2], B1[2][2];
    const char* cA = (const char*)g.A + (size_t)cur.pm * tstep; const char* cB = (const char*)g.Bt + (size_t)cur.pn * tstep;
    S.a_ready(cur);
    if constexpr (SP2) {
        PG8_STAGE(PG8_SB(0, 0), cB, voffB); PG8_STAGE(PG8_SB(0, 1), cB + hstep, voffB); PG8_STAGE(PG8_SA(0, 0), cA, voffA); PG8_STAGE(PG8_SA(0, 1), cA + hstep, voffA);
        if (wr == 1) PG8_BAR;
        PG8_WAIT_V(2); PG8_BAR;
        PG8_STAGE(PG8_SB(1, 0), cB + kstep, voffB); PG8_STAGE(PG8_SA(1, 0), cA + kstep, voffA); PG8_STAGE(PG8_SB(1, 1), cB + hstep + kstep, voffB);
        PG8_WAIT_V(6); PG8_BAR;
    } else {
        PG8_STAGE(PG8_SB(0, 0), cB, voffB); PG8_STAGE(PG8_SA(0, 0), cA, voffA); PG8_STAGE(PG8_SB(0, 1), cB + hstep, voffB); PG8_STAGE(PG8_SA(0, 1), cA + hstep, voffA);
        if (wr == 1) PG8_BAR;
        PG8_WAIT_V(4); PG8_BAR;
        PG8_STAGE(PG8_SB(1, 0), cB + kstep, voffB); PG8_STAGE(PG8_SA(1, 0), cA + kstep, voffA); PG8_STAGE(PG8_SB(1, 1), cB + hstep + kstep, voffB);
        PG8_WAIT_V(6); PG8_BAR;
    }
    for (;;) {
        const bool has_next = S.next(ui + 1, nxt);
        const char* nA = has_next ? (const char*)g.A + (size_t)nxt.pm * tstep : cA; const char* nB = has_next ? (const char*)g.Bt + (size_t)nxt.pn * tstep : cB;
        for (int t = 0; t < nt; t += 2) {
            const bool last = (t == nt - 2);
            const char* a1 = cA + (size_t)(t + 1) * kstep;
            const char* a2 = last ? nA : cA + (size_t)(t + 2) * kstep; const char* b2 = last ? nB : cB + (size_t)(t + 2) * kstep;
            const char* a3 = a2 + kstep; const char* b3 = b2 + kstep;
            if (last && has_next) S.a_ready(nxt);
            if constexpr (SP2) {
            PG8_LDB(B0, 0, 0); PG8_LDB(B1, 0, 1); PG8_SCHED; PG8_LDA(At, 0, 0); PG8_STAGE(PG8_SA(1, 1), a1 + hstep, voffA);
            PG8_WAIT_V(8); PG8_WAIT_L(0); PG8_BAR; PG8_MMA(0, 0, At, B0); PG8_MMA(0, 1, At, B1); PG8_BAR; PG8_SCHED;
            PG8_LDA(At, 0, 1); PG8_STAGE(PG8_SB(0, 0), b2, voffB); PG8_STAGE(PG8_SB(0, 1), b2 + hstep, voffB); PG8_STAGE(PG8_SA(0, 0), a2, voffA);
            PG8_WAIT_V(8); PG8_WAIT_L(0); PG8_BAR; PG8_MMA(1, 0, At, B0); PG8_MMA(1, 1, At, B1); PG8_BAR; PG8_SCHED;
            PG8_LDB(B0, 1, 0); PG8_LDB(B1, 1, 1); PG8_SCHED; PG8_LDA(At, 1, 0); PG8_STAGE(PG8_SA(0, 1), a2 + hstep, voffA);
            PG8_WAIT_V(8); PG8_WAIT_L(0); PG8_BAR; PG8_MMA(0, 0, At, B0); PG8_MMA(0, 1, At, B1); PG8_BAR; PG8_SCHED;
            PG8_LDA(At, 1, 1); PG8_STAGE(PG8_SB(1, 0), b3, voffB); PG8_STAGE(PG8_SB(1, 1), b3 + hstep, voffB); PG8_STAGE(PG8_SA(1, 0), a3, voffA);
            PG8_WAIT_V(8); PG8_WAIT_L(0); PG8_BAR; PG8_MMA(1, 0, At, B0); PG8_MMA(1, 1, At, B1); PG8_BAR; PG8_SCHED;
            } else {
            PG8_LDB(B0, 0, 0); PG8_SCHED; PG8_LDA(At, 0, 0); PG8_STAGE(PG8_SA(1, 1), a1 + hstep, voffA);
            PG8_WAIT_L(8); PG8_BAR; PG8_WAIT_L(0); PG8_MMA(0, 0, At, B0); PG8_BAR; PG8_SCHED;
            PG8_LDB(B1, 0, 1); PG8_STAGE(PG8_SB(0, 0), b2, voffB);
            PG8_BAR; PG8_WAIT_L(0); PG8_MMA(0, 1, At, B1); PG8_BAR;
            PG8_LDA(At, 0, 1); PG8_STAGE(PG8_SA(0, 0), a2, voffA);
            PG8_BAR; PG8_WAIT_L(0); PG8_MMA(1, 0, At, B0); PG8_BAR; PG8_SCHED;
            PG8_STAGE(PG8_SB(0, 1), b2 + hstep, voffB);
            PG8_WAIT_V(6); PG8_BAR; PG8_MMA(1, 1, At, B1); PG8_BAR;
            PG8_LDB(B0, 1, 0); PG8_SCHED; PG8_LDA(At, 1, 0); PG8_STAGE(PG8_SA(0, 1), a2 + hstep, voffA);
            PG8_WAIT_L(8); PG8_BAR; PG8_WAIT_L(0); PG8_MMA(0, 0, At, B0); PG8_BAR; PG8_SCHED;
            PG8_LDB(B1, 1, 1); PG8_STAGE(PG8_SB(1, 0), b3, voffB);
            PG8_BAR; PG8_WAIT_L(0); PG8_MMA(0, 1, At, B1); PG8_BAR;
            PG8_LDA(At, 1, 1); PG8_STAGE(PG8_SA(1, 0), a3, voffA);
            PG8_BAR; PG8_WAIT_L(0); PG8_MMA(1, 0, At, B0); PG8_BAR; PG8_SCHED;
            PG8_STAGE(PG8_SB(1, 1), b3 + hstep, voffB);
            PG8_WAIT_V(6); PG8_BAR; PG8_MMA(1, 1, At, B1); PG8_BAR;
            }
        }
        if constexpr (ALIGN_EPI) { if (wr == 0) PG8_BAR; }
        if constexpr (!Epi::AFTER_DRAIN) { E(acc, cur, wr, wc, fr, fq); S.done(cur); }
        if (!has_next) break;
#pragma unroll
        for (int a = 0; a < 2; ++a)
#pragma unroll
            for (int b = 0; b < 2; ++b)
#pragma unroll
                for (int m = 0; m < 4; ++m)
#pragma unroll
                    for (int n = 0; n < 2; ++n) acc[a][b][m][n] = (f32x4){0.f, 0.f, 0.f, 0.f};
        cur = nxt; cA = nA; cB = nB; ++ui;
        if constexpr (ALIGN_EPI) { if (wr == 1) PG8_BAR; }
    }
    PG8_WAIT_V(0);
    if constexpr (!ALIGN_EPI) { if (wr == 0) PG8_BAR; }
    PG8_BAR;
    if constexpr (Epi::AFTER_DRAIN) { E.fused(acc, cur, wr, wc, fr, fq, lds, wid, lane); S.done(cur); }
#undef PG8_SA
#undef PG8_SB
#undef PG8_STAGE
#undef PG8_LDA
#undef PG8_LDB
#undef PG8_MMA
#undef PG8_WAIT_V
#undef PG8_WAIT_L
#undef PG8_BAR
#undef PG8_SCHED
}
}
#include <hip/hip_bf16.h>
#include <cmath>
namespace attn_body {
using bf16=__hip_bfloat16;
using bf16x8=__attribute__((ext_vector_type(8)))short;
using s16x4=__attribute__((ext_vector_type(4)))short;
using f32x16=__attribute__((ext_vector_type(16)))float;
using u32x4=__attribute__((ext_vector_type(4)))unsigned;
constexpr int D=64,QP=2560,KP=128,OP=1024;
constexpr int NW=8,QBLK=32,QB=QBLK*NW,KVBLK=64;
constexpr int ATTN_UNIT_ROWS=QB;
__device__ __forceinline__ int crow(int r,int hi){return (r&3)+8*(r>>2)+4*hi;}
#define SBAR() __builtin_amdgcn_sched_barrier(0)
__device__ __forceinline__ void cmask(f32x16&p0,f32x16&p1,int jb,int qrel,int hi){
  const float NEG=-INFINITY; int kb=64*jb+4*hi;
  #pragma unroll
  for(int r=0;r<16;++r){int kv=kb+(r&3)+8*(r>>2); if(kv>qrel)p0[r]=NEG; if(kv+32>qrel)p1[r]=NEG;}
}

constexpr int NSLOT=3, SLOTB=8192;
constexpr int LDS_K=0, LDS_V=NSLOT*SLOTB, LDS_WS=2*NSLOT*SLOTB, LDS_OST=LDS_WS+NW*64*4, LDS_BYTES=LDS_OST+NW*4096;
constexpr float C2=0.125f*1.4426950408889634f;
__device__ __forceinline__ void glds16(const void*gsrc,unsigned lds_dst){unsigned keep;
  asm volatile("s_mov_b32 %0, m0\n\ts_mov_b32 m0, %2\n\ts_nop 0\n\tglobal_load_lds_dwordx4 %1, off\n\ts_mov_b32 m0, %0":"=&s"(keep):"v"(gsrc),"s"(lds_dst):"memory");}
__device__ __forceinline__ float max3f(float a,float b,float c){float r;asm("v_max3_f32 %0, %1, %2, %3":"=v"(r):"v"(a),"v"(b),"v"(c));return r;}
__device__ __forceinline__ float max2f(float a,float b){float r;asm("v_max_f32_e32 %0, %1, %2":"=v"(r):"v"(a),"v"(b));return r;}
__device__ __forceinline__ float fadd_s(float a,float b){float r;asm("v_add_f32_e32 %0, %1, %2":"=v"(r):"v"(a),"v"(b));return r;}
__device__ __forceinline__ float fsub_s(float a,float b){float r;asm("v_sub_f32_e32 %0, %1, %2":"=v"(r):"v"(a),"v"(b));return r;}
typedef float f32x2_t __attribute__((ext_vector_type(2))); typedef __bf16 bf16x2_t __attribute__((ext_vector_type(2)));
__device__ __forceinline__ unsigned cvtpk_s(float lo,float hi){f32x2_t v={lo,hi};bf16x2_t b=__builtin_convertvector(v,bf16x2_t);return __builtin_bit_cast(unsigned,b);}
#define WAIT_BAR(N) asm volatile("s_waitcnt vmcnt(" #N ") lgkmcnt(0)\n\ts_barrier":::"memory")

__device__ __forceinline__ void qkt(f32x16&p0,f32x16&p1,const char*Kslot,const bf16x8*qr,const f32x16&negm,int r32,int hi){
  const char*kb=Kslot+hi*1024+r32*16;
  #pragma unroll
  for(int d0=0;d0<4;++d0){
    const bf16x8 b0=*reinterpret_cast<const bf16x8*>(kb+d0*2048);
    const bf16x8 b1=*reinterpret_cast<const bf16x8*>(kb+d0*2048+512);
    if(d0==0){p0=__builtin_amdgcn_mfma_f32_32x32x16_bf16(b0,qr[0],negm,0,0,0);p1=__builtin_amdgcn_mfma_f32_32x32x16_bf16(b1,qr[0],negm,0,0,0);}
    else{p0=__builtin_amdgcn_mfma_f32_32x32x16_bf16(b0,qr[d0],p0,0,0,0);p1=__builtin_amdgcn_mfma_f32_32x32x16_bf16(b1,qr[d0],p1,0,0,0);}}
}
typedef __attribute__((address_space(3))) const char* lds_cptr;
typedef short v4i16_t __attribute__((ext_vector_type(4)));
__device__ __forceinline__ void kload8(bf16x8*kf,lds_cptr kp){
  kf[0]=*(const __attribute__((address_space(3))) bf16x8*)(kp);      kf[1]=*(const __attribute__((address_space(3))) bf16x8*)(kp+512);
  kf[2]=*(const __attribute__((address_space(3))) bf16x8*)(kp+2048); kf[3]=*(const __attribute__((address_space(3))) bf16x8*)(kp+2560);
  kf[4]=*(const __attribute__((address_space(3))) bf16x8*)(kp+4096); kf[5]=*(const __attribute__((address_space(3))) bf16x8*)(kp+4608);
  kf[6]=*(const __attribute__((address_space(3))) bf16x8*)(kp+6144); kf[7]=*(const __attribute__((address_space(3))) bf16x8*)(kp+6656);
}
__device__ __forceinline__ void kload2(bf16x8*kf,lds_cptr kp,int j){ kf[2*j]=*(const __attribute__((address_space(3))) bf16x8*)(kp+j*2048); kf[2*j+1]=*(const __attribute__((address_space(3))) bf16x8*)(kp+j*2048+512); }
__device__ __forceinline__ s16x4 vtr(lds_cptr p){ return __builtin_bit_cast(s16x4,__builtin_amdgcn_ds_read_tr16_b64_v4i16((__attribute__((address_space(3))) v4i16_t*)p)); }
__device__ __forceinline__ float rowmax(const f32x16&p0,const f32x16&p1){
  float a=max3f(p0[0],p0[1],p1[0]),b=max3f(p0[2],p0[3],p1[1]);a=max3f(a,p1[2],p1[3]);
  #pragma unroll
  for(int r=4;r<16;r+=4){a=max3f(a,p0[r],p0[r+1]);b=max3f(b,p0[r+2],p0[r+3]);a=max3f(a,p1[r],p1[r+1]);b=max3f(b,p1[r+2],p1[r+3]);}
  const float m=max2f(a,b);
  auto rr=__builtin_amdgcn_permlane32_swap(__float_as_uint(m),__float_as_uint(m),false,false);
  return max2f(__uint_as_float(rr[0]),__uint_as_float(rr[1]));
}
__device__ __forceinline__ void pv(f32x16*o,int vb,bf16x8 pa0,bf16x8 pa1,bf16x8 pa2,bf16x8 pa3){
  #pragma unroll
  for(int d0=0;d0<2;++d0){s16x4 lo[4],hi[4];
    #pragma unroll
    for(int ks=0;ks<4;++ks){
      asm volatile("ds_read_b64_tr_b16 %0,%1 offset:%c2":"=&v"(lo[ks]):"v"(vb),"i"(d0*4096+ks*1024):"memory");
      asm volatile("ds_read_b64_tr_b16 %0,%1 offset:%c2":"=&v"(hi[ks]):"v"(vb),"i"(d0*4096+ks*1024+512):"memory");}
    asm volatile("s_waitcnt lgkmcnt(0)":::"memory");SBAR();
    #define PK(k) (bf16x8){lo[k][0],lo[k][1],lo[k][2],lo[k][3],hi[k][0],hi[k][1],hi[k][2],hi[k][3]}
    o[d0]=__builtin_amdgcn_mfma_f32_32x32x16_bf16(pa0,PK(0),o[d0],0,0,0);
    o[d0]=__builtin_amdgcn_mfma_f32_32x32x16_bf16(pa1,PK(1),o[d0],0,0,0);
    o[d0]=__builtin_amdgcn_mfma_f32_32x32x16_bf16(pa2,PK(2),o[d0],0,0,0);
    o[d0]=__builtin_amdgcn_mfma_f32_32x32x16_bf16(pa3,PK(3),o[d0],0,0,0);
    #undef PK
  }
}

#ifndef ATTN_STORE16
#define ATTN_STORE16(p,v) (*(u32x4*)(p)=(v))
#endif
template<int THRL,bool FIXREF> __device__ __forceinline__ void attn_unit(const float*gq,const float*tab,const int tq0,const bf16*Qw0,const bf16*__restrict__ Kl,const bf16*__restrict__ Vl,const int NT,bf16*Ow0,char*shm){
  int tid_l=threadIdx.x; asm volatile("":"+v"(tid_l)); const int tid=tid_l,lane=tid&63,r32=lane&31,hi=lane>>5; const int wid=__builtin_amdgcn_readfirstlane(tid>>6);
  const bf16*Qw=Qw0+(long)(wid*QBLK)*QP;
  const unsigned lds0=(unsigned)(uintptr_t)shm;
  float*wsf=(float*)(shm+LDS_WS)+wid*64;
  const bf16*ksrc=Kl+wid*512+lane*8;
  const bf16*vsrc=Vl+wid*512+lane*8;
  const unsigned kdst=lds0+LDS_K+wid*1024, vdst=lds0+LDS_V+wid*1024;
  #define DMA_K(t,slot) glds16(ksrc+(long)(t)*4096,(unsigned)__builtin_amdgcn_readfirstlane(kdst+(slot)))
  #define DMA_V(t,slot) glds16(vsrc+(long)(t)*4096,(unsigned)__builtin_amdgcn_readfirstlane(vdst+(slot)))
  const int vb0=(int)(lds0+LDS_V)+((lane>>4)&1)*32+(lane&3)*8+(4*hi+((lane&15)>>2))*64;
  const char*Kbase=shm+LDS_K; bf16x8 kf[8];
  const lds_cptr shm3=(lds_cptr)shm; const lds_cptr kp0=shm3+LDS_K+hi*1024+r32*16; const lds_cptr vp0=shm3+LDS_V+((lane>>4)&1)*32+(lane&3)*8+(4*hi+((lane&15)>>2))*64;
  DMA_K(0,0);DMA_V(0,0);DMA_K(1,SLOTB);
  bf16x8 qr[4];
  {
    float xq[4][8]; float ss=0.f;
    #pragma unroll
    for(int d0=0;d0<4;++d0){ const u32x4 w=*reinterpret_cast<const u32x4*>(&Qw[(long)r32*QP+d0*16+hi*8]); const unsigned ww[4]={w.x,w.y,w.z,w.w};
      #pragma unroll
      for(int c=0;c<4;++c){ xq[d0][2*c]=__uint_as_float(ww[c]<<16); xq[d0][2*c+1]=__uint_as_float(ww[c]&0xffff0000u); ss+=xq[d0][2*c]*xq[d0][2*c]+xq[d0][2*c+1]*xq[d0][2*c+1]; } }
    { auto rr=__builtin_amdgcn_permlane32_swap(__float_as_uint(ss),__float_as_uint(ss),false,false); ss=__uint_as_float(rr[0])+__uint_as_float(rr[1]); }
    const float rstd=__builtin_amdgcn_rsqf(ss*(1.f/64.f)+1e-6f)*C2;
    #pragma unroll
    for(int d0=0;d0<4;++d0){ const float*gp=gq+d0*16+hi*8;
      #pragma unroll
      for(int j=0;j<8;++j)xq[d0][j]*=rstd*gp[j]; }
    if(tab){ const int tpos=(tq0+wid*QBLK+r32)&16383; const float*tr_=tab+((tpos>>6)*16+hi*8)*2; const float*tc_=tab+((tpos&63)*16+hi*8)*2;
      #pragma unroll
      for(int j=0;j<8;++j){ const float cr=tr_[2*j],sr=tr_[2*j+1],cc=tc_[2*j],sc=tc_[2*j+1];
        const float a0=xq[0][j],b0=xq[1][j],a1=xq[2][j],b1=xq[3][j];
        xq[0][j]=a0*cr-b0*sr; xq[1][j]=a0*sr+b0*cr; xq[2][j]=a1*cc-b1*sc; xq[3][j]=a1*sc+b1*cc; } }
    #pragma unroll
    for(int d0=0;d0<4;++d0){ u32x4 p; p.x=cvtpk_s(xq[d0][0],xq[d0][1]); p.y=cvtpk_s(xq[d0][2],xq[d0][3]); p.z=cvtpk_s(xq[d0][4],xq[d0][5]); p.w=cvtpk_s(xq[d0][6],xq[d0][7]); qr[d0]=__builtin_bit_cast(bf16x8,p); } }
  float mhat=0.f,l_reg=0.f;f32x16 o[2];o[0]=f32x16{};o[1]=f32x16{};f32x16 negm=f32x16{};asm volatile("":"+v"(negm));
  #define CMASK(P0,P1,t) do{}while(0)
  bool resc=false;
  #define START(P0,P1) do{ resc=false; \
    if(!FIXREF){ const float rm=rowmax(P0,P1); const float dl=rm; mhat=fadd_s(mhat,dl); \
      _Pragma("unroll") for(int r=0;r<16;++r){P0[r]=fsub_s(P0[r],dl);P1[r]=fsub_s(P1[r],dl);} \
      _Pragma("unroll") for(int r=0;r<16;++r)negm[r]=-mhat; asm volatile("":"+v"(negm)); } \
    _Pragma("unroll") for(int r=0;r<16;++r)P0[r]=__builtin_amdgcn_exp2f(P0[r]); }while(0)
  #define RESC() do{ if(resc){ asm volatile("s_waitcnt lgkmcnt(0)":::"memory"); \
      _Pragma("unroll") for(int d_=0;d_<2;++d_) _Pragma("unroll") for(int r=0;r<16;++r)o[d_][r]*=wsf[crow(r,hi)]; } }while(0)
  f32x16 pA0,pA1,pB0,pB1;
  int sl_prev=0,sl_cur=0,sl_next=SLOTB;
  #define ROT() do{sl_prev=sl_cur;sl_cur=sl_next;sl_next=(sl_next==(NSLOT-1)*SLOTB)?0:sl_next+SLOTB;}while(0)
  DMA_K(2,2*SLOTB);
  WAIT_BAR(3);
  qkt(pA0,pA1,Kbase,qr,negm,r32,hi);asm volatile("s_nop 15\n\ts_nop 7":"+v"(pA0),"+v"(pA1));CMASK(pA0,pA1,0);
  START(pA0,pA1);
  _Pragma("unroll") for(int r=0;r<16;++r)pA1[r]=__builtin_amdgcn_exp2f(pA1[r]);
  WAIT_BAR(0);
  DMA_K(3,0);DMA_V(1,SLOTB);
  ROT();
  kload8(kf,kp0+sl_cur);
  WAIT_BAR(2);
  s16x4 vlo[8],vhi[8]; u32x4 pw0,pw1,pw2,pw3;
  #define PKW(P,B) cvtpk_s(P[B],P[B+1])
  #define PAF(k) __builtin_bit_cast(bf16x8,pw##k)
  #define VFR(i) (bf16x8){vlo[i][0],vlo[i][1],vlo[i][2],vlo[i][3],vhi[i][0],vhi[i][1],vhi[i][2],vhi[i][3]}
  #define PIN(x) asm volatile("":"+v"(x))
  #define MX3(a,b,c) __builtin_fmaxf(__builtin_fmaxf((a),(b)),(c))
  #define GAPA(MF,A0,A1,A2,A3,W0,W1,PW) do{ MF; sacc+=A0; sacc+=A1; sacc+=A2; sacc+=A3; PIN(sacc); W0; W1; PIN(PW); SBAR(); }while(0)
  #define EX(v) __builtin_amdgcn_exp2f(v)
  #define GAPB(MF,X,B) do{ MF; X[B]=EX(X[B]); X[B+1]=EX(X[B+1]); X[B+2]=EX(X[B+2]); X[B+3]=EX(X[B+3]); PIN(X); SBAR(); }while(0)
  #define VRD(i) do{ vlo[i]=vtr(vp_+(((i)>>2)*4096+((i)&3)*1024)); vhi[i]=vtr(vp_+(((i)>>2)*4096+((i)&3)*1024+512)); }while(0)
  #define KRD(G,j) do{ if(G){ kload2(kf,kp0+sl_next,j); SBAR(); } }while(0)
  #define STEP(C0,C1,P0,P1,t,GK,GV,GL) do{ SBAR(); \
    const lds_cptr vp_=vp0+sl_prev; \
    VRD(0); SBAR(); float sacc=(P0[0]+P0[1]); \
    GAPA(C0=__builtin_amdgcn_mfma_f32_32x32x16_bf16(kf[0],qr[0],negm,0,0,0), P0[2],P0[3],P0[4],P0[5],     pw0[0]=PKW(P0,0), pw0[1]=PKW(P0,2), pw0); \
    VRD(4); SBAR(); GAPA(C1=__builtin_amdgcn_mfma_f32_32x32x16_bf16(kf[1],qr[0],negm,0,0,0), P0[6],P0[7],P0[8],P0[9],     pw0[2]=PKW(P0,4), pw0[3]=PKW(P0,6), pw0); \
    VRD(1); SBAR(); GAPA(C0=__builtin_amdgcn_mfma_f32_32x32x16_bf16(kf[2],qr[1],C0,0,0,0),   P0[10],P0[11],P0[12],P0[13], pw1[0]=PKW(P0,8), pw1[1]=PKW(P0,10), pw1); \
    VRD(5); SBAR(); GAPA(C1=__builtin_amdgcn_mfma_f32_32x32x16_bf16(kf[3],qr[1],C1,0,0,0),   P0[14],P0[15],P1[0],P1[1],   pw1[2]=PKW(P0,12),pw1[3]=PKW(P0,14), pw1); \
    VRD(2); SBAR(); GAPA(C0=__builtin_amdgcn_mfma_f32_32x32x16_bf16(kf[4],qr[2],C0,0,0,0),   P1[2],P1[3],P1[4],P1[5],     pw2[0]=PKW(P1,0), pw2[1]=PKW(P1,2), pw2); \
    VRD(6); SBAR(); GAPA(C1=__builtin_amdgcn_mfma_f32_32x32x16_bf16(kf[5],qr[2],C1,0,0,0),   P1[6],P1[7],P1[8],P1[9],     pw2[2]=PKW(P1,4), pw2[3]=PKW(P1,6), pw2); \
    VRD(3); SBAR(); GAPA(C0=__builtin_amdgcn_mfma_f32_32x32x16_bf16(kf[6],qr[3],C0,0,0,0),   P1[10],P1[11],P1[12],P1[13], pw3[0]=PKW(P1,8), pw3[1]=PKW(P1,10), pw3); \
    VRD(7); SBAR(); GAPA(C1=__builtin_amdgcn_mfma_f32_32x32x16_bf16(kf[7],qr[3],C1,0,0,0),   P1[14],P1[15],0.f,0.f,       pw3[2]=PKW(P1,12),pw3[3]=PKW(P1,14), pw3); \
    l_reg+=sacc; \
    if(GK){DMA_K((t)+3,sl_cur);} if(GV){DMA_V((t)+1,sl_next);} \
    CMASK(C0,C1,t); \
    if(!FIXREF){ float a=MX3(C0[0],C0[1],C1[0]),b=MX3(C0[2],C0[3],C1[1]); a=MX3(a,C1[2],C1[3]); \
      _Pragma("unroll") for(int r=4;r<16;r+=4){a=MX3(a,C0[r],C0[r+1]);b=MX3(b,C0[r+2],C0[r+3]);a=MX3(a,C1[r],C1[r+1]);b=MX3(b,C1[r+2],C1[r+3]);} \
      float rm=__builtin_fmaxf(a,b); { auto rr=__builtin_amdgcn_permlane32_swap(__float_as_uint(rm),__float_as_uint(rm),false,false); rm=__builtin_fmaxf(__uint_as_float(rr[0]),__uint_as_float(rr[1])); } \
      resc=false; \
      if(__builtin_expect(__any(rm>(float)THRL),0)){ const float dl=__builtin_fmaxf(rm,0.f); mhat+=dl; \
        _Pragma("unroll") for(int r=0;r<16;++r){C0[r]-=dl;C1[r]-=dl;} \
        _Pragma("unroll") for(int r=0;r<16;++r)negm[r]=-mhat; asm volatile("":"+v"(negm)); \
        const float f=__builtin_amdgcn_exp2f(-dl); l_reg*=f; if(hi==0)wsf[r32]=f; resc=true; } } \
    SBAR(); \
    GAPB(o[0]=__builtin_amdgcn_mfma_f32_32x32x16_bf16(PAF(0),VFR(0),o[0],0,0,0), C0,0); \
    GAPB(o[1]=__builtin_amdgcn_mfma_f32_32x32x16_bf16(PAF(0),VFR(4),o[1],0,0,0), C0,4); \
    KRD(GL,0); GAPB(o[0]=__builtin_amdgcn_mfma_f32_32x32x16_bf16(PAF(1),VFR(1),o[0],0,0,0), C0,8); \
    KRD(GL,1); GAPB(o[1]=__builtin_amdgcn_mfma_f32_32x32x16_bf16(PAF(1),VFR(5),o[1],0,0,0), C0,12); \
    KRD(GL,2); GAPB(o[0]=__builtin_amdgcn_mfma_f32_32x32x16_bf16(PAF(2),VFR(2),o[0],0,0,0), C1,0); \
    KRD(GL,3); GAPB(o[1]=__builtin_amdgcn_mfma_f32_32x32x16_bf16(PAF(2),VFR(6),o[1],0,0,0), C1,4); \
    GAPB(o[0]=__builtin_amdgcn_mfma_f32_32x32x16_bf16(PAF(3),VFR(3),o[0],0,0,0), C1,8); \
    GAPB(o[1]=__builtin_amdgcn_mfma_f32_32x32x16_bf16(PAF(3),VFR(7),o[1],0,0,0), C1,12); \
    }while(0)
  int t=1;
  #undef CMASK
  #define CMASK(P0,P1,t) do{}while(0)
  for(;t+5<NT;t+=2){
    STEP(pB0,pB1,pA0,pA1,t,true,true,true);     WAIT_BAR(2); RESC(); ROT();
    STEP(pA0,pA1,pB0,pB1,t+1,true,true,true);   WAIT_BAR(2); RESC(); ROT();
  }
  #undef CMASK
  #define CMASK(P0,P1,t) do{}while(0)
  #define ENDW(tt) do{ if((tt)+3<NT){WAIT_BAR(2);} else if((tt)+2<NT){WAIT_BAR(1);} else {WAIT_BAR(0);} }while(0)
  for(;t+1<NT;t+=2){
    STEP(pB0,pB1,pA0,pA1,t,(t+3<NT),(t+1<NT),(t+1<NT));       ENDW(t);   RESC(); ROT();
    STEP(pA0,pA1,pB0,pB1,t+1,(t+4<NT),(t+2<NT),(t+2<NT));     ENDW(t+1); RESC(); ROT();
  }
  STEP(pB0,pB1,pA0,pA1,NT-1,false,false,false); RESC();
  { float sacc=pB0[0]+pB0[1]; _Pragma("unroll") for(int r=2;r<16;++r)sacc+=pB0[r]; _Pragma("unroll") for(int r=0;r<16;++r)sacc+=pB1[r]; l_reg+=sacc;
    pw0=(u32x4){PKW(pB0,0),PKW(pB0,2),PKW(pB0,4),PKW(pB0,6)};pw1=(u32x4){PKW(pB0,8),PKW(pB0,10),PKW(pB0,12),PKW(pB0,14)};pw2=(u32x4){PKW(pB1,0),PKW(pB1,2),PKW(pB1,4),PKW(pB1,6)};pw3=(u32x4){PKW(pB1,8),PKW(pB1,10),PKW(pB1,12),PKW(pB1,14)};
    SBAR(); pv(o,vb0+sl_cur,PAF(0),PAF(1),PAF(2),PAF(3)); }
  #undef PKW
  #undef PAF
  #undef VFR
  #undef PIN
  #undef MX3
  #undef GAPA
  #undef GAPB
  #undef EX
  #undef VRD
  #undef KRD
  #undef STEP
  #undef ENDW
  {auto rr=__builtin_amdgcn_permlane32_swap(__float_as_uint(l_reg),__float_as_uint(l_reg),false,false);l_reg=__uint_as_float(rr[0])+__uint_as_float(rr[1]);}
  if(hi==0)wsf[32+r32]=l_reg;asm volatile("s_waitcnt lgkmcnt(0)":::"memory");
  float rli[16];
  #pragma unroll
  for(int r=0;r<16;++r)rli[r]=__builtin_amdgcn_rcpf(wsf[32+crow(r,hi)]);
  bf16*Ow=Ow0+(long)(wid*QBLK)*OP;
  { bf16*stg=(bf16*)(shm+LDS_OST)+wid*2048;
    #pragma unroll
    for(int r=0;r<16;++r){const int orow=crow(r,hi);
      #pragma unroll
      for(int d0=0;d0<2;++d0)stg[orow*64+d0*32+r32]=__float2bfloat16(o[d0][r]*rli[r]);}
    asm volatile("s_waitcnt lgkmcnt(0)":::"memory");
    #pragma unroll
    for(int i=0;i<4;++i){const int row=i*8+(lane>>3),ch=lane&7; const u32x4 v=*(const u32x4*)(stg+row*64+ch*8); ATTN_STORE16(Ow+(long)row*OP+ch*8,v);} }
  asm volatile("s_waitcnt lgkmcnt(0)\n\ts_barrier":::"memory");
  #undef DMA_K
  #undef DMA_V
  #undef CMASK
  #undef START
  #undef RESC
  #undef ROT
}
constexpr int ATTN_LDS_BYTES=LDS_BYTES;
#undef SBAR
#undef WAIT_BAR
}
#ifndef REP_SYNC
#define REP_SYNC 1
#endif
#ifndef REP_PRO
#define REP_PRO 1
#endif
#ifndef REP_S2
#define REP_S2 1
#endif
#ifndef REP_NORM
#define REP_NORM 1
#endif
#ifndef REP_G1
#define REP_G1 1
#endif
#ifndef REP_S1
#define REP_S1 1
#endif
#ifndef REP_S3
#define REP_S3 1
#endif
#ifndef REP_ATT
#define REP_ATT 1
#endif
#ifndef REP_POST0
#define REP_POST0 1
#endif
#define LAS __attribute__((address_space(3)))
typedef unsigned short u16;
typedef float f32x4 __attribute__((ext_vector_type(4)));
typedef float f32x2 __attribute__((ext_vector_type(2)));
typedef unsigned u32x4 __attribute__((ext_vector_type(4)));
typedef unsigned u32x2 __attribute__((ext_vector_type(2)));

constexpr int M_LAT = 32768, M_CTXR = 512, M_ALL = 33280, DM_ = 1024, NPAD = 2560, IN_W = 2336, FF_ = 4096;
constexpr int C_RQ = 0, C_RK = 128, C_RV = 256, C_RG = 512, C_GQ = 768, C_GK = 896, C_GV = 1024, C_GG = 1280, C_AQ = 1536, C_AK = 2048, C_AV = 2176, C_Z = 2304;
constexpr int SRC_GA = 1536;
constexpr float NEPS = 1e-6f;
constexpr int N_ITEM1 = 8320;
constexpr int N_ITEM3 = 4160;
constexpr size_t MiB = 1u << 20, KiB = 1u << 10;
constexpr size_t WS_MOD = 0;
constexpr size_t WS_BAR = 256 * KiB, WS_BAR_BYTES = 16 * KiB;
constexpr size_t WS_TAB = 512 * KiB;
constexpr size_t WS_CTXRES = 1 * MiB;
constexpr size_t WS_DEC = 3 * MiB;
constexpr size_t WS_W = 5 * MiB, W_LAYER = 23 * MiB, W_IN = 0, W_OUT = 5 * MiB, W_1 = 7 * MiB, W_2 = 15 * MiB;
constexpr size_t WS_XNY = 51 * MiB;
constexpr size_t WS_P = 116 * MiB;
constexpr size_t WS_QB = WS_P + (size_t)M_ALL * NPAD * 2;
constexpr size_t WS_KB = WS_QB + (size_t)M_ALL * 512 * 2;
constexpr size_t WS_VB = WS_KB + (size_t)M_ALL * 128 * 2;
constexpr size_t WS_G = WS_VB + (size_t)M_ALL * 128 * 2;
constexpr size_t WS_AS = WS_G + (size_t)M_ALL * 256 * 4;
constexpr size_t WS_END1 = WS_AS + (size_t)N_ITEM1 * 2048 * 4;
constexpr size_t WS_H = WS_P;
constexpr size_t WS_END2 = WS_H + (size_t)M_ALL * FF_ * 2;
constexpr size_t WS_YA = 430 * MiB;
static_assert(WS_YA >= WS_END1 && WS_YA >= WS_END2 && WS_YA + (size_t)M_ALL * 1024 * 2 <= 512 * MiB, "YA");
static_assert(WS_END1 <= 512 * MiB && WS_END2 <= 512 * MiB, "d_ws map");
constexpr int LDS_BYTES = 147456;

__device__ __forceinline__ float bf2f(unsigned h) { return __uint_as_float(h << 16); }
__device__ __forceinline__ float bflo(unsigned w) { return __uint_as_float(w << 16); }
__device__ __forceinline__ float bfhi(unsigned w) { return __uint_as_float(w & 0xffff0000u); }
__device__ __forceinline__ unsigned pk2(float lo, float hi) { return pg8::cvt_pk_bf16(lo, hi); }
template <int X> __device__ __forceinline__ float xor_lane(float v) { static_assert(X >= 1 && X <= 16, "xor_lane"); return __int_as_float(__builtin_amdgcn_ds_swizzle(__float_as_int(v), (X << 10) | 0x1F)); }
__device__ __forceinline__ float sum_halves(float v) { auto rr = __builtin_amdgcn_permlane32_swap(__float_as_uint(v), __float_as_uint(v), false, false); return __uint_as_float(rr[0]) + __uint_as_float(rr[1]); }
__device__ __forceinline__ float other_half(float v) { auto rr = __builtin_amdgcn_permlane32_swap(__float_as_uint(v), __float_as_uint(v), false, false); return (rr[0] == __float_as_uint(v)) ? __uint_as_float(rr[1]) : __uint_as_float(rr[0]); }
__device__ __forceinline__ float wave_sum(float v) {
    v += xor_lane<1>(v); v += xor_lane<2>(v); v += xor_lane<4>(v); v += xor_lane<8>(v); v += xor_lane<16>(v);
    return sum_halves(v);
}
__device__ __forceinline__ float logsig(float z) { return fminf(z, 0.f) - __logf(1.f + __expf(-fabsf(z))); }
#define LDS_WAIT() asm volatile("s_waitcnt lgkmcnt(0)" ::: "memory")

__device__ __forceinline__ void p0_transpose_item(const float* W, int K, int N, u16* WT, LAS float* scr, int item, int lane, int row_off = 0) {
    const int nblk = N / 32, kb = item / nblk, nb = item % nblk, k0 = 64 * kb, n0 = 32 * nb;
#pragma unroll 8
    for (int i = 0; i < 32; ++i) { const int kk = 2 * i + (lane >> 5); scr[kk * 33 + (lane & 31)] = W[(size_t)(k0 + kk) * N + n0 + (lane & 31)]; }
    LDS_WAIT(); asm volatile("" ::: "memory");
    const int c = lane & 7;
#pragma unroll
    for (int j = 0; j < 4; ++j) { const int n = (lane >> 3) + 8 * j; const LAS float* s = scr + (8 * c) * 33 + n;
        u32x4 o; o.x = pk2(s[0 * 33], s[1 * 33]); o.y = pk2(s[2 * 33], s[3 * 33]); o.z = pk2(s[4 * 33], s[5 * 33]); o.w = pk2(s[6 * 33], s[7 * 33]);
        *(u32x4*)(WT + (size_t)(n0 + n + row_off) * K + k0 + 8 * c) = o; }
    LDS_WAIT(); asm volatile("" ::: "memory");
}

#define XB_TMO      128
#define XB_XCNT(j)  (256  + 64 * (j))
#define XB_XSUB(j)  (1280 + 64 * (j))
#define XB_XGEN(j)  (2304 + 64 * (j))
#define XB_TOP      3328
#define XB_TOPGEN   3392
#define XCD_BAR_WORDS 3456
#define XB_SPIN_CAP (1u << 18)

__device__ __forceinline__ unsigned xb_ld(unsigned* p)              { return __hip_atomic_load(p, __ATOMIC_RELAXED, __HIP_MEMORY_SCOPE_AGENT); }
__device__ __forceinline__ unsigned xb_add(unsigned* p, unsigned v) { return __hip_atomic_fetch_add(p, v, __ATOMIC_RELAXED, __HIP_MEMORY_SCOPE_AGENT); }
__device__ __forceinline__ unsigned xb_xcc_id() { return (unsigned)__builtin_amdgcn_s_getreg((3 << 11) | 20) & 0xFu; }
#define XB_SPIN(cond, bar) do { unsigned _sp = 0; while (cond) { __builtin_amdgcn_s_sleep(1); \
    if ((++_sp & 255u) == 0u) { if (xb_ld(&(bar)[XB_TMO])) break; if (_sp > XB_SPIN_CAP) { atomicAdd(&(bar)[XB_TMO], 1u); break; } } } } while (0)

struct XcdBarrier {
    unsigned* bar; unsigned x;
    volatile LAS unsigned* st;
};

__device__ __forceinline__ XcdBarrier xcd_barrier_post(unsigned* bar, volatile LAS unsigned* st) {
    XcdBarrier b; b.bar = bar; b.x = xb_xcc_id(); b.st = st;
    if (threadIdx.x == 0) (void)xb_add(&bar[XB_XCNT(b.x)], 1u);
    return b;
}
__device__ __forceinline__ void xcd_barrier_complete(unsigned* bar, unsigned x, unsigned& nloc, unsigned& nx) {
    const unsigned G = gridDim.x * gridDim.y * gridDim.z;
    unsigned sum, cnt, mine, sp = 0u;
    for (;;) {
        sum = 0u; cnt = 0u; mine = 0u;
#pragma unroll
        for (unsigned j = 0; j < 16; ++j) { const unsigned c = xb_ld(&bar[XB_XCNT(j)]); sum += c; cnt += (c > 0u) ? 1u : 0u; mine = (j == x) ? c : mine; }
        if (sum == G) break;
        __builtin_amdgcn_s_sleep(1);
        if ((++sp & 255u) == 0u) { if (xb_ld(&bar[XB_TMO])) break; if (sp > XB_SPIN_CAP) { atomicAdd(&bar[XB_TMO], 1u); break; } }
    }
    nloc = mine > 0u ? mine : 1u; nx = cnt > 0u ? cnt : 1u;
}

__device__ __forceinline__ void xcd_barrier(const XcdBarrier& b) {
    asm volatile("s_waitcnt vmcnt(0)" ::: "memory");
    __syncthreads();
    if (threadIdx.x == 0) {
        unsigned* bar = b.bar;
        __builtin_amdgcn_s_waitcnt(0);
        unsigned nloc = b.st[0], nx = b.st[1];
        if (nloc == 0u) { xcd_barrier_complete(bar, b.x, nloc, nx); b.st[0] = nloc; b.st[1] = nx; }
        const unsigned old = xb_add(&bar[XB_XSUB(b.x)], 1u);
        const unsigned gen = old / nloc;
        if (old + 1u == (gen + 1u) * nloc) {
            __builtin_amdgcn_fence(__ATOMIC_RELEASE, "agent");
            asm volatile("s_waitcnt vmcnt(0)" ::: "memory");
            const unsigned og = xb_add(&bar[XB_TOP], 1u);
            const unsigned tg = og / nx;
            if (og + 1u == (tg + 1u) * nx) xb_add(&bar[XB_TOPGEN], 1u);
            else XB_SPIN(xb_ld(&bar[XB_TOPGEN]) == tg, bar);
            __builtin_amdgcn_fence(__ATOMIC_ACQUIRE, "agent");
            xb_add(&bar[XB_XGEN(b.x)], 1u);
            asm volatile("s_waitcnt vmcnt(0)" ::: "memory");
        } else {
            XB_SPIN(xb_ld(&bar[XB_XGEN(b.x)]) == gen, bar);
            __builtin_amdgcn_fence(__ATOMIC_ACQUIRE, "agent");
            asm volatile("s_waitcnt vmcnt(0)" ::: "memory");
        }
    }
    __syncthreads();
}


typedef short mbf16x8 __attribute__((ext_vector_type(8)));
template <int MODE> __device__ __forceinline__ void mini_gemm_ctx(const u16* A, const u16* Bt, int N, int K, u16* Ob, int ldo, int act, const float* gate, LAS unsigned char* L, int vb, int G_, int wave, int lane) {
    const int ncg = (N + 63) >> 6, ntiles = 8 * ncg, kslice = K >> 3;
    const int fr = lane & 15, fq = lane >> 4;
    LAS f32x4* red = (LAS f32x4*)L;
    for (int tile = vb; tile < ntiles; tile += G_) {
        const int r0 = (tile & 7) * 64, n0 = (tile >> 3) * 64;
        f32x4 acc[4][4];
#pragma unroll
        for (int a = 0; a < 4; ++a)
#pragma unroll
            for (int c = 0; c < 4; ++c) acc[a][c] = (f32x4){0.f, 0.f, 0.f, 0.f};
        const u16* ap = A + (size_t)(r0 + fr) * K + wave * kslice + 8 * fq; const u16* bp = Bt + (size_t)(n0 + fr) * K + wave * kslice + 8 * fq;
#pragma unroll 1
        for (int kc = 0; kc < kslice; kc += 64) {
            mbf16x8 fa[4][2], fb[4][2];
#pragma unroll
            for (int s = 0; s < 2; ++s)
#pragma unroll
                for (int q = 0; q < 4; ++q) { fa[q][s] = *(const mbf16x8*)(ap + (size_t)(16 * q) * K + kc + 32 * s); fb[q][s] = *(const mbf16x8*)(bp + (size_t)(16 * q) * K + kc + 32 * s); }
#pragma unroll
            for (int s = 0; s < 2; ++s)
#pragma unroll
                for (int mi = 0; mi < 4; ++mi)
#pragma unroll
                    for (int ni = 0; ni < 4; ++ni) acc[mi][ni] = __builtin_amdgcn_mfma_f32_16x16x32_bf16(fa[mi][s], fb[ni][s], acc[mi][ni], 0, 0, 0);
        }
#pragma unroll
        for (int ti = 0; ti < 16; ++ti) red[(wave * 16 + ti) * 64 + lane] = acc[ti >> 2][ti & 3];
        __syncthreads();
#pragma unroll
        for (int q = 0; q < 2; ++q) { const int ti = 2 * wave + q, mi = ti >> 2, ni = ti & 3;
            f32x4 s = red[ti * 64 + lane];
#pragma unroll
            for (int w = 1; w < 8; ++w) s += red[(w * 16 + ti) * 64 + lane];
            const int c = n0 + 16 * ni + fr;
            if (c < N) {
                const float gv = (MODE == 1) ? gate[c] : 1.f;
#pragma unroll
                for (int i = 0; i < 4; ++i) { const int r = r0 + 16 * mi + 4 * fq + i; float v = s[i] * gv;
                    if (act) { v = fmaxf(v, 0.f); v = v * v; } Ob[(size_t)r * ldo + c] = (u16)(pk2(v, 0.f) & 0xffffu); }
            }
        }
        __syncthreads();
    }
}

struct Args { const float* in[17]; float* out; unsigned char* ws; };

__global__ void __launch_bounds__(512, 2) fwd_megakernel(Args args) {
    extern __shared__ __attribute__((aligned(16))) unsigned char lds[];
    cg::grid_group grid = cg::this_grid();
    LAS unsigned char* L = (LAS unsigned char*)lds;
    const int G_ = gridDim.x, bx = blockIdx.x, NGW = G_ * 8;
#define PHASE_IDS int tid_l = threadIdx.x; asm volatile("" : "+v"(tid_l)); const int tid = tid_l, lane = tid & 63, wave = __builtin_amdgcn_readfirstlane(tid >> 6), gw = bx * 8 + wave; (void)gw; (void)lane;
    const int vcu = (G_ % 8 == 0) ? (bx % 8) * (G_ / 8) + bx / 8 : bx;
#define PHASE_PTRS \
    const __attribute__((address_space(4))) Args* ka_ = (const __attribute__((address_space(4))) Args*)__builtin_amdgcn_kernarg_segment_ptr(); asm volatile("" : "+s"(ka_)); \
    unsigned char* ws = ka_->ws; \
    const float* in_x = ka_->in[0]; const float* in_c = ka_->in[1]; const float* in_ctx = ka_->in[2]; const float* in_cctx = ka_->in[3]; \
    const float* in_modw = ka_->in[4]; const float* in_modb = ka_->in[5]; const float* in_ang = ka_->in[6]; const float* in_mng = ka_->in[7]; \
    const float* in_win = ka_->in[8]; const float* in_wout = ka_->in[9]; const float* in_retl = ka_->in[10]; const float* in_ggw = ka_->in[11]; \
    const float* in_ggb = ka_->in[12]; const float* in_qkg = ka_->in[13]; const float* in_w1 = ka_->in[14]; const float* in_w2 = ka_->in[15]; const float* in_fng = ka_->in[16]; \
    float* xlat = ka_->out; float* xctx = (float*)(ws + WS_CTXRES); \
    float* MOD = (float*)(ws + WS_MOD); float* DEC = (float*)(ws + WS_DEC); \
    u16* XNY = (u16*)(ws + WS_XNY); u16* P = (u16*)(ws + WS_P); u16* QB = (u16*)(ws + WS_QB); u16* KB = (u16*)(ws + WS_KB); u16* VB = (u16*)(ws + WS_VB); \
    float* GT = (float*)(ws + WS_G); float* AS = (float*)(ws + WS_AS); u16* HB = (u16*)(ws + WS_H); \
    (void)in_x; (void)in_c; (void)in_ctx; (void)in_cctx; (void)in_modw; (void)in_modb; (void)in_ang; (void)in_mng; (void)in_win; (void)in_wout; (void)in_retl; (void)in_ggw; (void)in_ggb; (void)in_qkg; (void)in_w1; (void)in_w2; (void)in_fng; \
    (void)xlat; (void)xctx; (void)MOD; (void)DEC; (void)XNY; (void)P; (void)QB; (void)KB; (void)VB; (void)GT; (void)AS; (void)HB;
    volatile LAS unsigned* MISC = (volatile LAS unsigned*)(L + LDS_BYTES - 256);
    if (threadIdx.x < 16) MISC[threadIdx.x] = 0u;
    __syncthreads();
    XcdBarrier bar = xcd_barrier_post((unsigned*)(args.ws + WS_BAR), MISC + 8);
    for (int rep_ = 0; rep_ < REP_PRO; ++rep_) {
    PHASE_IDS
    PHASE_PTRS
    if (bx < 192) {
        LAS float* sl = (LAS float*)L;
        for (int i = tid; i < 3072; i += 512) { const int cond = i >> 10, k = i & 1023; const float cv = cond < 2 ? in_c[cond * 1024 + k] : in_cctx[k]; sl[i] = cv / (1.f + expf(-cv)); }
        __syncthreads();
        const int layer = bx / 96, cn = tid & 63, col = (bx % 96) * 64 + cn, kg = tid >> 6;
        const float* wp = in_modw + (size_t)layer * 1024 * 6144 + (size_t)(kg * 128) * 6144 + col;
        float a0 = 0.f, a1 = 0.f, a2 = 0.f;
#pragma unroll 16
        for (int q = 0; q < 128; ++q) { const float w = wp[(size_t)q * 6144]; const int k = kg * 128 + q; a0 += sl[k] * w; a1 += sl[1024 + k] * w; a2 += sl[2048 + k] * w; }
        LAS float* red = sl + 3072;
        red[(kg * 3 + 0) * 64 + cn] = a0; red[(kg * 3 + 1) * 64 + cn] = a1; red[(kg * 3 + 2) * 64 + cn] = a2;
        __syncthreads();
        if (tid < 192) { const int cond = tid >> 6, c2 = tid & 63; float s = 0.f;
#pragma unroll
            for (int g = 0; g < 8; ++g) s += red[(g * 3 + cond) * 64 + c2];
            const int cc = (bx % 96) * 64 + c2; MOD[(size_t)(layer * 3 + cond) * 6144 + cc] = s + in_modb[layer * 6144 + cc]; }
        __syncthreads();
    }
    for (int i = bx * 512 + tid; i < 4096; i += G_ * 512) {
        const int pos = i >> 4, j = i & 15; const float invf = exp2f(-(float)j * 0.8304820237218406f); float sn, cs; sincosf((float)pos * invf, &sn, &cs);
        ((f32x2*)(ws + WS_TAB))[i] = (f32x2){cs, sn}; }
    {
        LAS float* scr = (LAS float*)(L + wave * 16384);
        for (int it = gw; it < 11552; it += NGW) {
            const int l = it / 5776; int r = it % 5776; unsigned char* wl = ws + WS_W + (size_t)l * W_LAYER;
            if (r < 1168) { const int nb = r % 73; if (nb != 48) p0_transpose_item(in_win + (size_t)l * 1024 * IN_W, 1024, IN_W, (u16*)(wl + W_IN), scr, r, lane, nb > 48 ? -32 : 0); continue; } r -= 1168;
            if (r < 512) { p0_transpose_item(in_wout + (size_t)l * 1024 * 1024, 1024, 1024, (u16*)(wl + W_OUT), scr, r, lane); continue; } r -= 512;
            if (r < 2048) { p0_transpose_item(in_w1 + (size_t)l * 1024 * 4096, 1024, 4096, (u16*)(wl + W_1), scr, r, lane); continue; } r -= 2048;
            p0_transpose_item(in_w2 + (size_t)l * 4096 * 1024, 4096, 1024, (u16*)(wl + W_2), scr, r, lane);
        }
        for (int idx = bx * 512 + tid; idx < 2 * 256 * 128; idx += G_ * 512) {
            const int l = idx >> 15, rem = idx & 32767, n = rem >> 7, k0 = (rem & 127) * 8, dirn = n >> 7, np = n & 127;
            const float* gwp = in_ggw + (size_t)l * 4096 + dirn * 2048 + np; const float* wp = in_win + (size_t)l * 1024 * IN_W + (size_t)k0 * IN_W + SRC_GA + dirn * 16;
            float o[8];
#pragma unroll
            for (int q = 0; q < 8; ++q) { float s = 0.f;
#pragma unroll
                for (int i = 0; i < 16; ++i) s += wp[(size_t)q * IN_W + i] * gwp[i * 128];
                o[q] = s; }
            u32x4 w; w.x = pk2(o[0], o[1]); w.y = pk2(o[2], o[3]); w.z = pk2(o[4], o[5]); w.w = pk2(o[6], o[7]);
            *(u32x4*)((u16*)(ws + WS_W + (size_t)l * W_LAYER + W_IN) + (size_t)(C_Z + n) * 1024 + k0) = w; }
    }
    __syncthreads();
    }
    if (args.ws == nullptr) grid.sync();
    xcd_barrier(bar);

    for (int step = 0; step < 20; ++step) {
        const int layer = step / 10, ph = step % 10;
        PHASE_IDS
        PHASE_PTRS
        unsigned char* wl = ws + WS_W + (size_t)layer * W_LAYER;
        const float* modl = MOD + (size_t)layer * 3 * 6144;
        if (ph == 0 || ph == 7) {
            for (int rep_ = 0; rep_ < REP_NORM; ++rep_) {

            const bool from_in = (layer == 0) || (ph == 0);
            const float* sl_ = from_in ? in_x : xlat; const float* sc_ = from_in ? in_ctx : xctx;
            const u16* ya = (layer == 0 && ph == 0) ? nullptr : (const u16*)(ws + WS_YA);
            const u16* yb = (layer == 1 && ph == 0) ? XNY : nullptr;
            const bool wx = (layer == 1 && ph == 0);
            const float* gvec = (ph == 0 ? in_ang : in_mng) + layer * 1024;
            const int sh_off = (ph == 0) ? 0 : 3072, sc_off = sh_off + 1024;
            const int Mn = (layer == 1 && ph == 7) ? M_LAT : M_ALL;
            for (int m = gw; m < Mn; m += NGW) {
                const float* src = (m < M_LAT) ? sl_ + (size_t)m * 1024 : sc_ + (size_t)(m - M_LAT) * 1024;
                const int cond = (m < M_LAT) ? (m >> 14) : 2;
                f32x4 v[4]; float ss = 0.f;
#pragma unroll
                for (int j = 0; j < 4; ++j) v[j] = *(const f32x4*)(src + 4 * lane + 256 * j);
                if (ya) {
#pragma unroll
                    for (int j = 0; j < 4; ++j) { const u32x2 y = *(const u32x2*)(ya + (size_t)m * 1024 + 4 * lane + 256 * j); v[j] = v[j] + (f32x4){bflo(y.x), bfhi(y.x), bflo(y.y), bfhi(y.y)}; } }
                if (yb) {
#pragma unroll
                    for (int j = 0; j < 4; ++j) { const u32x2 y = *(const u32x2*)(yb + (size_t)m * 1024 + 4 * lane + 256 * j); v[j] = v[j] + (f32x4){bflo(y.x), bfhi(y.x), bflo(y.y), bfhi(y.y)}; } }
#pragma unroll
                for (int j = 0; j < 4; ++j) ss += (v[j].x * v[j].x + v[j].y * v[j].y) + (v[j].z * v[j].z + v[j].w * v[j].w);
                if (wx) { float* dst = (m < M_LAT) ? xlat + (size_t)m * 1024 : xctx + (size_t)(m - M_LAT) * 1024;
#pragma unroll
                    for (int j = 0; j < 4; ++j) *(f32x4*)(dst + 4 * lane + 256 * j) = v[j]; }
                const float rstd = 1.0f / sqrtf(wave_sum(ss) * (1.f / 1024.f) + NEPS);
                const float* mc = modl + cond * 6144;
#pragma unroll
                for (int j = 0; j < 4; ++j) { const int col = 4 * lane + 256 * j;
                    const f32x4 gv = *(const f32x4*)(gvec + col), sc = *(const f32x4*)(mc + sc_off + col), sh = *(const f32x4*)(mc + sh_off + col);
                    const f32x4 hv = (v[j] * rstd) * gv * (sc + 1.0f) + sh;
                    u32x2 o; o.x = pk2(hv.x, hv.y); o.y = pk2(hv.z, hv.w); *(u32x2*)(XNY + (size_t)m * 1024 + col) = o; }
            }
            __syncthreads(); }
        } else if (ph == 1 || ph == 8 || ph == 6 || ph == 9) {
            for (int rep_ = 0; rep_ < REP_G1; ++rep_) {

            const u16* Aop = (ph == 9) ? HB : XNY; const int Kop = (ph == 9) ? FF_ : 1024;
            const u16* Bop = (const u16*)(wl + (ph == 1 ? W_IN : ph == 8 ? W_1 : ph == 6 ? W_OUT : W_2));
            const int Nmain = (ph == 1) ? NPAD : (ph == 8 ? FF_ : 1024), Nctx = Nmain;
            u16* Oop = (ph == 1) ? P : (ph == 8 ? HB : (ph == 6 ? (u16*)(ws + WS_YA) : XNY));
            const float* gate = (ph == 6) ? modl + 2048 : (ph == 9 ? modl + 5120 : (const float*)nullptr);
            if (ph == 1 || layer == 0) {
                if (gate) mini_gemm_ctx<1>(Aop + (size_t)M_LAT * Kop, Bop, Nctx, Kop, Oop + (size_t)M_LAT * Nmain, Nmain, 0, gate + 2 * 6144, L, vcu, G_, wave, lane);
                else mini_gemm_ctx<0>(Aop + (size_t)M_LAT * Kop, Bop, Nctx, Kop, Oop + (size_t)M_LAT * Nmain, Nmain, ph == 8 ? 1 : 0, nullptr, L, vcu, G_, wave, lane);
            }
            pg8::Gemm g{Aop, Bop, M_LAT, Nmain, Kop};
            pg8::StaticOrder S; S.init(g.M, g.N, G_, bx);
            pg8::EpiStoreBf16 E{Oop, Nmain, ph == 8 ? 1 : 0, gate};
            pg8::gemm_phase<pg8::EpiStoreBf16, pg8::StaticOrder, true, true>(L, g, S, E);
            __syncthreads(); }
        } else if (ph == 2) {
            LAS float* gw_s = (LAS float*)L; LAS float* gb_s = gw_s + 4096; LAS float* qg_s = gb_s + 256;
            if (tid < 256) gb_s[tid] = in_ggb[layer * 256 + tid];
            if (tid < 128) qg_s[tid] = in_qkg[layer * 128 + tid];
            __syncthreads();
            const float C2 = 0.125f * 1.4426950408889634f, KSC = 0.17677669529663687f;
            const f32x2* TAB = (const f32x2*)(ws + WS_TAB);
            const int r_head = lane >> 4, r_pi = lane & 15, r_j = r_pi & 7; const bool r_isrow = r_pi < 8; const int r_da = r_isrow ? r_j : 16 + r_j, r_db = r_da + 8;
            const int a_sub = lane & 7, a_hh = lane >> 3; const bool a_isrow = a_sub < 4; const int a_jb = a_isrow ? 4 * a_sub : 4 * a_sub - 16, a_da = a_isrow ? 4 * a_sub : 4 * a_sub + 16, a_db = a_da + 16;
            struct PostRaw { unsigned rq0, rq1, rk0, rk1; u32x2 gz; u32x2 aq0, aq1, ak0, ak1; u32x4 av; f32x2 t2; f32x4 t0, t1; };
#define POST_LOAD(R, mm) do { const u16* rp_ = P + (size_t)(mm) * NPAD; const int t_ = (mm) & 16383; const bool lat_ = (mm) < M_LAT; \
                R.rq0 = rp_[C_RQ + r_head * 32 + r_da]; R.rq1 = rp_[C_RQ + r_head * 32 + r_db]; R.rk0 = rp_[C_RK + r_head * 32 + r_da]; R.rk1 = rp_[C_RK + r_head * 32 + r_db]; \
                R.gz = *(const u32x2*)(rp_ + C_Z + 4 * lane); \
                R.aq0 = (u32x2){0u, 0u}; R.aq1 = (u32x2){0u, 0u}; \
                R.ak0 = *(const u32x2*)(rp_ + C_AK + (a_hh & 1) * 64 + a_da); R.ak1 = *(const u32x2*)(rp_ + C_AK + (a_hh & 1) * 64 + a_db); \
                R.av = *(const u32x4*)(rp_ + C_AV + (lane & 15) * 8); \
                R.t2 = (f32x2){1.f, 0.f}; R.t0 = (f32x4){1.f, 0.f, 1.f, 0.f}; R.t1 = (f32x4){1.f, 0.f, 1.f, 0.f}; \
                if (lat_) { R.t2 = TAB[(r_isrow ? (t_ >> 6) : (t_ & 63)) * 16 + 2 * r_j]; const f32x4* tp_ = (const f32x4*)(TAB + (a_isrow ? (t_ >> 6) : (t_ & 63)) * 16 + a_jb); R.t0 = tp_[0]; R.t1 = tp_[1]; } } while (0)
            PostRaw cur{};
            POST_LOAD(cur, gw);
            for (int m = gw; m < M_ALL; m += NGW) {
                PostRaw nxt = cur; const int mn = m + NGW;
                if (mn < M_ALL) POST_LOAD(nxt, mn);
                u16* rowp = P + (size_t)m * NPAD;
                const int kvb = m < M_LAT ? (m >> 14) : ((m - M_LAT) >> 8), kvt = m < M_LAT ? ((m & 16383) >> 6) : 256 + (((m - M_LAT) & 255) >> 6), kvr = m & 63;
                const size_t kvbase = ((size_t)(kvb * 2) * 260 + kvt) * 4096;
                {   const float cs = cur.t2.x, sn = cur.t2.y;
                    const float qa = bf2f(cur.rq0), qb_ = bf2f(cur.rq1), ka = bf2f(cur.rk0), kb_ = bf2f(cur.rk1);
                    const unsigned qo = pk2(qa * cs - qb_ * sn, qa * sn + qb_ * cs), ko = pk2((ka * cs - kb_ * sn) * KSC, (ka * sn + kb_ * cs) * KSC);
                    u16* qs = rowp + C_RQ + r_head * 32; u16* ks_ = rowp + C_RK + r_head * 32;
                    qs[r_da] = (u16)(qo & 0xffffu); qs[r_db] = (u16)(qo >> 16); ks_[r_da] = (u16)(ko & 0xffffu); ks_[r_db] = (u16)(ko >> 16);
                }
                {   const f32x4 bv = *(const LAS f32x4*)(gb_s + 4 * lane);
                    f32x4 g; g.x = logsig(bflo(cur.gz.x) + bv.x) * (1.f / 16.f); g.y = logsig(bfhi(cur.gz.x) + bv.y) * (1.f / 16.f); g.z = logsig(bflo(cur.gz.y) + bv.z) * (1.f / 16.f); g.w = logsig(bfhi(cur.gz.y) + bv.w) * (1.f / 16.f);
                    *(f32x4*)(GT + (size_t)m * 256 + 4 * lane) = g; }
                {   const float cs[4] = {cur.t0.x, cur.t0.z, cur.t1.x, cur.t1.z}, sn[4] = {cur.t0.y, cur.t0.w, cur.t1.y, cur.t1.w};
#pragma unroll
                    for (int pass = 1; pass < 2; ++pass) {
                        const int hd = pass == 0 ? a_hh : (a_hh & 1);
                        const u32x2 wa = pass == 0 ? cur.aq0 : cur.ak0, wb = pass == 0 ? cur.aq1 : cur.ak1;
                        float xa[4] = {bflo(wa.x), bfhi(wa.x), bflo(wa.y), bfhi(wa.y)}, xb[4] = {bflo(wb.x), bfhi(wb.x), bflo(wb.y), bfhi(wb.y)};
                        float ss = 0.f;
#pragma unroll
                        for (int e = 0; e < 4; ++e) ss += xa[e] * xa[e] + xb[e] * xb[e];
                        ss += xor_lane<1>(ss); ss += xor_lane<2>(ss); ss += xor_lane<4>(ss);
                        const float rstd = rsqrtf(ss * (1.f / 64.f) + NEPS); const float osc = pass == 0 ? C2 : 1.f;
                        float oa[4], ob[4];
#pragma unroll
                        for (int e = 0; e < 4; ++e) { const float ya = xa[e] * rstd * qg_s[pass * 64 + a_da + e], yb = xb[e] * rstd * qg_s[pass * 64 + a_db + e];
                            oa[e] = (ya * cs[e] - yb * sn[e]) * osc; ob[e] = (ya * sn[e] + yb * cs[e]) * osc; }
                        u32x2 pa, pb; pa.x = pk2(oa[0], oa[1]); pa.y = pk2(oa[2], oa[3]); pb.x = pk2(ob[0], ob[1]); pb.y = pk2(ob[2], ob[3]);
                        if (pass == 0) { u16* dp = QB + (size_t)m * 512 + hd * 64; *(u32x2*)(dp + a_da) = pa; *(u32x2*)(dp + a_db) = pb; }
                        else if (lane < 16) { u16* dp = KB + kvbase + (size_t)hd * (260 * 4096) + kvr * 8;
                            *(u32x2*)(dp + (a_da >> 3) * 512 + (a_da & 7)) = pa; *(u32x2*)(dp + (a_db >> 3) * 512 + (a_db & 7)) = pb; }
                    }
                    if (lane < 16) { const int cc = (lane & 7) * 8, vw_ = (cc >> 5) * 4 + (kvr >> 4), vl_ = (kvr & 15) * 4 + ((cc & 31) >> 3);
                        *(u32x4*)(VB + kvbase + (size_t)(lane >> 3) * (260 * 4096) + (vw_ * 64 + vl_) * 8) = cur.av; }
                }
                cur = nxt;
            }
#undef POST_LOAD
        } else if (ph == 3) {
            for (int rep_ = 0; rep_ < REP_S1; ++rep_) {

            LAS unsigned char* Lw = L + wave * 18048;
            LAS float* Bc = (LAS float*)Lw; LAS u16* KT = (LAS u16*)Lw;
            LAS u16* VT = (LAS u16*)(Lw + 8704); LAS float* tot = (LAS float*)(Lw + 8704 + 9216);
            const int nn = lane & 15, kk = lane >> 4;
            for (int item = gw; item < N_ITEM1; item += NGW) {
                const int cidx = item % 260, t = item / 260, h = t & 3, b = (t >> 2) & 1, dir = (t >> 3) & 1, grp = t >> 4;
                const int row0 = cidx < 4 ? M_LAT + b * 256 + cidx * 64 : b * 16384 + (cidx - 4) * 64;
                const u16* Pr = P + (size_t)(row0 + lane) * NPAD;
                const int kcol = (grp ? C_GK : C_RK) + h * 32, vcol = (grp ? C_GV : C_RV) + h * 64;
                u32x4 kr[4], vr[8];
#pragma unroll
                for (int q = 0; q < 4; ++q) kr[q] = *(const u32x4*)(Pr + kcol + 8 * q);
#pragma unroll
                for (int q = 0; q < 8; ++q) vr[q] = *(const u32x4*)(Pr + vcol + 8 * q);
                float lg = 0.f;
                if (grp == 0) lg = logsig(in_retl[layer * 8 + dir * 4 + h]);
                else {
                    const int d = lane & 31, half = lane >> 5; float* gp = GT + (size_t)row0 * 256 + dir * 128 + h * 32 + d; float run = 0.f;
                    float gv[32];
#pragma unroll
                    for (int i = 0; i < 32; ++i) gv[i] = gp[(size_t)(32 * half + i) * 256];
                    if (dir == 0) {
#pragma unroll
                        for (int i = 0; i < 32; ++i) { run += gv[i]; gv[i] = run; }
                    } else {
#pragma unroll
                        for (int i = 31; i >= 0; --i) { run += gv[i]; gv[i] = run; }
                    }
                    const float other = other_half(run);
                    const float addv = (dir == 0) ? (half == 1 ? other : 0.f) : (half == 0 ? other : 0.f);
#pragma unroll
                    for (int i = 0; i < 32; ++i) { const float full = gv[i] + addv; Bc[(32 * half + i) * 34 + d] = full; gp[(size_t)(32 * half + i) * 256] = full; }
                    if (half == 0) tot[d] = run + other;
                    LDS_WAIT(); asm volatile("" ::: "memory");
                }
                float fac[32];
                if (grp == 0) { const float f = __expf((dir == 0 ? (float)(63 - lane) : (float)lane) * lg);
#pragma unroll
                    for (int d = 0; d < 32; ++d) fac[d] = f;
                } else {
#pragma unroll
                    for (int q = 0; q < 16; ++q) { const f32x2 bc = *(const LAS f32x2*)(Bc + lane * 34 + 2 * q); const f32x2 tt = *(const LAS f32x2*)(tot + 2 * q);
                        fac[2 * q] = __expf(tt.x - bc.x); fac[2 * q + 1] = __expf(tt.y - bc.y); }
                    LDS_WAIT(); asm volatile("" ::: "memory");
                }
#pragma unroll
                for (int q = 0; q < 4; ++q) { const unsigned w[4] = {kr[q].x, kr[q].y, kr[q].z, kr[q].w};
#pragma unroll
                    for (int c = 0; c < 4; ++c) { const int d = 8 * q + 2 * c; const unsigned pk = pk2(bflo(w[c]) * fac[d], bfhi(w[c]) * fac[d + 1]);
                        KT[d * 72 + lane] = (u16)(pk & 0xffffu); KT[(d + 1) * 72 + lane] = (u16)(pk >> 16); } }
#pragma unroll
                for (int q = 0; q < 8; ++q) { const unsigned w[4] = {vr[q].x, vr[q].y, vr[q].z, vr[q].w};
#pragma unroll
                    for (int c = 0; c < 4; ++c) { const int e = 8 * q + 2 * c; VT[e * 72 + lane] = (u16)(w[c] & 0xffffu); VT[(e + 1) * 72 + lane] = (u16)(w[c] >> 16); } }
                LDS_WAIT(); asm volatile("" ::: "memory");
                f32x4 acc[4][2];
#pragma unroll
                for (int a = 0; a < 4; ++a) { acc[a][0] = (f32x4){0.f, 0.f, 0.f, 0.f}; acc[a][1] = (f32x4){0.f, 0.f, 0.f, 0.f}; }
#pragma unroll
                for (int ks = 0; ks < 2; ++ks) {
                    const mbf16x8 b0 = *(const LAS mbf16x8*)(KT + nn * 72 + 32 * ks + 8 * kk), b1 = *(const LAS mbf16x8*)(KT + (16 + nn) * 72 + 32 * ks + 8 * kk);
#pragma unroll
                    for (int mt = 0; mt < 4; ++mt) { const mbf16x8 a = *(const LAS mbf16x8*)(VT + (16 * mt + nn) * 72 + 32 * ks + 8 * kk);
                        acc[mt][0] = __builtin_amdgcn_mfma_f32_16x16x32_bf16(a, b0, acc[mt][0], 0, 0, 0); acc[mt][1] = __builtin_amdgcn_mfma_f32_16x16x32_bf16(a, b1, acc[mt][1], 0, 0, 0); }
                }
                float* o = AS + (size_t)item * 2048;
#pragma unroll
                for (int mt = 0; mt < 4; ++mt)
#pragma unroll
                    for (int nt = 0; nt < 2; ++nt)
#pragma unroll
                        for (int r = 0; r < 4; ++r) o[(16 * mt + 4 * kk + r) * 32 + 16 * nt + nn] = acc[mt][nt][r];
                if (lane < 32) DEC[(size_t)item * 32 + lane] = grp == 0 ? __expf(64.f * lg) : __expf(tot[lane]);
                LDS_WAIT(); asm volatile("" ::: "memory");
            }
            __syncthreads(); }
        } else if (ph == 4) {
            const int gt_ = bx * 512 + tid;
            for (int rep_ = 0; rep_ < REP_S2; ++rep_)
            if (gt_ < 32 * 2048) {
                const int seq = gt_ >> 11, elem = gt_ & 2047, d = elem & 31, dir = (seq >> 3) & 1;
                float* base = AS + (size_t)seq * 260 * 2048 + elem; const float* dbase = DEC + (size_t)seq * 260 * 32 + d;
                float S = 0.f;
                for (int n0 = 0; n0 < 260; n0 += 52) {
                    float a[52], dc[52];
#pragma unroll
                    for (int q = 0; q < 52; ++q) { const int n = n0 + q; const int ci = dir == 0 ? n : (n < 4 ? 3 - n : 263 - n); a[q] = base[(size_t)ci * 2048]; dc[q] = dbase[(size_t)ci * 32]; }
#pragma unroll
                    for (int q = 0; q < 52; ++q) { const int n = n0 + q; const int ci = dir == 0 ? n : (n < 4 ? 3 - n : 263 - n); (rep_ + 1 < REP_S2 ? base + 17039360 : base)[(size_t)ci * 2048] = S; S = dc[q] * S + a[q]; }
                }
            }
        } else if (ph == 5) {
            for (int rep_ = 0; rep_ < REP_S3; ++rep_) {
                const int slot = wave >> 2, w4 = wave & 3, t4 = tid & 255;
                LAS u16* KFs = (LAS u16*)(L + slot * 32768); LAS u16* KBs = KFs + 64 * 40; LAS u16* VT = KBs + 64 * 40; LAS u16* ST = VT + 64 * 72;
                const int nn = lane & 15, kk = lane >> 4;
                for (int pr = bx; pr < N_ITEM3 / 2; pr += G_) {
                    const int item = pr * 2 + slot;
                    const int cidx = item % 260, t = item / 260, h = t & 3, b = (t >> 2) & 1, grp = t >> 3;
                    const int row0 = cidx < 4 ? M_LAT + b * 256 + cidx * 64 : b * 16384 + (cidx - 4) * 64;
                    const u16* Pr = P + (size_t)row0 * NPAD;
                    const int qcol = (grp ? C_GQ : C_RQ) + h * 32, kcol = (grp ? C_GK : C_RK) + h * 32, vcol = (grp ? C_GV : C_RV) + h * 64, gcol = (grp ? C_GG : C_RG) + h * 64;
                    const size_t itF = (size_t)((((grp * 2 + 0) * 2 + b) * 4 + h) * 260 + cidx), itB = (size_t)((((grp * 2 + 1) * 2 + b) * 4 + h) * 260 + cidx);
                    const float lgf = logsig(in_retl[layer * 8 + h]), lgb = logsig(in_retl[layer * 8 + 4 + h]);
                    const int jr = t4 >> 2, d0 = (t4 & 3) * 8, iq = 16 * w4 + nn;
                    const u32x4 qw = *(const u32x4*)(Pr + (size_t)iq * NPAD + qcol + 8 * kk);
                    const u32x4 kw = *(const u32x4*)(Pr + (size_t)jr * NPAD + kcol + d0);
                    const u32x4 va = *(const u32x4*)(Pr + (size_t)jr * NPAD + vcol + (t4 & 3) * 16), vb = *(const u32x4*)(Pr + (size_t)jr * NPAD + vcol + (t4 & 3) * 16 + 8);
                    const f32x4 sf0 = *(const f32x4*)(AS + itF * 2048 + t4 * 8), sf1 = *(const f32x4*)(AS + itF * 2048 + t4 * 8 + 4);
                    const f32x4 sb0 = *(const f32x4*)(AS + itB * 2048 + t4 * 8), sb1 = *(const f32x4*)(AS + itB * 2048 + t4 * 8 + 4);
                    u16 graw[4][4];
#pragma unroll
                    for (int r = 0; r < 4; ++r)
#pragma unroll
                        for (int et = 0; et < 4; ++et) graw[r][et] = Pr[(size_t)(16 * w4 + 4 * kk + r) * NPAD + gcol + nn + 16 * et];
                    f32x4 bq[4], bk[4];
#pragma unroll
                    for (int s = 0; s < 4; ++s) { bq[s] = (f32x4){0.f, 0.f, 0.f, 0.f}; bk[s] = (f32x4){0.f, 0.f, 0.f, 0.f}; }
                    if (grp == 1) { const float* gq = GT + (size_t)(row0 + iq) * 256 + h * 32 + 8 * kk; const float* gk = GT + (size_t)(row0 + jr) * 256 + h * 32 + d0;
                        bq[0] = *(const f32x4*)gq; bq[1] = *(const f32x4*)(gq + 4); bq[2] = *(const f32x4*)(gq + 128); bq[3] = *(const f32x4*)(gq + 132);
                        bk[0] = *(const f32x4*)gk; bk[1] = *(const f32x4*)(gk + 4); bk[2] = *(const f32x4*)(gk + 128); bk[3] = *(const f32x4*)(gk + 132); }
                    else { const float ef = (float)(iq + 1) * lgf, eb = (float)(64 - iq) * lgb, kf = (float)(jr + 1) * lgf, kb = (float)(64 - jr) * lgb;
                        bq[0] = bq[1] = (f32x4){ef, ef, ef, ef}; bq[2] = bq[3] = (f32x4){eb, eb, eb, eb}; bk[0] = bk[1] = (f32x4){kf, kf, kf, kf}; bk[2] = bk[3] = (f32x4){kb, kb, kb, kb}; }
                    mbf16x8 qfr_f, qfr_b;
                    {   const float qs = grp ? 0.17677669529663687f : 1.f;
                        const float qx[8] = {bflo(qw.x) * qs, bfhi(qw.x) * qs, bflo(qw.y) * qs, bfhi(qw.y) * qs, bflo(qw.z) * qs, bfhi(qw.z) * qs, bflo(qw.w) * qs, bfhi(qw.w) * qs};
                        u32x4 pf, pb;
                        pf.x = pk2(qx[0] * __expf(bq[0].x), qx[1] * __expf(bq[0].y)); pf.y = pk2(qx[2] * __expf(bq[0].z), qx[3] * __expf(bq[0].w));
                        pf.z = pk2(qx[4] * __expf(bq[1].x), qx[5] * __expf(bq[1].y)); pf.w = pk2(qx[6] * __expf(bq[1].z), qx[7] * __expf(bq[1].w));
                        pb.x = pk2(qx[0] * __expf(bq[2].x), qx[1] * __expf(bq[2].y)); pb.y = pk2(qx[2] * __expf(bq[2].z), qx[3] * __expf(bq[2].w));
                        pb.z = pk2(qx[4] * __expf(bq[3].x), qx[5] * __expf(bq[3].y)); pb.w = pk2(qx[6] * __expf(bq[3].z), qx[7] * __expf(bq[3].w));
                        qfr_f = __builtin_bit_cast(mbf16x8, pf); qfr_b = __builtin_bit_cast(mbf16x8, pb); }
                    {   const float kx[8] = {bflo(kw.x), bfhi(kw.x), bflo(kw.y), bfhi(kw.y), bflo(kw.z), bfhi(kw.z), bflo(kw.w), bfhi(kw.w)};
                        u32x4 pf, pb;
                        pf.x = pk2(kx[0] * __expf(-bk[0].x), kx[1] * __expf(-bk[0].y)); pf.y = pk2(kx[2] * __expf(-bk[0].z), kx[3] * __expf(-bk[0].w));
                        pf.z = pk2(kx[4] * __expf(-bk[1].x), kx[5] * __expf(-bk[1].y)); pf.w = pk2(kx[6] * __expf(-bk[1].z), kx[7] * __expf(-bk[1].w));
                        pb.x = pk2(kx[0] * __expf(-bk[2].x), kx[1] * __expf(-bk[2].y)); pb.y = pk2(kx[2] * __expf(-bk[2].z), kx[3] * __expf(-bk[2].w));
                        pb.z = pk2(kx[4] * __expf(-bk[3].x), kx[5] * __expf(-bk[3].y)); pb.w = pk2(kx[6] * __expf(-bk[3].z), kx[7] * __expf(-bk[3].w));
                        *(LAS u32x4*)(KFs + jr * 40 + d0) = pf; *(LAS u32x4*)(KBs + jr * 40 + d0) = pb;
                        u32x4 s0, s1; s0.x = pk2(sf0.x, sf0.y); s0.y = pk2(sf0.z, sf0.w); s0.z = pk2(sf1.x, sf1.y); s0.w = pk2(sf1.z, sf1.w);
                        s1.x = pk2(sb0.x, sb0.y); s1.y = pk2(sb0.z, sb0.w); s1.z = pk2(sb1.x, sb1.y); s1.w = pk2(sb1.z, sb1.w);
                        *(LAS u32x4*)(ST + jr * 72 + d0) = s0; *(LAS u32x4*)(ST + jr * 72 + 32 + d0) = s1;
                        const int c0 = (t4 & 3) * 16; const unsigned vw[8] = {va.x, va.y, va.z, va.w, vb.x, vb.y, vb.z, vb.w};
#pragma unroll
                        for (int q = 0; q < 8; ++q) { VT[(c0 + 2 * q) * 72 + jr] = (u16)(vw[q] & 0xffffu); VT[(c0 + 2 * q + 1) * 72 + jr] = (u16)(vw[q] >> 16); } }
                    __syncthreads();
                    const f32x4 z4 = (f32x4){0.f, 0.f, 0.f, 0.f};
                    f32x4 sc[4];
#pragma unroll
                    for (int jt = 0; jt < 4; ++jt) {
                        const mbf16x8 kf_ = *(const LAS mbf16x8*)(KFs + (16 * jt + nn) * 40 + 8 * kk), kb_ = *(const LAS mbf16x8*)(KBs + (16 * jt + nn) * 40 + 8 * kk);
                        if (jt < w4) sc[jt] = __builtin_amdgcn_mfma_f32_16x16x32_bf16(kf_, qfr_f, z4, 0, 0, 0);
                        else if (jt > w4) sc[jt] = __builtin_amdgcn_mfma_f32_16x16x32_bf16(kb_, qfr_b, z4, 0, 0, 0);
                        else { const f32x4 a = __builtin_amdgcn_mfma_f32_16x16x32_bf16(kf_, qfr_f, z4, 0, 0, 0), c = __builtin_amdgcn_mfma_f32_16x16x32_bf16(kb_, qfr_b, z4, 0, 0, 0);
#pragma unroll
                            for (int r = 0; r < 4; ++r) sc[jt][r] = (4 * kk + r <= nn) ? a[r] : c[r]; }
                    }
                    f32x4 O[4];
#pragma unroll
                    for (int et = 0; et < 4; ++et) O[et] = z4;
#pragma unroll
                    for (int p2 = 0; p2 < 2; ++p2) {
                        u32x4 pa; pa.x = pk2(sc[2 * p2][0], sc[2 * p2][1]); pa.y = pk2(sc[2 * p2][2], sc[2 * p2][3]); pa.z = pk2(sc[2 * p2 + 1][0], sc[2 * p2 + 1][1]); pa.w = pk2(sc[2 * p2 + 1][2], sc[2 * p2 + 1][3]);
                        const mbf16x8 af = __builtin_bit_cast(mbf16x8, pa);
#pragma unroll
                        for (int et = 0; et < 4; ++et) { const LAS u16* vp = VT + (16 * et + nn) * 72 + 32 * p2 + 4 * kk;
                            const u32x2 lo = *(const LAS u32x2*)vp, hi = *(const LAS u32x2*)(vp + 16); u32x4 pbv; pbv.x = lo.x; pbv.y = lo.y; pbv.z = hi.x; pbv.w = hi.y;
                            O[et] = __builtin_amdgcn_mfma_f32_16x16x32_bf16(af, __builtin_bit_cast(mbf16x8, pbv), O[et], 0, 0, 0); }
                    }
#pragma unroll
                    for (int et = 0; et < 4; ++et) { const LAS u16* sp = ST + (16 * et + nn) * 72 + 8 * kk;
                        O[et] = __builtin_amdgcn_mfma_f32_16x16x32_bf16(qfr_f, *(const LAS mbf16x8*)sp, O[et], 0, 0, 0);
                        O[et] = __builtin_amdgcn_mfma_f32_16x16x32_bf16(qfr_b, *(const LAS mbf16x8*)(sp + 32), O[et], 0, 0, 0); }
#pragma unroll
                    for (int r = 0; r < 4; ++r) { const int i = 16 * w4 + 4 * kk + r;
                        float x0 = O[0][r], x1 = O[1][r], x2 = O[2][r], x3 = O[3][r];
                        if (grp == 0) { float sm = (x0 + x1) + (x2 + x3); sm += xor_lane<1>(sm); sm += xor_lane<2>(sm); sm += xor_lane<4>(sm); sm += xor_lane<8>(sm);
                            const float mean = sm * (1.f / 64.f); x0 -= mean; x1 -= mean; x2 -= mean; x3 -= mean; }
                        float sq = (x0 * x0 + x1 * x1) + (x2 * x2 + x3 * x3); sq += xor_lane<1>(sq); sq += xor_lane<2>(sq); sq += xor_lane<4>(sq); sq += xor_lane<8>(sq);
                        const float rs = rsqrtf(sq * (1.f / 64.f) + NEPS);
                        const float xs[4] = {x0 * rs, x1 * rs, x2 * rs, x3 * rs};
                        u16* yp = XNY + (size_t)(row0 + i) * 1024 + grp * 256 + h * 64 + nn;
#pragma unroll
                        for (int et = 0; et < 4; ++et) { const float gate = bf2f(graw[r][et]); const float sg = gate * __builtin_amdgcn_rcpf(1.f + __expf(-gate)); yp[16 * et] = (u16)(pk2(sg * xs[et], 0.f) & 0xffffu); } }
                    __syncthreads();
                }
            }
            if (__builtin_amdgcn_readfirstlane(threadIdx.x) >= 256) __builtin_amdgcn_s_setprio(1);
            for (int rep_ = 0; rep_ < REP_ATT; ++rep_) {
                const int per = (1024 + G_ - 1) / G_;
                float gq_ = fabsf(in_qkg[layer * 128 + lane]), gk_ = fabsf(in_qkg[layer * 128 + 64 + lane]);
                gq_ = fmaxf(gq_, xor_lane<1>(gq_)); gq_ = fmaxf(gq_, xor_lane<2>(gq_)); gq_ = fmaxf(gq_, xor_lane<4>(gq_)); gq_ = fmaxf(gq_, xor_lane<8>(gq_)); gq_ = fmaxf(gq_, xor_lane<16>(gq_)); gq_ = fmaxf(gq_, other_half(gq_));
                gk_ = fmaxf(gk_, xor_lane<1>(gk_)); gk_ = fmaxf(gk_, xor_lane<2>(gk_)); gk_ = fmaxf(gk_, xor_lane<4>(gk_)); gk_ = fmaxf(gk_, xor_lane<8>(gk_)); gk_ = fmaxf(gk_, xor_lane<16>(gk_)); gk_ = fmaxf(gk_, other_half(gk_));
                const bool fixref = __builtin_amdgcn_readfirstlane((8.f * 1.4426950408889634f * 1.05f) * gq_ * gk_ < 40.f ? 1 : 0) != 0;
                for (int i = 0; i <= per; ++i) {
                    const u16 *Qw0 = P, *Kl = KB, *Vl = VB; u16* Ow0 = XNY; int NT = 4, tq0 = 0; bool rope = false;
                    if (i < per) { const int U = vcu * per + i; if (U >= 1024) continue;
                        const int bkv = U >> 8, g = (U >> 6) & 3, qb = U & 63, b = bkv >> 1, kvh = bkv & 1, h = kvh * 4 + g; const size_t qrow0 = (size_t)b * 16384 + (size_t)qb * 256;
                        Qw0 = P + qrow0 * NPAD + C_AQ + h * 64; tq0 = (int)qrow0; rope = true; Kl = KB + (size_t)(b * 2 + kvh) * (260 * 4096); Vl = VB + (size_t)(b * 2 + kvh) * (260 * 4096);
                        Ow0 = XNY + qrow0 * 1024 + 512 + h * 64; NT = 260;
                    } else { if (layer != 0 || vcu >= 16) break;
                        const int b = vcu >> 3, h = vcu & 7, kvh = h >> 2; const size_t qrow0 = (size_t)(M_LAT + b * 256);
                        Qw0 = P + qrow0 * NPAD + C_AQ + h * 64; tq0 = 0; rope = false; Kl = KB + ((size_t)(b * 2 + kvh) * 260 + 256) * 4096; Vl = VB + ((size_t)(b * 2 + kvh) * 260 + 256) * 4096;
                        Ow0 = XNY + qrow0 * 1024 + 512 + h * 64; NT = 4; }
                    const float* gqp = in_qkg + layer * 128; const float* tabp = rope ? (const float*)(ws + WS_TAB) : (const float*)nullptr;
                    if (fixref) attn_body::attn_unit<8, true>(gqp, tabp, tq0, (const attn_body::bf16*)Qw0, (const attn_body::bf16*)Kl, (const attn_body::bf16*)Vl, NT, (attn_body::bf16*)Ow0, (char*)lds);
                    else attn_body::attn_unit<8, false>(gqp, tabp, tq0, (const attn_body::bf16*)Qw0, (const attn_body::bf16*)Kl, (const attn_body::bf16*)Vl, NT, (attn_body::bf16*)Ow0, (char*)lds);
                }
            }
            __builtin_amdgcn_s_setprio(0);
        }
        for (int rep_ = 0; rep_ < REP_SYNC; ++rep_) xcd_barrier(bar);
    }
    PHASE_IDS
    PHASE_PTRS
    for (int m = gw; m < M_LAT; m += NGW) {
        float* src = xlat + (size_t)m * 1024; f32x4 v[4]; float ss = 0.f;
        const u16* ya = (const u16*)(ws + WS_YA) + (size_t)m * 1024; const u16* yb = XNY + (size_t)m * 1024;
#pragma unroll
        for (int j = 0; j < 4; ++j) { v[j] = *(const f32x4*)(src + 4 * lane + 256 * j);
            const u32x2 y = *(const u32x2*)(ya + 4 * lane + 256 * j), z = *(const u32x2*)(yb + 4 * lane + 256 * j);
            v[j] = v[j] + (f32x4){bflo(y.x), bfhi(y.x), bflo(y.y), bfhi(y.y)} + (f32x4){bflo(z.x), bfhi(z.x), bflo(z.y), bfhi(z.y)};
            ss += (v[j].x * v[j].x + v[j].y * v[j].y) + (v[j].z * v[j].z + v[j].w * v[j].w); }
        const float rstd = 1.0f / sqrtf(wave_sum(ss) * (1.f / 1024.f) + NEPS);
#pragma unroll
        for (int j = 0; j < 4; ++j) { const f32x4 gv = *(const f32x4*)(in_fng + 4 * lane + 256 * j); __builtin_nontemporal_store((v[j] * rstd) * gv, (f32x4*)(src + 4 * lane + 256 * j)); }
    }
}

extern "C" void kernel_launch(void* const* d_in, const int* in_sizes, int n_in, void* d_out, int out_size, void* d_ws, size_t ws_size, hipStream_t stream) {
    static int grid_blocks = 0;
    if (grid_blocks == 0) {
        if (n_in != 17 || ws_size < 512 * MiB) { fprintf(stderr, "kernel_launch: unexpected n_in %d / ws %zu\n", n_in, ws_size); grid_blocks = -1; return; }
        int dev = 0, cus = 0, per_cu = 0;
        hipGetDevice(&dev); hipDeviceGetAttribute(&cus, hipDeviceAttributeMultiprocessorCount, dev);
        if (hipFuncSetAttribute((const void*)fwd_megakernel, hipFuncAttributeMaxDynamicSharedMemorySize, LDS_BYTES) != hipSuccess) { fprintf(stderr, "kernel_launch: hipFuncSetAttribute failed\n"); }
        if (hipOccupancyMaxActiveBlocksPerMultiprocessor(&per_cu, (const void*)fwd_megakernel, 512, LDS_BYTES) != hipSuccess || per_cu < 1) { fprintf(stderr, "kernel_launch: occupancy query gave %d\n", per_cu); per_cu = 1; }
        (void)hipGetLastError();
        if (per_cu > 1) per_cu = 1;
        grid_blocks = cus * per_cu;
    }
    if (grid_blocks < 0) return;
    Args a{};
    for (int i = 0; i < 17; ++i) a.in[i] = (const float*)d_in[i];
    a.out = (float*)d_out; a.ws = (unsigned char*)d_ws;
    if (hipMemsetAsync((char*)d_ws + WS_BAR, 0, WS_BAR_BYTES, stream) != hipSuccess) { fprintf(stderr, "kernel_launch: memset failed\n"); return; }
    void* kargs[] = {&a};
    hipError_t e = hipLaunchCooperativeKernel((const void*)fwd_megakernel, dim3(grid_blocks), dim3(512), kargs, LDS_BYTES, stream);
    if (e != hipSuccess) fprintf(stderr, "cooperative launch failed: %s (grid %d)\n", hipGetErrorString(e), grid_blocks);
}
```

```cpp
#include <hip/hip_runtime.h>
#include <hip/hip_cooperative_groups.h>
#include <cstdio>
#include <cstdint>
namespace cg = cooperative_groups;
namespace pg8 {
#define PG8_LAS __attribute__((address_space(3)))
typedef unsigned short bf16_t;
typedef short bf16x8 __attribute__((ext_vector_type(8)));
typedef float f32x4 __attribute__((ext_vector_type(4)));
typedef unsigned u32x4 __attribute__((ext_vector_type(4)));
constexpr int BM = 256, BK = 64, HALF = 128, HTB = HALF * BK * 2  , STAGE_BYTES = 8 * HTB, NXCD = 8, WGM = 8;

__host__ __device__ __forceinline__ int lds_byte(int r, int c) { const int st = (r >> 4) * 2 + (c >> 5), rr = r & 15, cc = c & 31, ob = rr * 64 + cc * 2; return st * 1024 + (ob ^ (((ob >> 9) & 1) << 5)); }
__host__ __device__ __forceinline__ void stage_rc(int b, int& R, int& C) { const int st = b / 1024, sb = b % 1024, swz = sb ^ (((sb >> 9) & 1) << 5); R = (st >> 1) * 16 + swz / 64; C = (st & 1) * 32 + (swz % 64) / 2; }
__host__ __device__ __forceinline__ int perm32(int rho) { const int n = rho >> 4, i = rho & 15; return 8 * (i >> 2) + 4 * n + (i & 3); }

struct Unit { int pm, pn; };
struct Gemm { const bf16_t* A; const bf16_t* Bt; int M, N, K; };

struct StaticOrder {
    int nM, nN, nwg, G, c;
    __host__ __device__ void init(int M, int N, int G_, int c_) { nM = M / BM; nN = N / BM; nwg = nM * nN; G = G_; c = c_; }
    __host__ __device__ bool next(int i, Unit& u) const {
        const long L = (long)i * G + c; if (L >= nwg) return false;
        int wgid = (int)L; { const int q = nwg / NXCD, r = nwg % NXCD, xcd = wgid % NXCD, off = wgid / NXCD; wgid = (xcd < r ? xcd * (q + 1) : r * (q + 1) + (xcd - r) * q) + off; }
        const int nig = WGM * nN, gid = wgid / nig, fm = gid * WGM, gsz = (nM - fm) < WGM ? (nM - fm) : WGM;
        u.pm = fm + ((wgid % nig) % gsz); u.pn = (wgid % nig) / gsz; return true;
    }
    __device__ __forceinline__ void a_ready(const Unit&) const {}
    __device__ __forceinline__ void done(const Unit&) const {}
};

__device__ __forceinline__ unsigned cvt_pk_bf16(float lo, float hi) { unsigned r; asm volatile("v_cvt_pk_bf16_f32 %0, %1, %2" : "=v"(r) : "v"(lo), "v"(hi)); return r; }
typedef float f32x2 __attribute__((ext_vector_type(2)));
struct EpiStoreBf16 {
    static constexpr bool PERM = true, AFTER_DRAIN = false;
    bf16_t* O; int ldc; int act; const float* gate;
    __device__ __forceinline__ void operator()(const f32x4 (&acc)[2][2][4][2], const Unit& u, int wr, int wc, int fr, int fq) const {
        const int row0 = u.pm * BM + wr * 64 + fr; const int col0 = u.pn * BM + wc * 32 + 8 * fq;
        f32x4 gv[2][2];
        if (gate) { const float* g = gate + (u.pm >> 6) * 6144 + col0;
#pragma unroll
            for (int bj = 0; bj < 2; ++bj) { gv[bj][0] = *(const f32x4*)(g + bj * HALF); gv[bj][1] = *(const f32x4*)(g + bj * HALF + 4); } }
#pragma unroll
        for (int ai = 0; ai < 2; ++ai)
#pragma unroll
            for (int m = 0; m < 4; ++m) { bf16_t* rowp = O + (size_t)(row0 + ai * HALF + m * 16) * ldc + col0;
#pragma unroll
                for (int bj = 0; bj < 2; ++bj) { f32x4 v0 = acc[ai][bj][m][0], v1 = acc[ai][bj][m][1];
                    if (gate) { v0 = v0 * gv[bj][0]; v1 = v1 * gv[bj][1]; }
                    if (act == 1) {
#pragma unroll
                        for (int e = 0; e < 4; ++e) { float a = fmaxf(v0[e], 0.f), b = fmaxf(v1[e], 0.f); v0[e] = a * a; v1[e] = b * b; } }
                    u32x4 w; w.x = cvt_pk_bf16(v0[0], v0[1]); w.y = cvt_pk_bf16(v0[2], v0[3]); w.z = cvt_pk_bf16(v1[0], v1[1]); w.w = cvt_pk_bf16(v1[2], v1[3]);
                    *(u32x4*)(rowp + bj * HALF) = w; } }
    }
};
struct EpiResid {
    static constexpr bool PERM = false, AFTER_DRAIN = false;
    float* xlat; float* xctx; const float* gt; float* dummy;
    __device__ __forceinline__ void operator()(const f32x4 (&acc)[2][2][4][2], const Unit& u, int wr, int wc, int fr, int fq) const {
        const int cond = (u.pm < 128) ? (u.pm >> 6) : 2; const float* g = gt + cond * 6144;
        const int col0 = u.pn * BM + wc * 32 + 4 * fq;
        f32x4 gv[2][2];
#pragma unroll
        for (int bj = 0; bj < 2; ++bj)
#pragma unroll
            for (int n = 0; n < 2; ++n) gv[bj][n] = *(const f32x4*)(g + col0 + bj * HALF + n * 16);
#pragma unroll
        for (int ai = 0; ai < 2; ++ai)
#pragma unroll
            for (int m = 0; m < 4; ++m) { const int r = u.pm * BM + ai * HALF + wr * 64 + m * 16 + fr;
                float* rowp = (r < 32768) ? (xlat + (size_t)r * 1024) : (xctx + (size_t)(r - 32768) * 1024);
#pragma unroll
                for (int bj = 0; bj < 2; ++bj)
#pragma unroll
                    for (int n = 0; n < 2; ++n) { float* p = rowp + col0 + bj * HALF + n * 16; f32x4 x = *(const f32x4*)p; x = x + gv[bj][n] * acc[ai][bj][m][n]; float* q = dummy ? (dummy + (size_t)(r & 16383) * 1024 + col0 + bj * HALF + n * 16) : p; *(f32x4*)q = x; } }
    }
};
template <class Epi, class Sched, bool ALIGN_EPI = false, bool SP2 = false>
__device__ __forceinline__ void gemm_phase(PG8_LAS unsigned char* lds, const Gemm g, const Sched& S, const Epi& E) {
    int tid_l = threadIdx.x; asm volatile("" : "+v"(tid_l));
    const int tid = tid_l, wid = __builtin_amdgcn_readfirstlane(tid >> 6), lane = tid & 63, wr = wid >> 2, wc = wid & 3, fr = lane & 15, fq = lane >> 4;
    const int K = g.K, nt = K / BK;
    unsigned voffA[2], voffB[2];
#pragma unroll
    for (int i = 0; i < 2; ++i) { int R, C; stage_rc(tid * 16 + i * 8192, R, C); const int Rb = Epi::PERM ? ((R & ~31) + perm32(R & 31)) : R;
        voffA[i] = (unsigned)(R * K + C) * 2u; voffB[i] = (unsigned)(Rb * K + C) * 2u; }
    const size_t kstep = (size_t)(BK * 2);
    const size_t hstep = (size_t)HALF * K * 2;
    const size_t tstep = 2 * hstep;
    const unsigned ldsw = (unsigned)wid * 1024u;
    const int aoff = lds_byte(wr * 64 + fr, fq * 8), boff = lds_byte(wc * 32 + fr, fq * 8);
#define PG8_SA(b, h) (((b) * 2 + (h)) * HTB)
#define PG8_SB(b, h) ((4 + (b) * 2 + (h)) * HTB)
#define PG8_STAGE(bufoff, gbase, voff) do { _Pragma("unroll") for (int _i = 0; _i < 2; ++_i) \
        __builtin_amdgcn_global_load_lds((const unsigned*)((const char*)(gbase) + (voff)[_i]), (PG8_LAS unsigned*)(lds + (bufoff) + ldsw + _i * 8192), 16, 0, 0); } while (0)
#define PG8_LDA(dst, b, h) do { _Pragma("unroll") for (int m = 0; m < 4; ++m) _Pragma("unroll") for (int k = 0; k < 2; ++k) dst[m][k] = *(const PG8_LAS bf16x8*)(lds + PG8_SA(b, h) + aoff + m * 2048 + k * 1024); } while (0)
#define PG8_LDB(dst, b, h) do { _Pragma("unroll") for (int n = 0; n < 2; ++n) _Pragma("unroll") for (int k = 0; k < 2; ++k) dst[n][k] = *(const PG8_LAS bf16x8*)(lds + PG8_SB(b, h) + boff + n * 2048 + k * 1024); } while (0)
#define PG8_MMA(ai, bj, At, Bt) do { __builtin_amdgcn_s_setprio(1); _Pragma("unroll") for (int m = 0; m < 4; ++m) _Pragma("unroll") for (int n = 0; n < 2; ++n) _Pragma("unroll") for (int k = 0; k < 2; ++k) \
        acc[ai][bj][m][n] = __builtin_amdgcn_mfma_f32_16x16x32_bf16(Bt[n][k], At[m][k], acc[ai][bj][m][n], 0, 0, 0); __builtin_amdgcn_s_setprio(0); } while (0)
#define PG8_WAIT_V(n) asm volatile("s_waitcnt vmcnt(" #n ")" ::: "memory")
#define PG8_WAIT_L(n) asm volatile("s_waitcnt lgkmcnt(" #n ")" ::: "memory")
#define PG8_BAR __builtin_amdgcn_s_barrier()
#define PG8_SCHED __builtin_amdgcn_sched_barrier(0)
    Unit cur, nxt; int ui = 0;
    if (!S.next(0, cur)) return;
    f32x4 acc[2][2][4][2];
#pragma unroll
    for (int a = 0; a < 2; ++a)
#pragma unroll
        for (int b = 0; b < 2; ++b)
#pragma unroll
            for (int m = 0; m < 4; ++m)
#pragma unroll
                for (int n = 0; n < 2; ++n) acc[a][b][m][n] = (f32x4){0.f, 0.f, 0.f, 0.f};
    bf16x8 At[4][2], B0[2][2], B1[2][2];
    const char* cA = (const char*)g.A + (size_t)cur.pm * tstep; const char* cB = (const char*)g.Bt + (size_t)cur.pn * tstep;
    S.a_ready(cur);
    if constexpr (SP2) {
        PG8_STAGE(PG8_SB(0, 0), cB, voffB); PG8_STAGE(PG8_SB(0, 1), cB + hstep, voffB); PG8_STAGE(PG8_SA(0, 0), cA, voffA); PG8_STAGE(PG8_SA(0, 1), cA + hstep, voffA);
        if (wr == 1) PG8_BAR;
        PG8_WAIT_V(2); PG8_BAR;
        PG8_STAGE(PG8_SB(1, 0), cB + kstep, voffB); PG8_STAGE(PG8_SA(1, 0), cA + kstep, voffA); PG8_STAGE(PG8_SB(1, 1), cB + hstep + kstep, voffB);
        PG8_WAIT_V(6); PG8_BAR;
    } else {
        PG8_STAGE(PG8_SB(0, 0), cB, voffB); PG8_STAGE(PG8_SA(0, 0), cA, voffA); PG8_STAGE(PG8_SB(0, 1), cB + hstep, voffB); PG8_STAGE(PG8_SA(0, 1), cA + hstep, voffA);
        if (wr == 1) PG8_BAR;
        PG8_WAIT_V(4); PG8_BAR;
        PG8_STAGE(PG8_SB(1, 0), cB + kstep, voffB); PG8_STAGE(PG8_SA(1, 0), cA + kstep, voffA); PG8_STAGE(PG8_SB(1, 1), cB + hstep + kstep, voffB);
        PG8_WAIT_V(6); PG8_BAR;
    }
    for (;;) {
        const bool has_next = S.next(ui + 1, nxt);
        const char* nA = has_next ? (const char*)g.A + (size_t)nxt.pm * tstep : cA; const char* nB = has_next ? (const char*)g.Bt + (size_t)nxt.pn * tstep : cB;
        for (int t = 0; t < nt; t += 2) {
            const bool last = (t == nt - 2);
            const char* a1 = cA + (size_t)(t + 1) * kstep;
            const char* a2 = last ? nA : cA + (size_t)(t + 2) * kstep; const char* b2 = last ? nB : cB + (size_t)(t + 2) * kstep;
            const char* a3 = a2 + kstep; const char* b3 = b2 + kstep;
            if (last && has_next) S.a_ready(nxt);
            if constexpr (SP2) {
            PG8_LDB(B0, 0, 0); PG8_LDB(B1, 0, 1); PG8_SCHED; PG8_LDA(At, 0, 0); PG8_STAGE(PG8_SA(1, 1), a1 + hstep, voffA);
            PG8_WAIT_V(8); PG8_WAIT_L(0); PG8_BAR; PG8_MMA(0, 0, At, B0); PG8_MMA(0, 1, At, B1); PG8_BAR; PG8_SCHED;
            PG8_LDA(At, 0, 1); PG8_STAGE(PG8_SB(0, 0), b2, voffB); PG8_STAGE(PG8_SB(0, 1), b2 + hstep, voffB); PG8_STAGE(PG8_SA(0, 0), a2, voffA);
            PG8_WAIT_V(8); PG8_WAIT_L(0); PG8_BAR; PG8_MMA(1, 0, At, B0); PG8_MMA(1, 1, At, B1); PG8_BAR; PG8_SCHED;
            PG8_LDB(B0, 1, 0); PG8_LDB(B1, 1, 1); PG8_SCHED; PG8_LDA(At, 1, 0); PG8_STAGE(PG8_SA(0, 1), a2 + hstep, voffA);
            PG8_WAIT_V(8); PG8_WAIT_L(0); PG8_BAR; PG8_MMA(0, 0, At, B0); PG8_MMA(0, 1, At, B1); PG8_BAR; PG8_SCHED;
            PG8_LDA(At, 1, 1); PG8_STAGE(PG8_SB(1, 0), b3, voffB); PG8_STAGE(PG8_SB(1, 1), b3 + hstep, voffB); PG8_STAGE(PG8_SA(1, 0), a3, voffA);
            PG8_WAIT_V(8); PG8_WAIT_L(0); PG8_BAR; PG8_MMA(1, 0, At, B0); PG8_MMA(1, 1, At, B1); PG8_BAR; PG8_SCHED;
            } else {
            PG8_LDB(B0, 0, 0); PG8_SCHED; PG8_LDA(At, 0, 0); PG8_STAGE(PG8_SA(1, 1), a1 + hstep, voffA);
            PG8_WAIT_L(8); PG8_BAR; PG8_WAIT_L(0); PG8_MMA(0, 0, At, B0); PG8_BAR; PG8_SCHED;
            PG8_LDB(B1, 0, 1); PG8_STAGE(PG8_SB(0, 0), b2, voffB);
            PG8_BAR; PG8_WAIT_L(0); PG8_MMA(0, 1, At, B1); PG8_BAR;
            PG8_LDA(At, 0, 1); PG8_STAGE(PG8_SA(0, 0), a2, voffA);
            PG8_BAR; PG8_WAIT_L(0); PG8_MMA(1, 0, At, B0); PG8_BAR; PG8_SCHED;
            PG8_STAGE(PG8_SB(0, 1), b2 + hstep, voffB);
            PG8_WAIT_V(6); PG8_BAR; PG8_MMA(1, 1, At, B1); PG8_BAR;
            PG8_LDB(B0, 1, 0); PG8_SCHED; PG8_LDA(At, 1, 0); PG8_STAGE(PG8_SA(0, 1), a2 + hstep, voffA);
            PG8_WAIT_L(8); PG8_BAR; PG8_WAIT_L(0); PG8_MMA(0, 0, At, B0); PG8_BAR; PG8_SCHED;
            PG8_LDB(B1, 1, 1); PG8_STAGE(PG8_SB(1, 0), b3, voffB);
            PG8_BAR; PG8_WAIT_L(0); PG8_MMA(0, 1, At, B1); PG8_BAR;
            PG8_LDA(At, 1, 1); PG8_STAGE(PG8_SA(1, 0), a3, voffA);
            PG8_BAR; PG8_WAIT_L(0); PG8_MMA(1, 0, At, B0); PG8_BAR; PG8_SCHED;
            PG8_STAGE(PG8_SB(1, 1), b3 + hstep, voffB);
            PG8_WAIT_V(6); PG8_BAR; PG8_MMA(1, 1, At, B1); PG8_BAR;
            }
        }
        if constexpr (ALIGN_EPI) { if (wr == 0) PG8_BAR; }
        if constexpr (!Epi::AFTER_DRAIN) { E(acc, cur, wr, wc, fr, fq); S.done(cur); }
        if (!has_next) break;
#pragma unroll
        for (int a = 0; a < 2; ++a)
#pragma unroll
            for (int b = 0; b < 2; ++b)
#pragma unroll
                for (int m = 0; m < 4; ++m)
#pragma unroll
                    for (int n = 0; n < 2; ++n) acc[a][b][m][n] = (f32x4){0.f, 0.f, 0.f, 0.f};
        cur = nxt; cA = nA; cB = nB; ++ui;
        if constexpr (ALIGN_EPI) { if (wr == 1) PG8_BAR; }
    }
    PG8_WAIT_V(0);
    if constexpr (!ALIGN_EPI) { if (wr == 0) PG8_BAR; }
    PG8_BAR;
    if constexpr (Epi::AFTER_DRAIN) { E.fused(acc, cur, wr, wc, fr, fq, lds, wid, lane); S.done(cur); }
#undef PG8_SA
#undef PG8_SB
#undef PG8_STAGE
#undef PG8_LDA
#undef PG8_LDB
#undef PG8_MMA
#undef PG8_WAIT_V
#undef PG8_WAIT_L
#undef PG8_BAR
#undef PG8_SCHED
}
}
#include <hip/hip_bf16.h>
#include <cmath>
namespace attn_body {
using bf16=__hip_bfloat16;
using bf16x8=__attribute__((ext_vector_type(8)))short;
using s16x4=__attribute__((ext_vector_type(4)))short;
using f32x16=__attribute__((ext_vector_type(16)))float;
using u32x4=__attribute__((ext_vector_type(4)))unsigned;
constexpr int D=64,QP=2560,KP=128,OP=1024;
constexpr int NW=8,QBLK=32,QB=QBLK*NW,KVBLK=64;
constexpr int ATTN_UNIT_ROWS=QB;
__device__ __forceinline__ int crow(int r,int hi){return (r&3)+8*(r>>2)+4*hi;}
#define SBAR() __builtin_amdgcn_sched_barrier(0)
__device__ __forceinline__ void cmask(f32x16&p0,f32x16&p1,int jb,int qrel,int hi){
  const float NEG=-INFINITY; int kb=64*jb+4*hi;
  #pragma unroll
  for(int r=0;r<16;++r){int kv=kb+(r&3)+8*(r>>2); if(kv>qrel)p0[r]=NEG; if(kv+32>qrel)p1[r]=NEG;}
}

constexpr int NSLOT=3, SLOTB=8192;
constexpr int LDS_K=0, LDS_V=NSLOT*SLOTB, LDS_WS=2*NSLOT*SLOTB, LDS_OST=LDS_WS+NW*64*4, LDS_BYTES=LDS_OST+NW*4096;
constexpr float C2=0.125f*1.4426950408889634f;
__device__ __forceinline__ void glds16(const void*gsrc,unsigned lds_dst){unsigned keep;
  asm volatile("s_mov_b32 %0, m0\n\ts_mov_b32 m0, %2\n\ts_nop 0\n\tglobal_load_lds_dwordx4 %1, off\n\ts_mov_b32 m0, %0":"=&s"(keep):"v"(gsrc),"s"(lds_dst):"memory");}
__device__ __forceinline__ float max3f(float a,float b,float c){float r;asm("v_max3_f32 %0, %1, %2, %3":"=v"(r):"v"(a),"v"(b),"v"(c));return r;}
__device__ __forceinline__ float max2f(float a,float b){float r;asm("v_max_f32_e32 %0, %1, %2":"=v"(r):"v"(a),"v"(b));return r;}
__device__ __forceinline__ float fadd_s(float a,float b){float r;asm("v_add_f32_e32 %0, %1, %2":"=v"(r):"v"(a),"v"(b));return r;}
__device__ __forceinline__ float fsub_s(float a,float b){float r;asm("v_sub_f32_e32 %0, %1, %2":"=v"(r):"v"(a),"v"(b));return r;}
typedef float f32x2_t __attribute__((ext_vector_type(2))); typedef __bf16 bf16x2_t __attribute__((ext_vector_type(2)));
__device__ __forceinline__ unsigned cvtpk_s(float lo,float hi){f32x2_t v={lo,hi};bf16x2_t b=__builtin_convertvector(v,bf16x2_t);return __builtin_bit_cast(unsigned,b);}
#define WAIT_BAR(N) asm volatile("s_waitcnt vmcnt(" #N ") lgkmcnt(0)\n\ts_barrier":::"memory")

__device__ __forceinline__ void qkt(f32x16&p0,f32x16&p1,const char*Kslot,const bf16x8*qr,const f32x16&negm,int r32,int hi){
  const char*kb=Kslot+hi*1024+r32*16;
  #pragma unroll
  for(int d0=0;d0<4;++d0){
    const bf16x8 b0=*reinterpret_cast<const bf16x8*>(kb+d0*2048);
    const bf16x8 b1=*reinterpret_cast<const bf16x8*>(kb+d0*2048+512);
    if(d0==0){p0=__builtin_amdgcn_mfma_f32_32x32x16_bf16(b0,qr[0],negm,0,0,0);p1=__builtin_amdgcn_mfma_f32_32x32x16_bf16(b1,qr[0],negm,0,0,0);}
    else{p0=__builtin_amdgcn_mfma_f32_32x32x16_bf16(b0,qr[d0],p0,0,0,0);p1=__builtin_amdgcn_mfma_f32_32x32x16_bf16(b1,qr[d0],p1,0,0,0);}}
}
typedef __attribute__((address_space(3))) const char* lds_cptr;
typedef short v4i16_t __attribute__((ext_vector_type(4)));
__device__ __forceinline__ void kload8(bf16x8*kf,lds_cptr kp){
  kf[0]=*(const __attribute__((address_space(3))) bf16x8*)(kp);      kf[1]=*(const __attribute__((address_space(3))) bf16x8*)(kp+512);
  kf[2]=*(const __attribute__((address_space(3))) bf16x8*)(kp+2048); kf[3]=*(const __attribute__((address_space(3))) bf16x8*)(kp+2560);
  kf[4]=*(const __attribute__((address_space(3))) bf16x8*)(kp+4096); kf[5]=*(const __attribute__((address_space(3))) bf16x8*)(kp+4608);
  kf[6]=*(const __attribute__((address_space(3))) bf16x8*)(kp+6144); kf[7]=*(const __attribute__((address_space(3))) bf16x8*)(kp+6656);
}
__device__ __forceinline__ void kload2(bf16x8*kf,lds_cptr kp,int j){ kf[2*j]=*(const __attribute__((address_space(3))) bf16x8*)(kp+j*2048); kf[2*j+1]=*(const __attribute__((address_space(3))) bf16x8*)(kp+j*2048+512); }
__device__ __forceinline__ s16x4 vtr(lds_cptr p){ return __builtin_bit_cast(s16x4,__builtin_amdgcn_ds_read_tr16_b64_v4i16((__attribute__((address_space(3))) v4i16_t*)p)); }
__device__ __forceinline__ float rowmax(const f32x16&p0,const f32x16&p1){
  float a=max3f(p0[0],p0[1],p1[0]),b=max3f(p0[2],p0[3],p1[1]);a=max3f(a,p1[2],p1[3]);
  #pragma unroll
  for(int r=4;r<16;r+=4){a=max3f(a,p0[r],p0[r+1]);b=max3f(b,p0[r+2],p0[r+3]);a=max3f(a,p1[r],p1[r+1]);b=max3f(b,p1[r+2],p1[r+3]);}
  const float m=max2f(a,b);
  auto rr=__builtin_amdgcn_permlane32_swap(__float_as_uint(m),__float_as_uint(m),false,false);
  return max2f(__uint_as_float(rr[0]),__uint_as_float(rr[1]));
}
__device__ __forceinline__ void pv(f32x16*o,int vb,bf16x8 pa0,bf16x8 pa1,bf16x8 pa2,bf16x8 pa3){
  #pragma unroll
  for(int d0=0;d0<2;++d0){s16x4 lo[4],hi[4];
    #pragma unroll
    for(int ks=0;ks<4;++ks){
      asm volatile("ds_read_b64_tr_b16 %0,%1 offset:%c2":"=&v"(lo[ks]):"v"(vb),"i"(d0*4096+ks*1024):"memory");
      asm volatile("ds_read_b64_tr_b16 %0,%1 offset:%c2":"=&v"(hi[ks]):"v"(vb),"i"(d0*4096+ks*1024+512):"memory");}
    asm volatile("s_waitcnt lgkmcnt(0)":::"memory");SBAR();
    #define PK(k) (bf16x8){lo[k][0],lo[k][1],lo[k][2],lo[k][3],hi[k][0],hi[k][1],hi[k][2],hi[k][3]}
    o[d0]=__builtin_amdgcn_mfma_f32_32x32x16_bf16(pa0,PK(0),o[d0],0,0,0);
    o[d0]=__builtin_amdgcn_mfma_f32_32x32x16_bf16(pa1,PK(1),o[d0],0,0,0);
    o[d0]=__builtin_amdgcn_mfma_f32_32x32x16_bf16(pa2,PK(2),o[d0],0,0,0);
    o[d0]=__builtin_amdgcn_mfma_f32_32x32x16_bf16(pa3,PK(3),o[d0],0,0,0);
    #undef PK
  }
}

#ifndef ATTN_STORE16
#define ATTN_STORE16(p,v) (*(u32x4*)(p)=(v))
#endif
template<int THRL,bool FIXREF> __device__ __forceinline__ void attn_unit(const float*gq,const float*tab,const int tq0,const bf16*Qw0,const bf16*__restrict__ Kl,const bf16*__restrict__ Vl,const int NT,bf16*Ow0,char*shm){
  int tid_l=threadIdx.x; asm volatile("":"+v"(tid_l)); const int tid=tid_l,lane=tid&63,r32=lane&31,hi=lane>>5; const int wid=__builtin_amdgcn_readfirstlane(tid>>6);
  const bf16*Qw=Qw0+(long)(wid*QBLK)*QP;
  const unsigned lds0=(unsigned)(uintptr_t)shm;
  float*wsf=(float*)(shm+LDS_WS)+wid*64;
  const bf16*ksrc=Kl+wid*512+lane*8;
  const bf16*vsrc=Vl+wid*512+lane*8;
  const unsigned kdst=lds0+LDS_K+wid*1024, vdst=lds0+LDS_V+wid*1024;
  #define DMA_K(t,slot) glds16(ksrc+(long)(t)*4096,(unsigned)__builtin_amdgcn_readfirstlane(kdst+(slot)))
  #define DMA_V(t,slot) glds16(vsrc+(long)(t)*4096,(unsigned)__builtin_amdgcn_readfirstlane(vdst+(slot)))
  const int vb0=(int)(lds0+LDS_V)+((lane>>4)&1)*32+(lane&3)*8+(4*hi+((lane&15)>>2))*64;
  const char*Kbase=shm+LDS_K; bf16x8 kf[8];
  const lds_cptr shm3=(lds_cptr)shm; const lds_cptr kp0=shm3+LDS_K+hi*1024+r32*16; const lds_cptr vp0=shm3+LDS_V+((lane>>4)&1)*32+(lane&3)*8+(4*hi+((lane&15)>>2))*64;
  DMA_K(0,0);DMA_V(0,0);DMA_K(1,SLOTB);
  bf16x8 qr[4];
  {
    float xq[4][8]; float ss=0.f;
    #pragma unroll
    for(int d0=0;d0<4;++d0){ const u32x4 w=*reinterpret_cast<const u32x4*>(&Qw[(long)r32*QP+d0*16+hi*8]); const unsigned ww[4]={w.x,w.y,w.z,w.w};
      #pragma unroll
      for(int c=0;c<4;++c){ xq[d0][2*c]=__uint_as_float(ww[c]<<16); xq[d0][2*c+1]=__uint_as_float(ww[c]&0xffff0000u); ss+=xq[d0][2*c]*xq[d0][2*c]+xq[d0][2*c+1]*xq[d0][2*c+1]; } }
    { auto rr=__builtin_amdgcn_permlane32_swap(__float_as_uint(ss),__float_as_uint(ss),false,false); ss=__uint_as_float(rr[0])+__uint_as_float(rr[1]); }
    const float rstd=__builtin_amdgcn_rsqf(ss*(1.f/64.f)+1e-6f)*C2;
    #pragma unroll
    for(int d0=0;d0<4;++d0){ const float*gp=gq+d0*16+hi*8;
      #pragma unroll
      for(int j=0;j<8;++j)xq[d0][j]*=rstd*gp[j]; }
    if(tab){ const int tpos=(tq0+wid*QBLK+r32)&16383; const float*tr_=tab+((tpos>>6)*16+hi*8)*2; const float*tc_=tab+((tpos&63)*16+hi*8)*2;
      #pragma unroll
      for(int j=0;j<8;++j){ const float cr=tr_[2*j],sr=tr_[2*j+1],cc=tc_[2*j],sc=tc_[2*j+1];
        const float a0=xq[0][j],b0=xq[1][j],a1=xq[2][j],b1=xq[3][j];
        xq[0][j]=a0*cr-b0*sr; xq[1][j]=a0*sr+b0*cr; xq[2][j]=a1*cc-b1*sc; xq[3][j]=a1*sc+b1*cc; } }
    #pragma unroll
    for(int d0=0;d0<4;++d0){ u32x4 p; p.x=cvtpk_s(xq[d0][0],xq[d0][1]); p.y=cvtpk_s(xq[d0][2],xq[d0][3]); p.z=cvtpk_s(xq[d0][4],xq[d0][5]); p.w=cvtpk_s(xq[d0][6],xq[d0][7]); qr[d0]=__builtin_bit_cast(bf16x8,p); } }
  float mhat=0.f,l_reg=0.f;f32x16 o[2];o[0]=f32x16{};o[1]=f32x16{};f32x16 negm=f32x16{};asm volatile("":"+v"(negm));
  #define CMASK(P0,P1,t) do{}while(0)
  bool resc=false;
  #define START(P0,P1) do{ resc=false; \
    if(!FIXREF){ const float rm=rowmax(P0,P1); const float dl=rm; mhat=fadd_s(mhat,dl); \
      _Pragma("unroll") for(int r=0;r<16;++r){P0[r]=fsub_s(P0[r],dl);P1[r]=fsub_s(P1[r],dl);} \
      _Pragma("unroll") for(int r=0;r<16;++r)negm[r]=-mhat; asm volatile("":"+v"(negm)); } \
    _Pragma("unroll") for(int r=0;r<16;++r)P0[r]=__builtin_amdgcn_exp2f(P0[r]); }while(0)
  #define RESC() do{ if(resc){ asm volatile("s_waitcnt lgkmcnt(0)":::"memory"); \
      _Pragma("unroll") for(int d_=0;d_<2;++d_) _Pragma("unroll") for(int r=0;r<16;++r)o[d_][r]*=wsf[crow(r,hi)]; } }while(0)
  f32x16 pA0,pA1,pB0,pB1;
  int sl_prev=0,sl_cur=0,sl_next=SLOTB;
  #define ROT() do{sl_prev=sl_cur;sl_cur=sl_next;sl_next=(sl_next==(NSLOT-1)*SLOTB)?0:sl_next+SLOTB;}while(0)
  DMA_K(2,2*SLOTB);
  WAIT_BAR(3);
  qkt(pA0,pA1,Kbase,qr,negm,r32,hi);asm volatile("s_nop 15\n\ts_nop 7":"+v"(pA0),"+v"(pA1));CMASK(pA0,pA1,0);
  START(pA0,pA1);
  _Pragma("unroll") for(int r=0;r<16;++r)pA1[r]=__builtin_amdgcn_exp2f(pA1[r]);
  WAIT_BAR(0);
  DMA_K(3,0);DMA_V(1,SLOTB);
  ROT();
  kload8(kf,kp0+sl_cur);
  WAIT_BAR(2);
  s16x4 vlo[8],vhi[8]; u32x4 pw0,pw1,pw2,pw3;
  #define PKW(P,B) cvtpk_s(P[B],P[B+1])
  #define PAF(k) __builtin_bit_cast(bf16x8,pw##k)
  #define VFR(i) (bf16x8){vlo[i][0],vlo[i][1],vlo[i][2],vlo[i][3],vhi[i][0],vhi[i][1],vhi[i][2],vhi[i][3]}
  #define PIN(x) asm volatile("":"+v"(x))
  #define MX3(a,b,c) __builtin_fmaxf(__builtin_fmaxf((a),(b)),(c))
  #define GAPA(MF,A0,A1,A2,A3,W0,W1,PW) do{ MF; sacc+=A0; sacc+=A1; sacc+=A2; sacc+=A3; PIN(sacc); W0; W1; PIN(PW); SBAR(); }while(0)
  #define EX(v) __builtin_amdgcn_exp2f(v)
  #define GAPB(MF,X,B) do{ MF; X[B]=EX(X[B]); X[B+1]=EX(X[B+1]); X[B+2]=EX(X[B+2]); X[B+3]=EX(X[B+3]); PIN(X); SBAR(); }while(0)
  #define VRD(i) do{ vlo[i]=vtr(vp_+(((i)>>2)*4096+((i)&3)*1024)); vhi[i]=vtr(vp_+(((i)>>2)*4096+((i)&3)*1024+512)); }while(0)
  #define KRD(G,j) do{ if(G){ kload2(kf,kp0+sl_next,j); SBAR(); } }while(0)
  #define STEP(C0,C1,P0,P1,t,GK,GV,GL) do{ SBAR(); \
    const lds_cptr vp_=vp0+sl_prev; \
    VRD(0); SBAR(); float sacc=(P0[0]+P0[1]); \
    GAPA(C0=__builtin_amdgcn_mfma_f32_32x32x16_bf16(kf[0],qr[0],negm,0,0,0), P0[2],P0[3],P0[4],P0[5],     pw0[0]=PKW(P0,0), pw0[1]=PKW(P0,2), pw0); \
    VRD(4); SBAR(); GAPA(C1=__builtin_amdgcn_mfma_f32_32x32x16_bf16(kf[1],qr[0],negm,0,0,0), P0[6],P0[7],P0[8],P0[9],     pw0[2]=PKW(P0,4), pw0[3]=PKW(P0,6), pw0); \
    VRD(1); SBAR(); GAPA(C0=__builtin_amdgcn_mfma_f32_32x32x16_bf16(kf[2],qr[1],C0,0,0,0),   P0[10],P0[11],P0[12],P0[13], pw1[0]=PKW(P0,8), pw1[1]=PKW(P0,10), pw1); \
    VRD(5); SBAR(); GAPA(C1=__builtin_amdgcn_mfma_f32_32x32x16_bf16(kf[3],qr[1],C1,0,0,0),   P0[14],P0[15],P1[0],P1[1],   pw1[2]=PKW(P0,12),pw1[3]=PKW(P0,14), pw1); \
    VRD(2); SBAR(); GAPA(C0=__builtin_amdgcn_mfma_f32_32x32x16_bf16(kf[4],qr[2],C0,0,0,0),   P1[2],P1[3],P1[4],P1[5],     pw2[0]=PKW(P1,0), pw2[1]=PKW(P1,2), pw2); \
    VRD(6); SBAR(); GAPA(C1=__builtin_amdgcn_mfma_f32_32x32x16_bf16(kf[5],qr[2],C1,0,0,0),   P1[6],P1[7],P1[8],P1[9],     pw2[2]=PKW(P1,4), pw2[3]=PKW(P1,6), pw2); \
    VRD(3); SBAR(); GAPA(C0=__builtin_amdgcn_mfma_f32_32x32x16_bf16(kf[6],qr[3],C0,0,0,0),   P1[10],P1[11],P1[12],P1[13], pw3[0]=PKW(P1,8), pw3[1]=PKW(P1,10), pw3); \
    VRD(7); SBAR(); GAPA(C1=__builtin_amdgcn_mfma_f32_32x32x16_bf16(kf[7],qr[3],C1,0,0,0),   P1[14],P1[15],0.f,0.f,       pw3[2]=PKW(P1,12),pw3[3]=PKW(P1,14), pw3); \
    l_reg+=sacc; \
    if(GK){DMA_K((t)+3,sl_cur);} if(GV){DMA_V((t)+1,sl_next);} \
    CMASK(C0,C1,t); \
    if(!FIXREF){ float a=MX3(C0[0],C0[1],C1[0]),b=MX3(C0[2],C0[3],C1[1]); a=MX3(a,C1[2],C1[3]); \
      _Pragma("unroll") for(int r=4;r<16;r+=4){a=MX3(a,C0[r],C0[r+1]);b=MX3(b,C0[r+2],C0[r+3]);a=MX3(a,C1[r],C1[r+1]);b=MX3(b,C1[r+2],C1[r+3]);} \
      float rm=__builtin_fmaxf(a,b); { auto rr=__builtin_amdgcn_permlane32_swap(__float_as_uint(rm),__float_as_uint(rm),false,false); rm=__builtin_fmaxf(__uint_as_float(rr[0]),__uint_as_float(rr[1])); } \
      resc=false; \
      if(__builtin_expect(__any(rm>(float)THRL),0)){ const float dl=__builtin_fmaxf(rm,0.f); mhat+=dl; \
        _Pragma("unroll") for(int r=0;r<16;++r){C0[r]-=dl;C1[r]-=dl;} \
        _Pragma("unroll") for(int r=0;r<16;++r)negm[r]=-mhat; asm volatile("":"+v"(negm)); \
        const float f=__builtin_amdgcn_exp2f(-dl); l_reg*=f; if(hi==0)wsf[r32]=f; resc=true; } } \
    SBAR(); \
    GAPB(o[0]=__builtin_amdgcn_mfma_f32_32x32x16_bf16(PAF(0),VFR(0),o[0],0,0,0), C0,0); \
    GAPB(o[1]=__builtin_amdgcn_mfma_f32_32x32x16_bf16(PAF(0),VFR(4),o[1],0,0,0), C0,4); \
    KRD(GL,0); GAPB(o[0]=__builtin_amdgcn_mfma_f32_32x32x16_bf16(PAF(1),VFR(1),o[0],0,0,0), C0,8); \
    KRD(GL,1); GAPB(o[1]=__builtin_amdgcn_mfma_f32_32x32x16_bf16(PAF(1),VFR(5),o[1],0,0,0), C0,12); \
    KRD(GL,2); GAPB(o[0]=__builtin_amdgcn_mfma_f32_32x32x16_bf16(PAF(2),VFR(2),o[0],0,0,0), C1,0); \
    KRD(GL,3); GAPB(o[1]=__builtin_amdgcn_mfma_f32_32x32x16_bf16(PAF(2),VFR(6),o[1],0,0,0), C1,4); \
    GAPB(o[0]=__builtin_amdgcn_mfma_f32_32x32x16_bf16(PAF(3),VFR(3),o[0],0,0,0), C1,8); \
    GAPB(o[1]=__builtin_amdgcn_mfma_f32_32x32x16_bf16(PAF(3),VFR(7),o[1],0,0,0), C1,12); \
    }while(0)
  int t=1;
  #undef CMASK
  #define CMASK(P0,P1,t) do{}while(0)
  for(;t+5<NT;t+=2){
    STEP(pB0,pB1,pA0,pA1,t,true,true,true);     WAIT_BAR(2); RESC(); ROT();
    STEP(pA0,pA1,pB0,pB1,t+1,true,true,true);   WAIT_BAR(2); RESC(); ROT();
  }
  #undef CMASK
  #define CMASK(P0,P1,t) do{}while(0)
  #define ENDW(tt) do{ if((tt)+3<NT){WAIT_BAR(2);} else if((tt)+2<NT){WAIT_BAR(1);} else {WAIT_BAR(0);} }while(0)
  for(;t+1<NT;t+=2){
    STEP(pB0,pB1,pA0,pA1,t,(t+3<NT),(t+1<NT),(t+1<NT));       ENDW(t);   RESC(); ROT();
    STEP(pA0,pA1,pB0,pB1,t+1,(t+4<NT),(t+2<NT),(t+2<NT));     ENDW(t+1); RESC(); ROT();
  }
  STEP(pB0,pB1,pA0,pA1,NT-1,false,false,false); RESC();
  { float sacc=pB0[0]+pB0[1]; _Pragma("unroll") for(int r=2;r<16;++r)sacc+=pB0[r]; _Pragma("unroll") for(int r=0;r<16;++r)sacc+=pB1[r]; l_reg+=sacc;
    pw0=(u32x4){PKW(pB0,0),PKW(pB0,2),PKW(pB0,4),PKW(pB0,6)};pw1=(u32x4){PKW(pB0,8),PKW(pB0,10),PKW(pB0,12),PKW(pB0,14)};pw2=(u32x4){PKW(pB1,0),PKW(pB1,2),PKW(pB1,4),PKW(pB1,6)};pw3=(u32x4){PKW(pB1,8),PKW(pB1,10),PKW(pB1,12),PKW(pB1,14)};
    SBAR(); pv(o,vb0+sl_cur,PAF(0),PAF(1),PAF(2),PAF(3)); }
  #undef PKW
  #undef PAF
  #undef VFR
  #undef PIN
  #undef MX3
  #undef GAPA
  #undef GAPB
  #undef EX
  #undef VRD
  #undef KRD
  #undef STEP
  #undef ENDW
  {auto rr=__builtin_amdgcn_permlane32_swap(__float_as_uint(l_reg),__float_as_uint(l_reg),false,false);l_reg=__uint_as_float(rr[0])+__uint_as_float(rr[1]);}
  if(hi==0)wsf[32+r32]=l_reg;asm volatile("s_waitcnt lgkmcnt(0)":::"memory");
  float rli[16];
  #pragma unroll
  for(int r=0;r<16;++r)rli[r]=__builtin_amdgcn_rcpf(wsf[32+crow(r,hi)]);
  bf16*Ow=Ow0+(long)(wid*QBLK)*OP;
  { bf16*stg=(bf16*)(shm+LDS_OST)+wid*2048;
    #pragma unroll
    for(int r=0;r<16;++r){const int orow=crow(r,hi);
      #pragma unroll
      for(int d0=0;d0<2;++d0)stg[orow*64+d0*32+r32]=__float2bfloat16(o[d0][r]*rli[r]);}
    asm volatile("s_waitcnt lgkmcnt(0)":::"memory");
    #pragma unroll
    for(int i=0;i<4;++i){const int row=i*8+(lane>>3),ch=lane&7; const u32x4 v=*(const u32x4*)(stg+row*64+ch*8); ATTN_STORE16(Ow+(long)row*OP+ch*8,v);} }
  asm volatile("s_waitcnt lgkmcnt(0)\n\ts_barrier":::"memory");
  #undef DMA_K
  #undef DMA_V
  #undef CMASK
  #undef START
  #undef RESC
  #undef ROT
}
constexpr int ATTN_LDS_BYTES=LDS_BYTES;
#undef SBAR
#undef WAIT_BAR
}
#ifndef REP_SYNC
#define REP_SYNC 1
#endif
#ifndef REP_PRO
#define REP_PRO 1
#endif
#ifndef REP_S2
#define REP_S2 1
#endif
#ifndef REP_NORM
#define REP_NORM 1
#endif
#ifndef REP_G1
#define REP_G1 1
#endif
#ifndef REP_S1
#define REP_S1 1
#endif
#ifndef REP_S3
#define REP_S3 1
#endif
#ifndef REP_ATT
#define REP_ATT 1
#endif
#ifndef REP_POST0
#define REP_POST0 1
#endif
#define LAS __attribute__((address_space(3)))
typedef unsigned short u16;
typedef float f32x4 __attribute__((ext_vector_type(4)));
typedef float f32x2 __attribute__((ext_vector_type(2)));
typedef unsigned u32x4 __attribute__((ext_vector_type(4)));
typedef unsigned u32x2 __attribute__((ext_vector_type(2)));

constexpr int M_LAT = 32768, M_CTXR = 512, M_ALL = 33280, DM_ = 1024, NPAD = 2560, IN_W = 2336, FF_ = 4096;
constexpr int C_RQ = 0, C_RK = 128, C_RV = 256, C_RG = 512, C_GQ = 768, C_GK = 896, C_GV = 1024, C_GG = 1280, C_AQ = 1536, C_AK = 2048, C_AV = 2176, C_Z = 2304;
constexpr int SRC_GA = 1536;
constexpr float NEPS = 1e-6f;
constexpr int N_ITEM1 = 8320;
constexpr int N_ITEM3 = 4160;
constexpr size_t MiB = 1u << 20, KiB = 1u << 10;
constexpr size_t WS_MOD = 0;
constexpr size_t WS_BAR = 256 * KiB, WS_BAR_BYTES = 16 * KiB;
constexpr size_t WS_TAB = 512 * KiB;
constexpr size_t WS_CTXRES = 1 * MiB;
constexpr size_t WS_DEC = 3 * MiB;
constexpr size_t WS_W = 5 * MiB, W_LAYER = 23 * MiB, W_IN = 0, W_OUT = 5 * MiB, W_1 = 7 * MiB, W_2 = 15 * MiB;
constexpr size_t WS_XNY = 51 * MiB;
constexpr size_t WS_P = 116 * MiB;
constexpr size_t WS_QB = WS_P + (size_t)M_ALL * NPAD * 2;
constexpr size_t WS_KB = WS_QB + (size_t)M_ALL * 512 * 2;
constexpr size_t WS_VB = WS_KB + (size_t)M_ALL * 128 * 2;
constexpr size_t WS_G = WS_VB + (size_t)M_ALL * 128 * 2;
constexpr size_t WS_AS = WS_G + (size_t)M_ALL * 256 * 4;
constexpr size_t WS_END1 = WS_AS + (size_t)N_ITEM1 * 2048 * 4;
constexpr size_t WS_H = WS_P;
constexpr size_t WS_END2 = WS_H + (size_t)M_ALL * FF_ * 2;
constexpr size_t WS_YA = 430 * MiB;
static_assert(WS_YA >= WS_END1 && WS_YA >= WS_END2 && WS_YA + (size_t)M_ALL * 1024 * 2 <= 512 * MiB, "YA");
static_assert(WS_END1 <= 512 * MiB && WS_END2 <= 512 * MiB, "d_ws map");
constexpr int LDS_BYTES = 147456;

__device__ __forceinline__ float bf2f(unsigned h) { return __uint_as_float(h << 16); }
__device__ __forceinline__ float bflo(unsigned w) { return __uint_as_float(w << 16); }
__device__ __forceinline__ float bfhi(unsigned w) { return __uint_as_float(w & 0xffff0000u); }
__device__ __forceinline__ unsigned pk2(float lo, float hi) { return pg8::cvt_pk_bf16(lo, hi); }
template <int X> __device__ __forceinline__ float xor_lane(float v) { static_assert(X >= 1 && X <= 16, "xor_lane"); return __int_as_float(__builtin_amdgcn_ds_swizzle(__float_as_int(v), (X << 10) | 0x1F)); }
__device__ __forceinline__ float sum_halves(float v) { auto rr = __builtin_amdgcn_permlane32_swap(__float_as_uint(v), __float_as_uint(v), false, false); return __uint_as_float(rr[0]) + __uint_as_float(rr[1]); }
__device__ __forceinline__ float other_half(float v) { auto rr = __builtin_amdgcn_permlane32_swap(__float_as_uint(v), __float_as_uint(v), false, false); return (rr[0] == __float_as_uint(v)) ? __uint_as_float(rr[1]) : __uint_as_float(rr[0]); }
__device__ __forceinline__ float wave_sum(float v) {
    v += xor_lane<1>(v); v += xor_lane<2>(v); v += xor_lane<4>(v); v += xor_lane<8>(v); v += xor_lane<16>(v);
    return sum_halves(v);
}
__device__ __forceinline__ float logsig(float z) { return fminf(z, 0.f) - __logf(1.f + __expf(-fabsf(z))); }
#define LDS_WAIT() asm volatile("s_waitcnt lgkmcnt(0)" ::: "memory")

__device__ __forceinline__ void p0_transpose_item(const float* W, int K, int N, u16* WT, LAS float* scr, int item, int lane, int row_off = 0) {
    const int nblk = N / 32, kb = item / nblk, nb = item % nblk, k0 = 64 * kb, n0 = 32 * nb;
#pragma unroll 8
    for (int i = 0; i < 32; ++i) { const int kk = 2 * i + (lane >> 5); scr[kk * 33 + (lane & 31)] = W[(size_t)(k0 + kk) * N + n0 + (lane & 31)]; }
    LDS_WAIT(); asm volatile("" ::: "memory");
    const int c = lane & 7;
#pragma unroll
    for (int j = 0; j < 4; ++j) { const int n = (lane >> 3) + 8 * j; const LAS float* s = scr + (8 * c) * 33 + n;
        u32x4 o; o.x = pk2(s[0 * 33], s[1 * 33]); o.y = pk2(s[2 * 33], s[3 * 33]); o.z = pk2(s[4 * 33], s[5 * 33]); o.w = pk2(s[6 * 33], s[7 * 33]);
        *(u32x4*)(WT + (size_t)(n0 + n + row_off) * K + k0 + 8 * c) = o; }
    LDS_WAIT(); asm volatile("" ::: "memory");
}

#define XB_TMO      128
#define XB_XCNT(j)  (256  + 64 * (j))
#define XB_XSUB(j)  (1280 + 64 * (j))
#define XB_XGEN(j)  (2304 + 64 * (j))
#define XB_TOP      3328
#define XB_TOPGEN   3392
#define XCD_BAR_WORDS 3456
#define XB_SPIN_CAP (1u << 18)

__device__ __forceinline__ unsigned xb_ld(unsigned* p)              { return __hip_atomic_load(p, __ATOMIC_RELAXED, __HIP_MEMORY_SCOPE_AGENT); }
__device__ __forceinline__ unsigned xb_add(unsigned* p, unsigned v) { return __hip_atomic_fetch_add(p, v, __ATOMIC_RELAXED, __HIP_MEMORY_SCOPE_AGENT); }
__device__ __forceinline__ unsigned xb_xcc_id() { return (unsigned)__builtin_amdgcn_s_getreg((3 << 11) | 20) & 0xFu; }
#define XB_SPIN(cond, bar) do { unsigned _sp = 0; while (cond) { __builtin_amdgcn_s_sleep(1); \
    if ((++_sp & 255u) == 0u) { if (xb_ld(&(bar)[XB_TMO])) break; if (_sp > XB_SPIN_CAP) { atomicAdd(&(bar)[XB_TMO], 1u); break; } } } } while (0)

struct XcdBarrier {
    unsigned* bar; unsigned x;
    volatile LAS unsigned* st;
};

__device__ __forceinline__ XcdBarrier xcd_barrier_post(unsigned* bar, volatile LAS unsigned* st) {
    XcdBarrier b; b.bar = bar; b.x = xb_xcc_id(); b.st = st;
    if (threadIdx.x == 0) (void)xb_add(&bar[XB_XCNT(b.x)], 1u);
    return b;
}
__device__ __forceinline__ void xcd_barrier_complete(unsigned* bar, unsigned x, unsigned& nloc, unsigned& nx) {
    const unsigned G = gridDim.x * gridDim.y * gridDim.z;
    unsigned sum, cnt, mine, sp = 0u;
    for (;;) {
        sum = 0u; cnt = 0u; mine = 0u;
#pragma unroll
        for (unsigned j = 0; j < 16; ++j) { const unsigned c = xb_ld(&bar[XB_XCNT(j)]); sum += c; cnt += (c > 0u) ? 1u : 0u; mine = (j == x) ? c : mine; }
        if (sum == G) break;
        __builtin_amdgcn_s_sleep(1);
        if ((++sp & 255u) == 0u) { if (xb_ld(&bar[XB_TMO])) break; if (sp > XB_SPIN_CAP) { atomicAdd(&bar[XB_TMO], 1u); break; } }
    }
    nloc = mine > 0u ? mine : 1u; nx = cnt > 0u ? cnt : 1u;
}

__device__ __forceinline__ void xcd_barrier(const XcdBarrier& b) {
    asm volatile("s_waitcnt vmcnt(0)" ::: "memory");
    __syncthreads();
    if (threadIdx.x == 0) {
        unsigned* bar = b.bar;
        __builtin_amdgcn_s_waitcnt(0);
        unsigned nloc = b.st[0], nx = b.st[1];
        if (nloc == 0u) { xcd_barrier_complete(bar, b.x, nloc, nx); b.st[0] = nloc; b.st[1] = nx; }
        const unsigned old = xb_add(&bar[XB_XSUB(b.x)], 1u);
        const unsigned gen = old / nloc;
        if (old + 1u == (gen + 1u) * nloc) {
            __builtin_amdgcn_fence(__ATOMIC_RELEASE, "agent");
            asm volatile("s_waitcnt vmcnt(0)" ::: "memory");
            const unsigned og = xb_add(&bar[XB_TOP], 1u);
            const unsigned tg = og / nx;
            if (og + 1u == (tg + 1u) * nx) xb_add(&bar[XB_TOPGEN], 1u);
            else XB_SPIN(xb_ld(&bar[XB_TOPGEN]) == tg, bar);
            __builtin_amdgcn_fence(__ATOMIC_ACQUIRE, "agent");
            xb_add(&bar[XB_XGEN(b.x)], 1u);
            asm volatile("s_waitcnt vmcnt(0)" ::: "memory");
        } else {
            XB_SPIN(xb_ld(&bar[XB_XGEN(b.x)]) == gen, bar);
            __builtin_amdgcn_fence(__ATOMIC_ACQUIRE, "agent");
            asm volatile("s_waitcnt vmcnt(0)" ::: "memory");
        }
    }
    __syncthreads();
}


typedef short mbf16x8 __attribute__((ext_vector_type(8)));
template <int MODE> __device__ __forceinline__ void mini_gemm_ctx(const u16* A, const u16* Bt, int N, int K, u16* Ob, int ldo, int act, const float* gate, LAS unsigned char* L, int vb, int G_, int wave, int lane) {
    const int ncg = (N + 63) >> 6, ntiles = 8 * ncg, kslice = K >> 3;
    const int fr = lane & 15, fq = lane >> 4;
    LAS f32x4* red = (LAS f32x4*)L;
    for (int tile = vb; tile < ntiles; tile += G_) {
        const int r0 = (tile & 7) * 64, n0 = (tile >> 3) * 64;
        f32x4 acc[4][4];
#pragma unroll
        for (int a = 0; a < 4; ++a)
#pragma unroll
            for (int c = 0; c < 4; ++c) acc[a][c] = (f32x4){0.f, 0.f, 0.f, 0.f};
        const u16* ap = A + (size_t)(r0 + fr) * K + wave * kslice + 8 * fq; const u16* bp = Bt + (size_t)(n0 + fr) * K + wave * kslice + 8 * fq;
#pragma unroll 1
        for (int kc = 0; kc < kslice; kc += 64) {
            mbf16x8 fa[4][2], fb[4][2];
#pragma unroll
            for (int s = 0; s < 2; ++s)
#pragma unroll
                for (int q = 0; q < 4; ++q) { fa[q][s] = *(const mbf16x8*)(ap + (size_t)(16 * q) * K + kc + 32 * s); fb[q][s] = *(const mbf16x8*)(bp + (size_t)(16 * q) * K + kc + 32 * s); }
#pragma unroll
            for (int s = 0; s < 2; ++s)
#pragma unroll
                for (int mi = 0; mi < 4; ++mi)
#pragma unroll
                    for (int ni = 0; ni < 4; ++ni) acc[mi][ni] = __builtin_amdgcn_mfma_f32_16x16x32_bf16(fa[mi][s], fb[ni][s], acc[mi][ni], 0, 0, 0);
        }
#pragma unroll
        for (int ti = 0; ti < 16; ++ti) red[(wave * 16 + ti) * 64 + lane] = acc[ti >> 2][ti & 3];
        __syncthreads();
#pragma unroll
        for (int q = 0; q < 2; ++q) { const int ti = 2 * wave + q, mi = ti >> 2, ni = ti & 3;
            f32x4 s = red[ti * 64 + lane];
#pragma unroll
            for (int w = 1; w < 8; ++w) s += red[(w * 16 + ti) * 64 + lane];
            const int c = n0 + 16 * ni + fr;
            if (c < N) {
                const float gv = (MODE == 1) ? gate[c] : 1.f;
#pragma unroll
                for (int i = 0; i < 4; ++i) { const int r = r0 + 16 * mi + 4 * fq + i; float v = s[i] * gv;
                    if (act) { v = fmaxf(v, 0.f); v = v * v; } Ob[(size_t)r * ldo + c] = (u16)(pk2(v, 0.f) & 0xffffu); }
            }
        }
        __syncthreads();
    }
}

struct Args { const float* in[17]; float* out; unsigned char* ws; };

__global__ void __launch_bounds__(512, 2) fwd_megakernel(Args args) {
    extern __shared__ __attribute__((aligned(16))) unsigned char lds[];
    cg::grid_group grid = cg::this_grid();
    LAS unsigned char* L = (LAS unsigned char*)lds;
    const int G_ = gridDim.x, bx = blockIdx.x, NGW = G_ * 8;
#define PHASE_IDS int tid_l = threadIdx.x; asm volatile("" : "+v"(tid_l)); const int tid = tid_l, lane = tid & 63, wave = __builtin_amdgcn_readfirstlane(tid >> 6), gw = bx * 8 + wave; (void)gw; (void)lane;
    const int vcu = (G_ % 8 == 0) ? (bx % 8) * (G_ / 8) + bx / 8 : bx;
#define PHASE_PTRS \
    const __attribute__((address_space(4))) Args* ka_ = (const __attribute__((address_space(4))) Args*)__builtin_amdgcn_kernarg_segment_ptr(); asm volatile("" : "+s"(ka_)); \
    unsigned char* ws = ka_->ws; \
    const float* in_x = ka_->in[0]; const float* in_c = ka_->in[1]; const float* in_ctx = ka_->in[2]; const float* in_cctx = ka_->in[3]; \
    const float* in_modw = ka_->in[4]; const float* in_modb = ka_->in[5]; const float* in_ang = ka_->in[6]; const float* in_mng = ka_->in[7]; \
    const float* in_win = ka_->in[8]; const float* in_wout = ka_->in[9]; const float* in_retl = ka_->in[10]; const float* in_ggw = ka_->in[11]; \
    const float* in_ggb = ka_->in[12]; const float* in_qkg = ka_->in[13]; const float* in_w1 = ka_->in[14]; const float* in_w2 = ka_->in[15]; const float* in_fng = ka_->in[16]; \
    float* xlat = ka_->out; float* xctx = (float*)(ws + WS_CTXRES); \
    float* MOD = (float*)(ws + WS_MOD); float* DEC = (float*)(ws + WS_DEC); \
    u16* XNY = (u16*)(ws + WS_XNY); u16* P = (u16*)(ws + WS_P); u16* QB = (u16*)(ws + WS_QB); u16* KB = (u16*)(ws + WS_KB); u16* VB = (u16*)(ws + WS_VB); \
    float* GT = (float*)(ws + WS_G); float* AS = (float*)(ws + WS_AS); u16* HB = (u16*)(ws + WS_H); \
    (void)in_x; (void)in_c; (void)in_ctx; (void)in_cctx; (void)in_modw; (void)in_modb; (void)in_ang; (void)in_mng; (void)in_win; (void)in_wout; (void)in_retl; (void)in_ggw; (void)in_ggb; (void)in_qkg; (void)in_w1; (void)in_w2; (void)in_fng; \
    (void)xlat; (void)xctx; (void)MOD; (void)DEC; (void)XNY; (void)P; (void)QB; (void)KB; (void)VB; (void)GT; (void)AS; (void)HB;
    volatile LAS unsigned* MISC = (volatile LAS unsigned*)(L + LDS_BYTES - 256);
    if (threadIdx.x < 16) MISC[threadIdx.x] = 0u;
    __syncthreads();
    XcdBarrier bar = xcd_barrier_post((unsigned*)(args.ws + WS_BAR), MISC + 8);
    for (int rep_ = 0; rep_ < REP_PRO; ++rep_) {
    PHASE_IDS
    PHASE_PTRS
    if (bx < 192) {
        LAS float* sl = (LAS float*)L;
        for (int i = tid; i < 3072; i += 512) { const int cond = i >> 10, k = i & 1023; const float cv = cond < 2 ? in_c[cond * 1024 + k] : in_cctx[k]; sl[i] = cv / (1.f + expf(-cv)); }
        __syncthreads();
        const int layer = bx / 96, cn = tid & 63, col = (bx % 96) * 64 + cn, kg = tid >> 6;
        const float* wp = in_modw + (size_t)layer * 1024 * 6144 + (size_t)(kg * 128) * 6144 + col;
        float a0 = 0.f, a1 = 0.f, a2 = 0.f;
#pragma unroll 16
        for (int q = 0; q < 128; ++q) { const float w = wp[(size_t)q * 6144]; const int k = kg * 128 + q; a0 += sl[k] * w; a1 += sl[1024 + k] * w; a2 += sl[2048 + k] * w; }
        LAS float* red = sl + 3072;
        red[(kg * 3 + 0) * 64 + cn] = a0; red[(kg * 3 + 1) * 64 + cn] = a1; red[(kg * 3 + 2) * 64 + cn] = a2;
        __syncthreads();
        if (tid < 192) { const int cond = tid >> 6, c2 = tid & 63; float s = 0.f;
#pragma unroll
            for (int g = 0; g < 8; ++g) s += red[(g * 3 + cond) * 64 + c2];
            const int cc = (bx % 96) * 64 + c2; MOD[(size_t)(layer * 3 + cond) * 6144 + cc] = s + in_modb[layer * 6144 + cc]; }
        __syncthreads();
    }
    for (int i = bx * 512 + tid; i < 4096; i += G_ * 512) {
        const int pos = i >> 4, j = i & 15; const float invf = exp2f(-(float)j * 0.8304820237218406f); float sn, cs; sincosf((float)pos * invf, &sn, &cs);
        ((f32x2*)(ws + WS_TAB))[i] = (f32x2){cs, sn}; }
    {
        LAS float* scr = (LAS float*)(L + wave * 16384);
        for (int it = gw; it < 11552; it += NGW) {
            const int l = it / 5776; int r = it % 5776; unsigned char* wl = ws + WS_W + (size_t)l * W_LAYER;
            if (r < 1168) { const int nb = r % 73; if (nb != 48) p0_transpose_item(in_win + (size_t)l * 1024 * IN_W, 1024, IN_W, (u16*)(wl + W_IN), scr, r, lane, nb > 48 ? -32 : 0); continue; } r -= 1168;
            if (r < 512) { p0_transpose_item(in_wout + (size_t)l * 1024 * 1024, 1024, 1024, (u16*)(wl + W_OUT), scr, r, lane); continue; } r -= 512;
            if (r < 2048) { p0_transpose_item(in_w1 + (size_t)l * 1024 * 4096, 1024, 4096, (u16*)(wl + W_1), scr, r, lane); continue; } r -= 2048;
            p0_transpose_item(in_w2 + (size_t)l * 4096 * 1024, 4096, 1024, (u16*)(wl + W_2), scr, r, lane);
        }
        for (int idx = bx * 512 + tid; idx < 2 * 256 * 128; idx += G_ * 512) {
            const int l = idx >> 15, rem = idx & 32767, n = rem >> 7, k0 = (rem & 127) * 8, dirn = n >> 7, np = n & 127;
            const float* gwp = in_ggw + (size_t)l * 4096 + dirn * 2048 + np; const float* wp = in_win + (size_t)l * 1024 * IN_W + (size_t)k0 * IN_W + SRC_GA + dirn * 16;
            float o[8];
#pragma unroll
            for (int q = 0; q < 8; ++q) { float s = 0.f;
#pragma unroll
                for (int i = 0; i < 16; ++i) s += wp[(size_t)q * IN_W + i] * gwp[i * 128];
                o[q] = s; }
            u32x4 w; w.x = pk2(o[0], o[1]); w.y = pk2(o[2], o[3]); w.z = pk2(o[4], o[5]); w.w = pk2(o[6], o[7]);
            *(u32x4*)((u16*)(ws + WS_W + (size_t)l * W_LAYER + W_IN) + (size_t)(C_Z + n) * 1024 + k0) = w; }
    }
    __syncthreads();
    }
    if (args.ws == nullptr) grid.sync();
    xcd_barrier(bar);

    for (int step = 0; step < 20; ++step) {
        const int layer = step / 10, ph = step % 10;
        PHASE_IDS
        PHASE_PTRS
        unsigned char* wl = ws + WS_W + (size_t)layer * W_LAYER;
        const float* modl = MOD + (size_t)layer * 3 * 6144;
        if (ph == 0 || ph == 7) {
            for (int rep_ = 0; rep_ < REP_NORM; ++rep_) {

            const bool from_in = (layer == 0) || (ph == 0);
            const float* sl_ = from_in ? in_x : xlat; const float* sc_ = from_in ? in_ctx : xctx;
            const u16* ya = (layer == 0 && ph == 0) ? nullptr : (const u16*)(ws + WS_YA);
            const u16* yb = (layer == 1 && ph == 0) ? XNY : nullptr;
            const bool wx = (layer == 1 && ph == 0);
            const float* gvec = (ph == 0 ? in_ang : in_mng) + layer * 1024;
            const int sh_off = (ph == 0) ? 0 : 3072, sc_off = sh_off + 1024;
            const int Mn = (layer == 1 && ph == 7) ? M_LAT : M_ALL;
            for (int m = gw; m < Mn; m += NGW) {
                const float* src = (m < M_LAT) ? sl_ + (size_t)m * 1024 : sc_ + (size_t)(m - M_LAT) * 1024;
                const int cond = (m < M_LAT) ? (m >> 14) : 2;
                f32x4 v[4]; float ss = 0.f;
#pragma unroll
                for (int j = 0; j < 4; ++j) v[j] = *(const f32x4*)(src + 4 * lane + 256 * j);
                if (ya) {
#pragma unroll
                    for (int j = 0; j < 4; ++j) { const u32x2 y = *(const u32x2*)(ya + (size_t)m * 1024 + 4 * lane + 256 * j); v[j] = v[j] + (f32x4){bflo(y.x), bfhi(y.x), bflo(y.y), bfhi(y.y)}; } }
                if (yb) {
#pragma unroll
                    for (int j = 0; j < 4; ++j) { const u32x2 y = *(const u32x2*)(yb + (size_t)m * 1024 + 4 * lane + 256 * j); v[j] = v[j] + (f32x4){bflo(y.x), bfhi(y.x), bflo(y.y), bfhi(y.y)}; } }
#pragma unroll
                for (int j = 0; j < 4; ++j) ss += (v[j].x * v[j].x + v[j].y * v[j].y) + (v[j].z * v[j].z + v[j].w * v[j].w);
                if (wx) { float* dst = (m < M_LAT) ? xlat + (size_t)m * 1024 : xctx + (size_t)(m - M_LAT) * 1024;
#pragma unroll
                    for (int j = 0; j < 4; ++j) *(f32x4*)(dst + 4 * lane + 256 * j) = v[j]; }
                const float rstd = 1.0f / sqrtf(wave_sum(ss) * (1.f / 1024.f) + NEPS);
                const float* mc = modl + cond * 6144;
#pragma unroll
                for (int j = 0; j < 4; ++j) { const int col = 4 * lane + 256 * j;
                    const f32x4 gv = *(const f32x4*)(gvec + col), sc = *(const f32x4*)(mc + sc_off + col), sh = *(const f32x4*)(mc + sh_off + col);
                    const f32x4 hv = (v[j] * rstd) * gv * (sc + 1.0f) + sh;
                    u32x2 o; o.x = pk2(hv.x, hv.y); o.y = pk2(hv.z, hv.w); *(u32x2*)(XNY + (size_t)m * 1024 + col) = o; }
            }
            __syncthreads(); }
        } else if (ph == 1 || ph == 8 || ph == 6 || ph == 9) {
            for (int rep_ = 0; rep_ < REP_G1; ++rep_) {

            const u16* Aop = (ph == 9) ? HB : XNY; const int Kop = (ph == 9) ? FF_ : 1024;
            const u16* Bop = (const u16*)(wl + (ph == 1 ? W_IN : ph == 8 ? W_1 : ph == 6 ? W_OUT : W_2));
            const int Nmain = (ph == 1) ? NPAD : (ph == 8 ? FF_ : 1024), Nctx = Nmain;
            u16* Oop = (ph == 1) ? P : (ph == 8 ? HB : (ph == 6 ? (u16*)(ws + WS_YA) : XNY));
            const float* gate = (ph == 6) ? modl + 2048 : (ph == 9 ? modl + 5120 : (const float*)nullptr);
            if (ph == 1 || layer == 0) {
                if (gate) mini_gemm_ctx<1>(Aop + (size_t)M_LAT * Kop, Bop, Nctx, Kop, Oop + (size_t)M_LAT * Nmain, Nmain, 0, gate + 2 * 6144, L, vcu, G_, wave, lane);
                else mini_gemm_ctx<0>(Aop + (size_t)M_LAT * Kop, Bop, Nctx, Kop, Oop + (size_t)M_LAT * Nmain, Nmain, ph == 8 ? 1 : 0, nullptr, L, vcu, G_, wave, lane);
            }
            pg8::Gemm g{Aop, Bop, M_LAT, Nmain, Kop};
            pg8::StaticOrder S; S.init(g.M, g.N, G_, bx);
            pg8::EpiStoreBf16 E{Oop, Nmain, ph == 8 ? 1 : 0, gate};
            pg8::gemm_phase<pg8::EpiStoreBf16, pg8::StaticOrder, true, true>(L, g, S, E);
            __syncthreads(); }
        } else if (ph == 2) {
            LAS float* gw_s = (LAS float*)L; LAS float* gb_s = gw_s + 4096; LAS float* qg_s = gb_s + 256;
            if (tid < 256) gb_s[tid] = in_ggb[layer * 256 + tid];
            if (tid < 128) qg_s[tid] = in_qkg[layer * 128 + tid];
            __syncthreads();
            const float C2 = 0.125f * 1.4426950408889634f, KSC = 0.17677669529663687f;
            const f32x2* TAB = (const f32x2*)(ws + WS_TAB);
            const int r_head = lane >> 4, r_pi = lane & 15, r_j = r_pi & 7; const bool r_isrow = r_pi < 8; const int r_da = r_isrow ? r_j : 16 + r_j, r_db = r_da + 8;
            const int a_sub = lane & 7, a_hh = lane >> 3; const bool a_isrow = a_sub < 4; const int a_jb = a_isrow ? 4 * a_sub : 4 * a_sub - 16, a_da = a_isrow ? 4 * a_sub : 4 * a_sub + 16, a_db = a_da + 16;
            struct PostRaw { unsigned rq0, rq1, rk0, rk1; u32x2 gz; u32x2 aq0, aq1, ak0, ak1; u32x4 av; f32x2 t2; f32x4 t0, t1; };
#define POST_LOAD(R, mm) do { const u16* rp_ = P + (size_t)(mm) * NPAD; const int t_ = (mm) & 16383; const bool lat_ = (mm) < M_LAT; \
                R.rq0 = rp_[C_RQ + r_head * 32 + r_da]; R.rq1 = rp_[C_RQ + r_head * 32 + r_db]; R.rk0 = rp_[C_RK + r_head * 32 + r_da]; R.rk1 = rp_[C_RK + r_head * 32 + r_db]; \
                R.gz = *(const u32x2*)(rp_ + C_Z + 4 * lane); \
                R.aq0 = (u32x2){0u, 0u}; R.aq1 = (u32x2){0u, 0u}; \
                R.ak0 = *(const u32x2*)(rp_ + C_AK + (a_hh & 1) * 64 + a_da); R.ak1 = *(const u32x2*)(rp_ + C_AK + (a_hh & 1) * 64 + a_db); \
                R.av = *(const u32x4*)(rp_ + C_AV + (lane & 15) * 8); \
                R.t2 = (f32x2){1.f, 0.f}; R.t0 = (f32x4){1.f, 0.f, 1.f, 0.f}; R.t1 = (f32x4){1.f, 0.f, 1.f, 0.f}; \
                if (lat_) { R.t2 = TAB[(r_isrow ? (t_ >> 6) : (t_ & 63)) * 16 + 2 * r_j]; const f32x4* tp_ = (const f32x4*)(TAB + (a_isrow ? (t_ >> 6) : (t_ & 63)) * 16 + a_jb); R.t0 = tp_[0]; R.t1 = tp_[1]; } } while (0)
            PostRaw cur{};
            POST_LOAD(cur, gw);
            for (int m = gw; m < M_ALL; m += NGW) {
                PostRaw nxt = cur; const int mn = m + NGW;
                if (mn < M_ALL) POST_LOAD(nxt, mn);
                u16* rowp = P + (size_t)m * NPAD;
                const int kvb = m < M_LAT ? (m >> 14) : ((m - M_LAT) >> 8), kvt = m < M_LAT ? ((m & 16383) >> 6) : 256 + (((m - M_LAT) & 255) >> 6), kvr = m & 63;
                const size_t kvbase = ((size_t)(kvb * 2) * 260 + kvt) * 4096;
                {   const float cs = cur.t2.x, sn = cur.t2.y;
                    const float qa = bf2f(cur.rq0), qb_ = bf2f(cur.rq1), ka = bf2f(cur.rk0), kb_ = bf2f(cur.rk1);
                    const unsigned qo = pk2(qa * cs - qb_ * sn, qa * sn + qb_ * cs), ko = pk2((ka * cs - kb_ * sn) * KSC, (ka * sn + kb_ * cs) * KSC);
                    u16* qs = rowp + C_RQ + r_head * 32; u16* ks_ = rowp + C_RK + r_head * 32;
                    qs[r_da] = (u16)(qo & 0xffffu); qs[r_db] = (u16)(qo >> 16); ks_[r_da] = (u16)(ko & 0xffffu); ks_[r_db] = (u16)(ko >> 16);
                }
                {   const f32x4 bv = *(const LAS f32x4*)(gb_s + 4 * lane);
                    f32x4 g; g.x = logsig(bflo(cur.gz.x) + bv.x) * (1.f / 16.f); g.y = logsig(bfhi(cur.gz.x) + bv.y) * (1.f / 16.f); g.z = logsig(bflo(cur.gz.y) + bv.z) * (1.f / 16.f); g.w = logsig(bfhi(cur.gz.y) + bv.w) * (1.f / 16.f);
                    *(f32x4*)(GT + (size_t)m * 256 + 4 * lane) = g; }
                {   const float cs[4] = {cur.t0.x, cur.t0.z, cur.t1.x, cur.t1.z}, sn[4] = {cur.t0.y, cur.t0.w, cur.t1.y, cur.t1.w};
#pragma unroll
                    for (int pass = 1; pass < 2; ++pass) {
                        const int hd = pass == 0 ? a_hh : (a_hh & 1);
                        const u32x2 wa = pass == 0 ? cur.aq0 : cur.ak0, wb = pass == 0 ? cur.aq1 : cur.ak1;
                        float xa[4] = {bflo(wa.x), bfhi(wa.x), bflo(wa.y), bfhi(wa.y)}, xb[4] = {bflo(wb.x), bfhi(wb.x), bflo(wb.y), bfhi(wb.y)};
                        float ss = 0.f;
#pragma unroll
                        for (int e = 0; e < 4; ++e) ss += xa[e] * xa[e] + xb[e] * xb[e];
                        ss += xor_lane<1>(ss); ss += xor_lane<2>(ss); ss += xor_lane<4>(ss);
                        const float rstd = rsqrtf(ss * (1.f / 64.f) + NEPS); const float osc = pass == 0 ? C2 : 1.f;
                        float oa[4], ob[4];
#pragma unroll
                        for (int e = 0; e < 4; ++e) { const float ya = xa[e] * rstd * qg_s[pass * 64 + a_da + e], yb = xb[e] * rstd * qg_s[pass * 64 + a_db + e];
                            oa[e] = (ya * cs[e] - yb * sn[e]) * osc; ob[e] = (ya * sn[e] + yb * cs[e]) * osc; }
                        u32x2 pa, pb; pa.x = pk2(oa[0], oa[1]); pa.y = pk2(oa[2], oa[3]); pb.x = pk2(ob[0], ob[1]); pb.y = pk2(ob[2], ob[3]);
                        if (pass == 0) { u16* dp = QB + (size_t)m * 512 + hd * 64; *(u32x2*)(dp + a_da) = pa; *(u32x2*)(dp + a_db) = pb; }
                        else if (lane < 16) { u16* dp = KB + kvbase + (size_t)hd * (260 * 4096) + kvr * 8;
                            *(u32x2*)(dp + (a_da >> 3) * 512 + (a_da & 7)) = pa; *(u32x2*)(dp + (a_db >> 3) * 512 + (a_db & 7)) = pb; }
                    }
                    if (lane < 16) { const int cc = (lane & 7) * 8, vw_ = (cc >> 5) * 4 + (kvr >> 4), vl_ = (kvr & 15) * 4 + ((cc & 31) >> 3);
                        *(u32x4*)(VB + kvbase + (size_t)(lane >> 3) * (260 * 4096) + (vw_ * 64 + vl_) * 8) = cur.av; }
                }
                cur = nxt;
            }
#undef POST_LOAD
        } else if (ph == 3) {
            for (int rep_ = 0; rep_ < REP_S1; ++rep_) {

            LAS unsigned char* Lw = L + wave * 18048;
            LAS float* Bc = (LAS float*)Lw; LAS u16* KT = (LAS u16*)Lw;
            LAS u16* VT = (LAS u16*)(Lw + 8704); LAS float* tot = (LAS float*)(Lw + 8704 + 9216);
            const int nn = lane & 15, kk = lane >> 4;
            for (int item = gw; item < N_ITEM1; item += NGW) {
                const int cidx = item % 260, t = item / 260, h = t & 3, b = (t >> 2) & 1, dir = (t >> 3) & 1, grp = t >> 4;
                const int row0 = cidx < 4 ? M_LAT + b * 256 + cidx * 64 : b * 16384 + (cidx - 4) * 64;
                const u16* Pr = P + (size_t)(row0 + lane) * NPAD;
                const int kcol = (grp ? C_GK : C_RK) + h * 32, vcol = (grp ? C_GV : C_RV) + h * 64;
                u32x4 kr[4], vr[8];
#pragma unroll
                for (int q = 0; q < 4; ++q) kr[q] = *(const u32x4*)(Pr + kcol + 8 * q);
                {   const u16* Pv = P + (size_t)(row0 + (lane >> 3)) * NPAD + vcol + 8 * (lane & 7);
#pragma unroll
                    for (int q = 0; q < 8; ++q) vr[q] = *(const u32x4*)(Pv + (size_t)(8 * q) * NPAD); }
                float lg = 0.f;
                if (grp == 0) lg = logsig(in_retl[layer * 8 + dir * 4 + h]);
                else {
                    const int d = lane & 31, half = lane >> 5; float* gp = GT + (size_t)row0 * 256 + dir * 128 + h * 32 + d; float run = 0.f;
                    float gv[32];
#pragma unroll
                    for (int i = 0; i < 32; ++i) gv[i] = gp[(size_t)(32 * half + i) * 256];
                    if (dir == 0) {
#pragma unroll
                        for (int i = 0; i < 32; ++i) { run += gv[i]; gv[i] = run; }
                    } else {
#pragma unroll
                        for (int i = 31; i >= 0; --i) { run += gv[i]; gv[i] = run; }
                    }
                    const float other = other_half(run);
                    const float addv = (dir == 0) ? (half == 1 ? other : 0.f) : (half == 0 ? other : 0.f);
#pragma unroll
                    for (int i = 0; i < 32; ++i) { const float full = gv[i] + addv; Bc[(32 * half + i) * 34 + d] = full; gp[(size_t)(32 * half + i) * 256] = full; }
                    if (half == 0) tot[d] = run + other;
                    LDS_WAIT(); asm volatile("" ::: "memory");
                }
                float fac[32];
                if (grp == 0) { const float f = __expf((dir == 0 ? (float)(63 - lane) : (float)lane) * lg);
#pragma unroll
                    for (int d = 0; d < 32; ++d) fac[d] = f;
                } else {
#pragma unroll
                    for (int q = 0; q < 16; ++q) { const f32x2 bc = *(const LAS f32x2*)(Bc + lane * 34 + 2 * q); const f32x2 tt = *(const LAS f32x2*)(tot + 2 * q);
                        fac[2 * q] = __expf(tt.x - bc.x); fac[2 * q + 1] = __expf(tt.y - bc.y); }
                    LDS_WAIT(); asm volatile("" ::: "memory");
                }
#pragma unroll
                for (int q = 0; q < 4; ++q) { const unsigned w[4] = {kr[q].x, kr[q].y, kr[q].z, kr[q].w};
#pragma unroll
                    for (int c = 0; c < 4; ++c) { const int d = 8 * q + 2 * c; const unsigned pk = pk2(bflo(w[c]) * fac[d], bfhi(w[c]) * fac[d + 1]);
                        KT[d * 72 + lane] = (u16)(pk & 0xffffu); KT[(d + 1) * 72 + lane] = (u16)(pk >> 16); } }
#pragma unroll
                for (int q = 0; q < 8; ++q) { LAS u32x2* wp = (LAS u32x2*)(VT + (8 * q + (lane >> 3)) * 68 + 8 * (lane & 7));
                    wp[0] = (u32x2){vr[q].x, vr[q].y}; wp[1] = (u32x2){vr[q].z, vr[q].w}; }
                LDS_WAIT(); asm volatile("" ::: "memory");
                f32x4 acc[4][2];
#pragma unroll
                for (int a = 0; a < 4; ++a) { acc[a][0] = (f32x4){0.f, 0.f, 0.f, 0.f}; acc[a][1] = (f32x4){0.f, 0.f, 0.f, 0.f}; }
#pragma unroll
                for (int ks = 0; ks < 2; ++ks) {
                    const mbf16x8 b0 = *(const LAS mbf16x8*)(KT + nn * 72 + 32 * ks + 8 * kk), b1 = *(const LAS mbf16x8*)(KT + (16 + nn) * 72 + 32 * ks + 8 * kk);
#pragma unroll
                    for (int mt = 0; mt < 4; ++mt) {
                        typedef short tr4_t __attribute__((ext_vector_type(4)));
                        const LAS u16* ap_ = VT + (32 * ks + 8 * kk + (nn >> 2)) * 68 + 16 * mt + 4 * (nn & 3);
                        const tr4_t lo_ = __builtin_amdgcn_ds_read_tr16_b64_v4i16((LAS tr4_t*)ap_), hi_ = __builtin_amdgcn_ds_read_tr16_b64_v4i16((LAS tr4_t*)(ap_ + 4 * 68));
                        const mbf16x8 a = (mbf16x8){lo_[0], lo_[1], lo_[2], lo_[3], hi_[0], hi_[1], hi_[2], hi_[3]};
                        acc[mt][0] = __builtin_amdgcn_mfma_f32_16x16x32_bf16(a, b0, acc[mt][0], 0, 0, 0); acc[mt][1] = __builtin_amdgcn_mfma_f32_16x16x32_bf16(a, b1, acc[mt][1], 0, 0, 0); }
                }
                float* o = AS + (size_t)item * 2048;
#pragma unroll
                for (int mt = 0; mt < 4; ++mt)
#pragma unroll
                    for (int nt = 0; nt < 2; ++nt)
#pragma unroll
                        for (int r = 0; r < 4; ++r) o[(16 * mt + 4 * kk + r) * 32 + 16 * nt + nn] = acc[mt][nt][r];
                if (lane < 32) DEC[(size_t)item * 32 + lane] = grp == 0 ? __expf(64.f * lg) : __expf(tot[lane]);
                LDS_WAIT(); asm volatile("" ::: "memory");
            }
            __syncthreads(); }
        } else if (ph == 4) {
            const int gt_ = bx * 512 + tid;
            for (int rep_ = 0; rep_ < REP_S2; ++rep_)
            if (gt_ < 32 * 2048) {
                const int seq = gt_ >> 11, elem = gt_ & 2047, d = elem & 31, dir = (seq >> 3) & 1;
                float* base = AS + (size_t)seq * 260 * 2048 + elem; const float* dbase = DEC + (size_t)seq * 260 * 32 + d;
                float S = 0.f;
                for (int n0 = 0; n0 < 260; n0 += 52) {
                    float a[52], dc[52];
#pragma unroll
                    for (int q = 0; q < 52; ++q) { const int n = n0 + q; const int ci = dir == 0 ? n : (n < 4 ? 3 - n : 263 - n); a[q] = base[(size_t)ci * 2048]; dc[q] = dbase[(size_t)ci * 32]; }
#pragma unroll
                    for (int q = 0; q < 52; ++q) { const int n = n0 + q; const int ci = dir == 0 ? n : (n < 4 ? 3 - n : 263 - n); (rep_ + 1 < REP_S2 ? base + 17039360 : base)[(size_t)ci * 2048] = S; S = dc[q] * S + a[q]; }
                }
            }
        } else if (ph == 5) {
            for (int rep_ = 0; rep_ < REP_S3; ++rep_) {
                const int slot = wave >> 2, w4 = wave & 3, t4 = tid & 255;
                LAS u16* KFs = (LAS u16*)(L + slot * 32768); LAS u16* KBs = KFs + 64 * 40; LAS u16* VT = KBs + 64 * 40; LAS u16* ST = VT + 64 * 72;
                const int nn = lane & 15, kk = lane >> 4;
                for (int pr = bx; pr < N_ITEM3 / 2; pr += G_) {
                    const int item = pr * 2 + slot;
                    const int cidx = item % 260, t = item / 260, h = t & 3, b = (t >> 2) & 1, grp = t >> 3;
                    const int row0 = cidx < 4 ? M_LAT + b * 256 + cidx * 64 : b * 16384 + (cidx - 4) * 64;
                    const u16* Pr = P + (size_t)row0 * NPAD;
                    const int qcol = (grp ? C_GQ : C_RQ) + h * 32, kcol = (grp ? C_GK : C_RK) + h * 32, vcol = (grp ? C_GV : C_RV) + h * 64, gcol = (grp ? C_GG : C_RG) + h * 64;
                    const size_t itF = (size_t)((((grp * 2 + 0) * 2 + b) * 4 + h) * 260 + cidx), itB = (size_t)((((grp * 2 + 1) * 2 + b) * 4 + h) * 260 + cidx);
                    const float lgf = logsig(in_retl[layer * 8 + h]), lgb = logsig(in_retl[layer * 8 + 4 + h]);
                    const int jr = t4 >> 2, d0 = (t4 & 3) * 8, iq = 16 * w4 + nn;
                    const u32x4 qw = *(const u32x4*)(Pr + (size_t)iq * NPAD + qcol + 8 * kk);
                    const u32x4 kw = *(const u32x4*)(Pr + (size_t)jr * NPAD + kcol + d0);
                    const u32x4 va = *(const u32x4*)(Pr + (size_t)jr * NPAD + vcol + (t4 & 3) * 16), vb = *(const u32x4*)(Pr + (size_t)jr * NPAD + vcol + (t4 & 3) * 16 + 8);
                    const f32x4 sf0 = *(const f32x4*)(AS + itF * 2048 + t4 * 8), sf1 = *(const f32x4*)(AS + itF * 2048 + t4 * 8 + 4);
                    const f32x4 sb0 = *(const f32x4*)(AS + itB * 2048 + t4 * 8), sb1 = *(const f32x4*)(AS + itB * 2048 + t4 * 8 + 4);
                    u16 graw[4][4];
#pragma unroll
                    for (int r = 0; r < 4; ++r)
#pragma unroll
                        for (int et = 0; et < 4; ++et) graw[r][et] = Pr[(size_t)(16 * w4 + 4 * kk + r) * NPAD + gcol + nn + 16 * et];
                    f32x4 bq[4], bk[4];
#pragma unroll
                    for (int s = 0; s < 4; ++s) { bq[s] = (f32x4){0.f, 0.f, 0.f, 0.f}; bk[s] = (f32x4){0.f, 0.f, 0.f, 0.f}; }
                    if (grp == 1) { const float* gq = GT + (size_t)(row0 + iq) * 256 + h * 32 + 8 * kk; const float* gk = GT + (size_t)(row0 + jr) * 256 + h * 32 + d0;
                        bq[0] = *(const f32x4*)gq; bq[1] = *(const f32x4*)(gq + 4); bq[2] = *(const f32x4*)(gq + 128); bq[3] = *(const f32x4*)(gq + 132);
                        bk[0] = *(const f32x4*)gk; bk[1] = *(const f32x4*)(gk + 4); bk[2] = *(const f32x4*)(gk + 128); bk[3] = *(const f32x4*)(gk + 132); }
                    else { const float ef = (float)(iq + 1) * lgf, eb = (float)(64 - iq) * lgb, kf = (float)(jr + 1) * lgf, kb = (float)(64 - jr) * lgb;
                        bq[0] = bq[1] = (f32x4){ef, ef, ef, ef}; bq[2] = bq[3] = (f32x4){eb, eb, eb, eb}; bk[0] = bk[1] = (f32x4){kf, kf, kf, kf}; bk[2] = bk[3] = (f32x4){kb, kb, kb, kb}; }
                    mbf16x8 qfr_f, qfr_b;
                    {   const float qs = grp ? 0.17677669529663687f : 1.f;
                        const float qx[8] = {bflo(qw.x) * qs, bfhi(qw.x) * qs, bflo(qw.y) * qs, bfhi(qw.y) * qs, bflo(qw.z) * qs, bfhi(qw.z) * qs, bflo(qw.w) * qs, bfhi(qw.w) * qs};
                        u32x4 pf, pb;
                        pf.x = pk2(qx[0] * __expf(bq[0].x), qx[1] * __expf(bq[0].y)); pf.y = pk2(qx[2] * __expf(bq[0].z), qx[3] * __expf(bq[0].w));
                        pf.z = pk2(qx[4] * __expf(bq[1].x), qx[5] * __expf(bq[1].y)); pf.w = pk2(qx[6] * __expf(bq[1].z), qx[7] * __expf(bq[1].w));
                        pb.x = pk2(qx[0] * __expf(bq[2].x), qx[1] * __expf(bq[2].y)); pb.y = pk2(qx[2] * __expf(bq[2].z), qx[3] * __expf(bq[2].w));
                        pb.z = pk2(qx[4] * __expf(bq[3].x), qx[5] * __expf(bq[3].y)); pb.w = pk2(qx[6] * __expf(bq[3].z), qx[7] * __expf(bq[3].w));
                        qfr_f = __builtin_bit_cast(mbf16x8, pf); qfr_b = __builtin_bit_cast(mbf16x8, pb); }
                    {   const float kx[8] = {bflo(kw.x), bfhi(kw.x), bflo(kw.y), bfhi(kw.y), bflo(kw.z), bfhi(kw.z), bflo(kw.w), bfhi(kw.w)};
                        u32x4 pf, pb;
                        pf.x = pk2(kx[0] * __expf(-bk[0].x), kx[1] * __expf(-bk[0].y)); pf.y = pk2(kx[2] * __expf(-bk[0].z), kx[3] * __expf(-bk[0].w));
                        pf.z = pk2(kx[4] * __expf(-bk[1].x), kx[5] * __expf(-bk[1].y)); pf.w = pk2(kx[6] * __expf(-bk[1].z), kx[7] * __expf(-bk[1].w));
                        pb.x = pk2(kx[0] * __expf(-bk[2].x), kx[1] * __expf(-bk[2].y)); pb.y = pk2(kx[2] * __expf(-bk[2].z), kx[3] * __expf(-bk[2].w));
                        pb.z = pk2(kx[4] * __expf(-bk[3].x), kx[5] * __expf(-bk[3].y)); pb.w = pk2(kx[6] * __expf(-bk[3].z), kx[7] * __expf(-bk[3].w));
                        *(LAS u32x4*)(KFs + jr * 40 + d0) = pf; *(LAS u32x4*)(KBs + jr * 40 + d0) = pb;
                        u32x4 s0, s1; s0.x = pk2(sf0.x, sf0.y); s0.y = pk2(sf0.z, sf0.w); s0.z = pk2(sf1.x, sf1.y); s0.w = pk2(sf1.z, sf1.w);
                        s1.x = pk2(sb0.x, sb0.y); s1.y = pk2(sb0.z, sb0.w); s1.z = pk2(sb1.x, sb1.y); s1.w = pk2(sb1.z, sb1.w);
                        *(LAS u32x4*)(ST + jr * 72 + d0) = s0; *(LAS u32x4*)(ST + jr * 72 + 32 + d0) = s1;
                        const int c0 = (t4 & 3) * 16; const unsigned vw[8] = {va.x, va.y, va.z, va.w, vb.x, vb.y, vb.z, vb.w};
#pragma unroll
                        for (int q = 0; q < 8; ++q) { VT[(c0 + 2 * q) * 72 + jr] = (u16)(vw[q] & 0xffffu); VT[(c0 + 2 * q + 1) * 72 + jr] = (u16)(vw[q] >> 16); } }
                    __syncthreads();
                    const f32x4 z4 = (f32x4){0.f, 0.f, 0.f, 0.f};
                    f32x4 sc[4];
#pragma unroll
                    for (int jt = 0; jt < 4; ++jt) {
                        const mbf16x8 kf_ = *(const LAS mbf16x8*)(KFs + (16 * jt + nn) * 40 + 8 * kk), kb_ = *(const LAS mbf16x8*)(KBs + (16 * jt + nn) * 40 + 8 * kk);
                        if (jt < w4) sc[jt] = __builtin_amdgcn_mfma_f32_16x16x32_bf16(kf_, qfr_f, z4, 0, 0, 0);
                        else if (jt > w4) sc[jt] = __builtin_amdgcn_mfma_f32_16x16x32_bf16(kb_, qfr_b, z4, 0, 0, 0);
                        else { const f32x4 a = __builtin_amdgcn_mfma_f32_16x16x32_bf16(kf_, qfr_f, z4, 0, 0, 0), c = __builtin_amdgcn_mfma_f32_16x16x32_bf16(kb_, qfr_b, z4, 0, 0, 0);
#pragma unroll
                            for (int r = 0; r < 4; ++r) sc[jt][r] = (4 * kk + r <= nn) ? a[r] : c[r]; }
                    }
                    f32x4 O[4];
#pragma unroll
                    for (int et = 0; et < 4; ++et) O[et] = z4;
#pragma unroll
                    for (int p2 = 0; p2 < 2; ++p2) {
                        u32x4 pa; pa.x = pk2(sc[2 * p2][0], sc[2 * p2][1]); pa.y = pk2(sc[2 * p2][2], sc[2 * p2][3]); pa.z = pk2(sc[2 * p2 + 1][0], sc[2 * p2 + 1][1]); pa.w = pk2(sc[2 * p2 + 1][2], sc[2 * p2 + 1][3]);
                        const mbf16x8 af = __builtin_bit_cast(mbf16x8, pa);
#pragma unroll
                        for (int et = 0; et < 4; ++et) { const LAS u16* vp = VT + (16 * et + nn) * 72 + 32 * p2 + 4 * kk;
                            const u32x2 lo = *(const LAS u32x2*)vp, hi = *(const LAS u32x2*)(vp + 16); u32x4 pbv; pbv.x = lo.x; pbv.y = lo.y; pbv.z = hi.x; pbv.w = hi.y;
                            O[et] = __builtin_amdgcn_mfma_f32_16x16x32_bf16(af, __builtin_bit_cast(mbf16x8, pbv), O[et], 0, 0, 0); }
                    }
#pragma unroll
                    for (int et = 0; et < 4; ++et) { const LAS u16* sp = ST + (16 * et + nn) * 72 + 8 * kk;
                        O[et] = __builtin_amdgcn_mfma_f32_16x16x32_bf16(qfr_f, *(const LAS mbf16x8*)sp, O[et], 0, 0, 0);
                        O[et] = __builtin_amdgcn_mfma_f32_16x16x32_bf16(qfr_b, *(const LAS mbf16x8*)(sp + 32), O[et], 0, 0, 0); }
#pragma unroll
                    for (int r = 0; r < 4; ++r) { const int i = 16 * w4 + 4 * kk + r;
                        float x0 = O[0][r], x1 = O[1][r], x2 = O[2][r], x3 = O[3][r];
                        if (grp == 0) { float sm = (x0 + x1) + (x2 + x3); sm += xor_lane<1>(sm); sm += xor_lane<2>(sm); sm += xor_lane<4>(sm); sm += xor_lane<8>(sm);
                            const float mean = sm * (1.f / 64.f); x0 -= mean; x1 -= mean; x2 -= mean; x3 -= mean; }
                        float sq = (x0 * x0 + x1 * x1) + (x2 * x2 + x3 * x3); sq += xor_lane<1>(sq); sq += xor_lane<2>(sq); sq += xor_lane<4>(sq); sq += xor_lane<8>(sq);
                        const float rs = rsqrtf(sq * (1.f / 64.f) + NEPS);
                        const float xs[4] = {x0 * rs, x1 * rs, x2 * rs, x3 * rs};
                        u16* yp = XNY + (size_t)(row0 + i) * 1024 + grp * 256 + h * 64 + nn;
#pragma unroll
                        for (int et = 0; et < 4; ++et) { const float gate = bf2f(graw[r][et]); const float sg = gate * __builtin_amdgcn_rcpf(1.f + __expf(-gate)); yp[16 * et] = (u16)(pk2(sg * xs[et], 0.f) & 0xffffu); } }
                    __syncthreads();
                }
            }
            if (__builtin_amdgcn_readfirstlane(threadIdx.x) >= 256) __builtin_amdgcn_s_setprio(1);
            for (int rep_ = 0; rep_ < REP_ATT; ++rep_) {
                const int per = (1024 + G_ - 1) / G_;
                float gq_ = fabsf(in_qkg[layer * 128 + lane]), gk_ = fabsf(in_qkg[layer * 128 + 64 + lane]);
                gq_ = fmaxf(gq_, xor_lane<1>(gq_)); gq_ = fmaxf(gq_, xor_lane<2>(gq_)); gq_ = fmaxf(gq_, xor_lane<4>(gq_)); gq_ = fmaxf(gq_, xor_lane<8>(gq_)); gq_ = fmaxf(gq_, xor_lane<16>(gq_)); gq_ = fmaxf(gq_, other_half(gq_));
                gk_ = fmaxf(gk_, xor_lane<1>(gk_)); gk_ = fmaxf(gk_, xor_lane<2>(gk_)); gk_ = fmaxf(gk_, xor_lane<4>(gk_)); gk_ = fmaxf(gk_, xor_lane<8>(gk_)); gk_ = fmaxf(gk_, xor_lane<16>(gk_)); gk_ = fmaxf(gk_, other_half(gk_));
                const bool fixref = __builtin_amdgcn_readfirstlane((8.f * 1.4426950408889634f * 1.05f) * gq_ * gk_ < 40.f ? 1 : 0) != 0;
                for (int i = 0; i <= per; ++i) {
                    const u16 *Qw0 = P, *Kl = KB, *Vl = VB; u16* Ow0 = XNY; int NT = 4, tq0 = 0; bool rope = false;
                    if (i < per) { const int U = vcu * per + i; if (U >= 1024) continue;
                        const int bkv = U >> 8, g = (U >> 6) & 3, qb = U & 63, b = bkv >> 1, kvh = bkv & 1, h = kvh * 4 + g; const size_t qrow0 = (size_t)b * 16384 + (size_t)qb * 256;
                        Qw0 = P + qrow0 * NPAD + C_AQ + h * 64; tq0 = (int)qrow0; rope = true; Kl = KB + (size_t)(b * 2 + kvh) * (260 * 4096); Vl = VB + (size_t)(b * 2 + kvh) * (260 * 4096);
                        Ow0 = XNY + qrow0 * 1024 + 512 + h * 64; NT = 260;
                    } else { if (layer != 0 || vcu >= 16) break;
                        const int b = vcu >> 3, h = vcu & 7, kvh = h >> 2; const size_t qrow0 = (size_t)(M_LAT + b * 256);
                        Qw0 = P + qrow0 * NPAD + C_AQ + h * 64; tq0 = 0; rope = false; Kl = KB + ((size_t)(b * 2 + kvh) * 260 + 256) * 4096; Vl = VB + ((size_t)(b * 2 + kvh) * 260 + 256) * 4096;
                        Ow0 = XNY + qrow0 * 1024 + 512 + h * 64; NT = 4; }
                    const float* gqp = in_qkg + layer * 128; const float* tabp = rope ? (const float*)(ws + WS_TAB) : (const float*)nullptr;
                    if (fixref) attn_body::attn_unit<8, true>(gqp, tabp, tq0, (const attn_body::bf16*)Qw0, (const attn_body::bf16*)Kl, (const attn_body::bf16*)Vl, NT, (attn_body::bf16*)Ow0, (char*)lds);
                    else attn_body::attn_unit<8, false>(gqp, tabp, tq0, (const attn_body::bf16*)Qw0, (const attn_body::bf16*)Kl, (const attn_body::bf16*)Vl, NT, (attn_body::bf16*)Ow0, (char*)lds);
                }
            }
            __builtin_amdgcn_s_setprio(0);
        }
        for (int rep_ = 0; rep_ < REP_SYNC; ++rep_) xcd_barrier(bar);
    }
    PHASE_IDS
    PHASE_PTRS
    for (int m = gw; m < M_LAT; m += NGW) {
        float* src = xlat + (size_t)m * 1024; f32x4 v[4]; float ss = 0.f;
        const u16* ya = (const u16*)(ws + WS_YA) + (size_t)m * 1024; const u16* yb = XNY + (size_t)m * 1024;
#pragma unroll
        for (int j = 0; j < 4; ++j) { v[j] = *(const f32x4*)(src + 4 * lane + 256 * j);
            const u32x2 y = *(const u32x2*)(ya + 4 * lane + 256 * j), z = *(const u32x2*)(yb + 4 * lane + 256 * j);
            v[j] = v[j] + (f32x4){bflo(y.x), bfhi(y.x), bflo(y.y), bfhi(y.y)} + (f32x4){bflo(z.x), bfhi(z.x), bflo(z.y), bfhi(z.y)};
            ss += (v[j].x * v[j].x + v[j].y * v[j].y) + (v[j].z * v[j].z + v[j].w * v[j].w); }
        const float rstd = 1.0f / sqrtf(wave_sum(ss) * (1.f / 1024.f) + NEPS);
#pragma unroll
        for (int j = 0; j < 4; ++j) { const f32x4 gv = *(const f32x4*)(in_fng + 4 * lane + 256 * j); *(f32x4*)(src + 4 * lane + 256 * j) = (v[j] * rstd) * gv; }
    }
}

extern "C" void kernel_launch(void* const* d_in, const int* in_sizes, int n_in, void* d_out, int out_size, void* d_ws, size_t ws_size, hipStream_t stream) {
    static int grid_blocks = 0;
    if (grid_blocks == 0) {
        if (n_in != 17 || ws_size < 512 * MiB) { fprintf(stderr, "kernel_launch: unexpected n_in %d / ws %zu\n", n_in, ws_size); grid_blocks = -1; return; }
        int dev = 0, cus = 0, per_cu = 0;
        hipGetDevice(&dev); hipDeviceGetAttribute(&cus, hipDeviceAttributeMultiprocessorCount, dev);
        if (hipFuncSetAttribute((const void*)fwd_megakernel, hipFuncAttributeMaxDynamicSharedMemorySize, LDS_BYTES) != hipSuccess) { fprintf(stderr, "kernel_launch: hipFuncSetAttribute failed\n"); }
        if (hipOccupancyMaxActiveBlocksPerMultiprocessor(&per_cu, (const void*)fwd_megakernel, 512, LDS_BYTES) != hipSuccess || per_cu < 1) { fprintf(stderr, "kernel_launch: occupancy query gave %d\n", per_cu); per_cu = 1; }
        (void)hipGetLastError();
        if (per_cu > 1) per_cu = 1;
        grid_blocks = cus * per_cu;
    }
    if (grid_blocks < 0) return;
    Args a{};
    for (int i = 0; i < 17; ++i) a.in[i] = (const float*)d_in[i];
    a.out = (float*)d_out; a.ws = (unsigned char*)d_ws;
    if (hipMemsetAsync((char*)d_ws + WS_BAR, 0, WS_BAR_BYTES, stream) != hipSuccess) { fprintf(stderr, "kernel_launch: memset failed\n"); return; }
    void* kargs[] = {&a};
    hipError_t e = hipLaunchCooperativeKernel((const void*)fwd_megakernel, dim3(grid_blocks), dim3(512), kargs, LDS_BYTES, stream);
    if (e != hipSuccess) fprintf(stderr, "cooperative launch failed: %s (grid %d)\n", hipGetErrorString(e), grid_blocks);
}
```

```cpp
#include <hip/hip_runtime.h>
#include <hip/hip_cooperative_groups.h>
#include <cstdio>
#include <cstdint>
namespace cg = cooperative_groups;
namespace pg8 {
#define PG8_LAS __attribute__((address_space(3)))
typedef unsigned short bf16_t;
typedef short bf16x8 __attribute__((ext_vector_type(8)));
typedef float f32x4 __attribute__((ext_vector_type(4)));
typedef unsigned u32x4 __attribute__((ext_vector_type(4)));
constexpr int BM = 256, BK = 64, HALF = 128, HTB = HALF * BK * 2  , STAGE_BYTES = 8 * HTB, NXCD = 8, WGM = 8;

__host__ __device__ __forceinline__ int lds_byte(int r, int c) { const int st = (r >> 4) * 2 + (c >> 5), rr = r & 15, cc = c & 31, ob = rr * 64 + cc * 2; return st * 1024 + (ob ^ (((ob >> 9) & 1) << 5)); }
__host__ __device__ __forceinline__ void stage_rc(int b, int& R, int& C) { const int st = b / 1024, sb = b % 1024, swz = sb ^ (((sb >> 9) & 1) << 5); R = (st >> 1) * 16 + swz / 64; C = (st & 1) * 32 + (swz % 64) / 2; }
__host__ __device__ __forceinline__ int perm32(int rho) { const int n = rho >> 4, i = rho & 15; return 8 * (i >> 2) + 4 * n + (i & 3); }

struct Unit { int pm, pn; };
struct Gemm { const bf16_t* A; const bf16_t* Bt; int M, N, K; };

struct StaticOrder {
    int nM, nN, nwg, G, c;
    __host__ __device__ void init(int M, int N, int G_, int c_) { nM = M / BM; nN = N / BM; nwg = nM * nN; G = G_; c = c_; }
    __host__ __device__ bool next(int i, Unit& u) const {
        const long L = (long)i * G + c; if (L >= nwg) return false;
        int wgid = (int)L; { const int q = nwg / NXCD, r = nwg % NXCD, xcd = wgid % NXCD, off = wgid / NXCD; wgid = (xcd < r ? xcd * (q + 1) : r * (q + 1) + (xcd - r) * q) + off; }
        const int nig = WGM * nN, gid = wgid / nig, fm = gid * WGM, gsz = (nM - fm) < WGM ? (nM - fm) : WGM;
        u.pm = fm + ((wgid % nig) % gsz); u.pn = (wgid % nig) / gsz; return true;
    }
    __device__ __forceinline__ void a_ready(const Unit&) const {}
    __device__ __forceinline__ void done(const Unit&) const {}
};

__device__ __forceinline__ unsigned cvt_pk_bf16(float lo, float hi) { unsigned r; asm volatile("v_cvt_pk_bf16_f32 %0, %1, %2" : "=v"(r) : "v"(lo), "v"(hi)); return r; }
typedef float f32x2 __attribute__((ext_vector_type(2)));
struct EpiStoreBf16 {
    static constexpr bool PERM = true, AFTER_DRAIN = false;
    bf16_t* O; int ldc; int act; const float* gate;
    __device__ __forceinline__ void operator()(const f32x4 (&acc)[2][2][4][2], const Unit& u, int wr, int wc, int fr, int fq) const {
        const int row0 = u.pm * BM + wr * 64 + fr; const int col0 = u.pn * BM + wc * 32 + 8 * fq;
        f32x4 gv[2][2];
        if (gate) { const float* g = gate + (u.pm >> 6) * 6144 + col0;
#pragma unroll
            for (int bj = 0; bj < 2; ++bj) { gv[bj][0] = *(const f32x4*)(g + bj * HALF); gv[bj][1] = *(const f32x4*)(g + bj * HALF + 4); } }
#pragma unroll
        for (int ai = 0; ai < 2; ++ai)
#pragma unroll
            for (int m = 0; m < 4; ++m) { bf16_t* rowp = O + (size_t)(row0 + ai * HALF + m * 16) * ldc + col0;
#pragma unroll
                for (int bj = 0; bj < 2; ++bj) { f32x4 v0 = acc[ai][bj][m][0], v1 = acc[ai][bj][m][1];
                    if (gate) { v0 = v0 * gv[bj][0]; v1 = v1 * gv[bj][1]; }
                    if (act == 1) {
#pragma unroll
                        for (int e = 0; e < 4; ++e) { float a = fmaxf(v0[e], 0.f), b = fmaxf(v1[e], 0.f); v0[e] = a * a; v1[e] = b * b; } }
                    u32x4 w; w.x = cvt_pk_bf16(v0[0], v0[1]); w.y = cvt_pk_bf16(v0[2], v0[3]); w.z = cvt_pk_bf16(v1[0], v1[1]); w.w = cvt_pk_bf16(v1[2], v1[3]);
                    *(u32x4*)(rowp + bj * HALF) = w; } }
    }
};
struct EpiResid {
    static constexpr bool PERM = false, AFTER_DRAIN = false;
    float* xlat; float* xctx; const float* gt; float* dummy;
    __device__ __forceinline__ void operator()(const f32x4 (&acc)[2][2][4][2], const Unit& u, int wr, int wc, int fr, int fq) const {
        const int cond = (u.pm < 128) ? (u.pm >> 6) : 2; const float* g = gt + cond * 6144;
        const int col0 = u.pn * BM + wc * 32 + 4 * fq;
        f32x4 gv[2][2];
#pragma unroll
        for (int bj = 0; bj < 2; ++bj)
#pragma unroll
            for (int n = 0; n < 2; ++n) gv[bj][n] = *(const f32x4*)(g + col0 + bj * HALF + n * 16);
#pragma unroll
        for (int ai = 0; ai < 2; ++ai)
#pragma unroll
            for (int m = 0; m < 4; ++m) { const int r = u.pm * BM + ai * HALF + wr * 64 + m * 16 + fr;
                float* rowp = (r < 32768) ? (xlat + (size_t)r * 1024) : (xctx + (size_t)(r - 32768) * 1024);
#pragma unroll
                for (int bj = 0; bj < 2; ++bj)
#pragma unroll
                    for (int n = 0; n < 2; ++n) { float* p = rowp + col0 + bj * HALF + n * 16; f32x4 x = *(const f32x4*)p; x = x + gv[bj][n] * acc[ai][bj][m][n]; float* q = dummy ? (dummy + (size_t)(r & 16383) * 1024 + col0 + bj * HALF + n * 16) : p; *(f32x4*)q = x; } }
    }
};
template <class Epi, class Sched, bool ALIGN_EPI = false, bool SP2 = false>
__device__ __forceinline__ void gemm_phase(PG8_LAS unsigned char* lds, const Gemm g, const Sched& S, const Epi& E) {
    int tid_l = threadIdx.x; asm volatile("" : "+v"(tid_l));
    const int tid = tid_l, wid = __builtin_amdgcn_readfirstlane(tid >> 6), lane = tid & 63, wr = wid >> 2, wc = wid & 3, fr = lane & 15, fq = lane >> 4;
    const int K = g.K, nt = K / BK;
    unsigned voffA[2], voffB[2];
#pragma unroll
    for (int i = 0; i < 2; ++i) { int R, C; stage_rc(tid * 16 + i * 8192, R, C); const int Rb = Epi::PERM ? ((R & ~31) + perm32(R & 31)) : R;
        voffA[i] = (unsigned)(R * K + C) * 2u; voffB[i] = (unsigned)(Rb * K + C) * 2u; }
    const size_t kstep = (size_t)(BK * 2);
    const size_t hstep = (size_t)HALF * K * 2;
    const size_t tstep = 2 * hstep;
    const unsigned ldsw = (unsigned)wid * 1024u;
    const int aoff = lds_byte(wr * 64 + fr, fq * 8), boff = lds_byte(wc * 32 + fr, fq * 8);
#define PG8_SA(b, h) (((b) * 2 + (h)) * HTB)
#define PG8_SB(b, h) ((4 + (b) * 2 + (h)) * HTB)
#define PG8_STAGE(bufoff, gbase, voff) do { _Pragma("unroll") for (int _i = 0; _i < 2; ++_i) \
        __builtin_amdgcn_global_load_lds((const unsigned*)((const char*)(gbase) + (voff)[_i]), (PG8_LAS unsigned*)(lds + (bufoff) + ldsw + _i * 8192), 16, 0, 0); } while (0)
#define PG8_LDA(dst, b, h) do { _Pragma("unroll") for (int m = 0; m < 4; ++m) _Pragma("unroll") for (int k = 0; k < 2; ++k) dst[m][k] = *(const PG8_LAS bf16x8*)(lds + PG8_SA(b, h) + aoff + m * 2048 + k * 1024); } while (0)
#define PG8_LDB(dst, b, h) do { _Pragma("unroll") for (int n = 0; n < 2; ++n) _Pragma("unroll") for (int k = 0; k < 2; ++k) dst[n][k] = *(const PG8_LAS bf16x8*)(lds + PG8_SB(b, h) + boff + n * 2048 + k * 1024); } while (0)
#define PG8_MMA(ai, bj, At, Bt) do { __builtin_amdgcn_s_setprio(1); _Pragma("unroll") for (int m = 0; m < 4; ++m) _Pragma("unroll") for (int n = 0; n < 2; ++n) _Pragma("unroll") for (int k = 0; k < 2; ++k) \
        acc[ai][bj][m][n] = __builtin_amdgcn_mfma_f32_16x16x32_bf16(Bt[n][k], At[m][k], acc[ai][bj][m][n], 0, 0, 0); __builtin_amdgcn_s_setprio(0); } while (0)
#define PG8_WAIT_V(n) asm volatile("s_waitcnt vmcnt(" #n ")" ::: "memory")
#define PG8_WAIT_L(n) asm volatile("s_waitcnt lgkmcnt(" #n ")" ::: "memory")
#define PG8_BAR __builtin_amdgcn_s_barrier()
#define PG8_SCHED __builtin_amdgcn_sched_barrier(0)
    Unit cur, nxt; int ui = 0;
    if (!S.next(0, cur)) return;
    f32x4 acc[2][2][4][2];
#pragma unroll
    for (int a = 0; a < 2; ++a)
#pragma unroll
        for (int b = 0; b < 2; ++b)
#pragma unroll
            for (int m = 0; m < 4; ++m)
#pragma unroll
                for (int n = 0; n < 2; ++n) acc[a][b][m][n] = (f32x4){0.f, 0.f, 0.f, 0.f};
    bf16x8 At[4][2], B0[2][2], B1[2][2];
    const char* cA = (const char*)g.A + (size_t)cur.pm * tstep; const char* cB = (const char*)g.Bt + (size_t)cur.pn * tstep;
    S.a_ready(cur);
    if constexpr (SP2) {
        PG8_STAGE(PG8_SB(0, 0), cB, voffB); PG8_STAGE(PG8_SB(0, 1), cB + hstep, voffB); PG8_STAGE(PG8_SA(0, 0), cA, voffA); PG8_STAGE(PG8_SA(0, 1), cA + hstep, voffA);
        if (wr == 1) PG8_BAR;
        PG8_WAIT_V(2); PG8_BAR;
        PG8_STAGE(PG8_SB(1, 0), cB + kstep, voffB); PG8_STAGE(PG8_SA(1, 0), cA + kstep, voffA); PG8_STAGE(PG8_SB(1, 1), cB + hstep + kstep, voffB);
        PG8_WAIT_V(6); PG8_BAR;
    } else {
        PG8_STAGE(PG8_SB(0, 0), cB, voffB); PG8_STAGE(PG8_SA(0, 0), cA, voffA); PG8_STAGE(PG8_SB(0, 1), cB + hstep, voffB); PG8_STAGE(PG8_SA(0, 1), cA + hstep, voffA);
        if (wr == 1) PG8_BAR;
        PG8_WAIT_V(4); PG8_BAR;
        PG8_STAGE(PG8_SB(1, 0), cB + kstep, voffB); PG8_STAGE(PG8_SA(1, 0), cA + kstep, voffA); PG8_STAGE(PG8_SB(1, 1), cB + hstep + kstep, voffB);
        PG8_WAIT_V(6); PG8_BAR;
    }
    for (;;) {
        const bool has_next = S.next(ui + 1, nxt);
        const char* nA = has_next ? (const char*)g.A + (size_t)nxt.pm * tstep : cA; const char* nB = has_next ? (const char*)g.Bt + (size_t)nxt.pn * tstep : cB;
        for (int t = 0; t < nt; t += 2) {
            const bool last = (t == nt - 2);
            const char* a1 = cA + (size_t)(t + 1) * kstep;
            const char* a2 = last ? nA : cA + (size_t)(t + 2) * kstep; const char* b2 = last ? nB : cB + (size_t)(t + 2) * kstep;
            const char* a3 = a2 + kstep; const char* b3 = b2 + kstep;
            if (last && has_next) S.a_ready(nxt);
            if constexpr (SP2) {
            PG8_LDB(B0, 0, 0); PG8_LDB(B1, 0, 1); PG8_SCHED; PG8_LDA(At, 0, 0); PG8_STAGE(PG8_SA(1, 1), a1 + hstep, voffA);
            PG8_WAIT_V(8); PG8_WAIT_L(0); PG8_BAR; PG8_MMA(0, 0, At, B0); PG8_MMA(0, 1, At, B1); PG8_BAR; PG8_SCHED;
            PG8_LDA(At, 0, 1); PG8_STAGE(PG8_SB(0, 0), b2, voffB); PG8_STAGE(PG8_SB(0, 1), b2 + hstep, voffB); PG8_STAGE(PG8_SA(0, 0), a2, voffA);
            PG8_WAIT_V(8); PG8_WAIT_L(0); PG8_BAR; PG8_MMA(1, 0, At, B0); PG8_MMA(1, 1, At, B1); PG8_BAR; PG8_SCHED;
            PG8_LDB(B0, 1, 0); PG8_LDB(B1, 1, 1); PG8_SCHED; PG8_LDA(At, 1, 0); PG8_STAGE(PG8_SA(0, 1), a2 + hstep, voffA);
            PG8_WAIT_V(8); PG8_WAIT_L(0); PG8_BAR; PG8_MMA(0, 0, At, B0); PG8_MMA(0, 1, At, B1); PG8_BAR; PG8_SCHED;
            PG8_LDA(At, 1, 1); PG8_STAGE(PG8_SB(1, 0), b3, voffB); PG8_STAGE(PG8_SB(1, 1), b3 + hstep, voffB); PG8_STAGE(PG8_SA(1, 0), a3, voffA);
            PG8_WAIT_V(8); PG8_WAIT_L(0); PG8_BAR; PG8_MMA(1, 0, At, B0); PG8_MMA(1, 1, At, B1); PG8_BAR; PG8_SCHED;
            } else {
            PG8_LDB(B0, 0, 0); PG8_SCHED; PG8_LDA(At, 0, 0); PG8_STAGE(PG8_SA(1, 1), a1 + hstep, voffA);
            PG8_WAIT_L(8); PG8_BAR; PG8_WAIT_L(0); PG8_MMA(0, 0, At, B0); PG8_BAR; PG8_SCHED;
            PG8_LDB(B1, 0, 1); PG8_STAGE(PG8_SB(0, 0), b2, voffB);
            PG8_BAR; PG8_WAIT_L(0); PG8_MMA(0, 1, At, B1); PG8_BAR;
            PG8_LDA(At, 0, 1); PG8_STAGE(PG8_SA(0, 0), a2, voffA);
            PG8_BAR; PG8_WAIT_L(0); PG8_MMA(1, 0, At, B0); PG8_BAR; PG8_SCHED;
            PG8_STAGE(PG8_SB(0, 1), b2 + hstep, voffB);
            PG8_WAIT_V(6); PG8_BAR; PG8_MMA(1, 1, At, B1); PG8_BAR;
            PG8_LDB(B0, 1, 0); PG8_SCHED; PG8_LDA(At, 1, 0); PG8_STAGE(PG8_SA(0, 1), a2 + hstep, voffA);
            PG8_WAIT_L(8); PG8_BAR; PG8_WAIT_L(0); PG8_MMA(0, 0, At, B0); PG8_BAR; PG8_SCHED;
            PG8_LDB(B1, 1, 1); PG8_STAGE(PG8_SB(1, 0), b3, voffB);
            PG8_BAR; PG8_WAIT_L(0); PG8_MMA(0, 1, At, B1); PG8_BAR;
            PG8_LDA(At, 1, 1); PG8_STAGE(PG8_SA(1, 0), a3, voffA);
            PG8_BAR; PG8_WAIT_L(0); PG8_MMA(1, 0, At, B0); PG8_BAR; PG8_SCHED;
            PG8_STAGE(PG8_SB(1, 1), b3 + hstep, voffB);
            PG8_WAIT_V(6); PG8_BAR; PG8_MMA(1, 1, At, B1); PG8_BAR;
            }
        }
        if constexpr (ALIGN_EPI) { if (wr == 0) PG8_BAR; }
        if constexpr (!Epi::AFTER_DRAIN) { E(acc, cur, wr, wc, fr, fq); S.done(cur); }
        if (!has_next) break;
#pragma unroll
        for (int a = 0; a < 2; ++a)
#pragma unroll
            for (int b = 0; b < 2; ++b)
#pragma unroll
                for (int m = 0; m < 4; ++m)
#pragma unroll
                    for (int n = 0; n < 2; ++n) acc[a][b][m][n] = (f32x4){0.f, 0.f, 0.f, 0.f};
        cur = nxt; cA = nA; cB = nB; ++ui;
        if constexpr (ALIGN_EPI) { if (wr == 1) PG8_BAR; }
    }
    PG8_WAIT_V(0);
    if constexpr (!ALIGN_EPI) { if (wr == 0) PG8_BAR; }
    PG8_BAR;
    if constexpr (Epi::AFTER_DRAIN) { E.fused(acc, cur, wr, wc, fr, fq, lds, wid, lane); S.done(cur); }
#undef PG8_SA
#undef PG8_SB
#undef PG8_STAGE
#undef PG8_LDA
#undef PG8_LDB
#undef PG8_MMA
#undef PG8_WAIT_V
#undef PG8_WAIT_L
#undef PG8_BAR
#undef PG8_SCHED
}
}
#include <hip/hip_bf16.h>
#include <cmath>
namespace attn_body {
using bf16=__hip_bfloat16;
using bf16x8=__attribute__((ext_vector_type(8)))short;
using s16x4=__attribute__((ext_vector_type(4)))short;
using f32x16=__attribute__((ext_vector_type(16)))float;
using u32x4=__attribute__((ext_vector_type(4)))unsigned;
constexpr int D=64,QP=2560,KP=128,OP=1024;
constexpr int NW=8,QBLK=32,QB=QBLK*NW,KVBLK=64;
constexpr int ATTN_UNIT_ROWS=QB;
__device__ __forceinline__ int crow(int r,int hi){return (r&3)+8*(r>>2)+4*hi;}
#define SBAR() __builtin_amdgcn_sched_barrier(0)
__device__ __forceinline__ void cmask(f32x16&p0,f32x16&p1,int jb,int qrel,int hi){
  const float NEG=-INFINITY; int kb=64*jb+4*hi;
  #pragma unroll
  for(int r=0;r<16;++r){int kv=kb+(r&3)+8*(r>>2); if(kv>qrel)p0[r]=NEG; if(kv+32>qrel)p1[r]=NEG;}
}

constexpr int NSLOT=3, SLOTB=8192;
constexpr int LDS_K=0, LDS_V=NSLOT*SLOTB, LDS_WS=2*NSLOT*SLOTB, LDS_OST=LDS_WS+NW*64*4, LDS_BYTES=LDS_OST+NW*4096;
constexpr float C2=0.125f*1.4426950408889634f;
__device__ __forceinline__ void glds16(const void*gsrc,unsigned lds_dst){unsigned keep;
  asm volatile("s_mov_b32 %0, m0\n\ts_mov_b32 m0, %2\n\ts_nop 0\n\tglobal_load_lds_dwordx4 %1, off\n\ts_mov_b32 m0, %0":"=&s"(keep):"v"(gsrc),"s"(lds_dst):"memory");}
__device__ __forceinline__ float max3f(float a,float b,float c){float r;asm("v_max3_f32 %0, %1, %2, %3":"=v"(r):"v"(a),"v"(b),"v"(c));return r;}
__device__ __forceinline__ float max2f(float a,float b){float r;asm("v_max_f32_e32 %0, %1, %2":"=v"(r):"v"(a),"v"(b));return r;}
__device__ __forceinline__ float fadd_s(float a,float b){float r;asm("v_add_f32_e32 %0, %1, %2":"=v"(r):"v"(a),"v"(b));return r;}
__device__ __forceinline__ float fsub_s(float a,float b){float r;asm("v_sub_f32_e32 %0, %1, %2":"=v"(r):"v"(a),"v"(b));return r;}
typedef float f32x2_t __attribute__((ext_vector_type(2))); typedef __bf16 bf16x2_t __attribute__((ext_vector_type(2)));
__device__ __forceinline__ unsigned cvtpk_s(float lo,float hi){f32x2_t v={lo,hi};bf16x2_t b=__builtin_convertvector(v,bf16x2_t);return __builtin_bit_cast(unsigned,b);}
#define WAIT_BAR(N) asm volatile("s_waitcnt vmcnt(" #N ") lgkmcnt(0)\n\ts_barrier":::"memory")

__device__ __forceinline__ void qkt(f32x16&p0,f32x16&p1,const char*Kslot,const bf16x8*qr,const f32x16&negm,int r32,int hi){
  const char*kb=Kslot+hi*1024+r32*16;
  #pragma unroll
  for(int d0=0;d0<4;++d0){
    const bf16x8 b0=*reinterpret_cast<const bf16x8*>(kb+d0*2048);
    const bf16x8 b1=*reinterpret_cast<const bf16x8*>(kb+d0*2048+512);
    if(d0==0){p0=__builtin_amdgcn_mfma_f32_32x32x16_bf16(b0,qr[0],negm,0,0,0);p1=__builtin_amdgcn_mfma_f32_32x32x16_bf16(b1,qr[0],negm,0,0,0);}
    else{p0=__builtin_amdgcn_mfma_f32_32x32x16_bf16(b0,qr[d0],p0,0,0,0);p1=__builtin_amdgcn_mfma_f32_32x32x16_bf16(b1,qr[d0],p1,0,0,0);}}
}
typedef __attribute__((address_space(3))) const char* lds_cptr;
typedef short v4i16_t __attribute__((ext_vector_type(4)));
__device__ __forceinline__ void kload8(bf16x8*kf,lds_cptr kp){
  kf[0]=*(const __attribute__((address_space(3))) bf16x8*)(kp);      kf[1]=*(const __attribute__((address_space(3))) bf16x8*)(kp+512);
  kf[2]=*(const __attribute__((address_space(3))) bf16x8*)(kp+2048); kf[3]=*(const __attribute__((address_space(3))) bf16x8*)(kp+2560);
  kf[4]=*(const __attribute__((address_space(3))) bf16x8*)(kp+4096); kf[5]=*(const __attribute__((address_space(3))) bf16x8*)(kp+4608);
  kf[6]=*(const __attribute__((address_space(3))) bf16x8*)(kp+6144); kf[7]=*(const __attribute__((address_space(3))) bf16x8*)(kp+6656);
}
__device__ __forceinline__ void kload2(bf16x8*kf,lds_cptr kp,int j){ kf[2*j]=*(const __attribute__((address_space(3))) bf16x8*)(kp+j*2048); kf[2*j+1]=*(const __attribute__((address_space(3))) bf16x8*)(kp+j*2048+512); }
__device__ __forceinline__ s16x4 vtr(lds_cptr p){ return __builtin_bit_cast(s16x4,__builtin_amdgcn_ds_read_tr16_b64_v4i16((__attribute__((address_space(3))) v4i16_t*)p)); }
__device__ __forceinline__ float rowmax(const f32x16&p0,const f32x16&p1){
  float a=max3f(p0[0],p0[1],p1[0]),b=max3f(p0[2],p0[3],p1[1]);a=max3f(a,p1[2],p1[3]);
  #pragma unroll
  for(int r=4;r<16;r+=4){a=max3f(a,p0[r],p0[r+1]);b=max3f(b,p0[r+2],p0[r+3]);a=max3f(a,p1[r],p1[r+1]);b=max3f(b,p1[r+2],p1[r+3]);}
  const float m=max2f(a,b);
  auto rr=__builtin_amdgcn_permlane32_swap(__float_as_uint(m),__float_as_uint(m),false,false);
  return max2f(__uint_as_float(rr[0]),__uint_as_float(rr[1]));
}
__device__ __forceinline__ void pv(f32x16*o,int vb,bf16x8 pa0,bf16x8 pa1,bf16x8 pa2,bf16x8 pa3){
  #pragma unroll
  for(int d0=0;d0<2;++d0){s16x4 lo[4],hi[4];
    #pragma unroll
    for(int ks=0;ks<4;++ks){
      asm volatile("ds_read_b64_tr_b16 %0,%1 offset:%c2":"=&v"(lo[ks]):"v"(vb),"i"(d0*4096+ks*1024):"memory");
      asm volatile("ds_read_b64_tr_b16 %0,%1 offset:%c2":"=&v"(hi[ks]):"v"(vb),"i"(d0*4096+ks*1024+512):"memory");}
    asm volatile("s_waitcnt lgkmcnt(0)":::"memory");SBAR();
    #define PK(k) (bf16x8){lo[k][0],lo[k][1],lo[k][2],lo[k][3],hi[k][0],hi[k][1],hi[k][2],hi[k][3]}
    o[d0]=__builtin_amdgcn_mfma_f32_32x32x16_bf16(pa0,PK(0),o[d0],0,0,0);
    o[d0]=__builtin_amdgcn_mfma_f32_32x32x16_bf16(pa1,PK(1),o[d0],0,0,0);
    o[d0]=__builtin_amdgcn_mfma_f32_32x32x16_bf16(pa2,PK(2),o[d0],0,0,0);
    o[d0]=__builtin_amdgcn_mfma_f32_32x32x16_bf16(pa3,PK(3),o[d0],0,0,0);
    #undef PK
  }
}

#ifndef ATTN_STORE16
#define ATTN_STORE16(p,v) (*(u32x4*)(p)=(v))
#endif
template<int THRL,bool FIXREF> __device__ __forceinline__ void attn_unit(const float*gq,const float*tab,const int tq0,const bf16*Qw0,const bf16*__restrict__ Kl,const bf16*__restrict__ Vl,const int NT,bf16*Ow0,char*shm){
  int tid_l=threadIdx.x; asm volatile("":"+v"(tid_l)); const int tid=tid_l,lane=tid&63,r32=lane&31,hi=lane>>5; const int wid=__builtin_amdgcn_readfirstlane(tid>>6);
  const bf16*Qw=Qw0+(long)(wid*QBLK)*QP;
  const unsigned lds0=(unsigned)(uintptr_t)shm;
  float*wsf=(float*)(shm+LDS_WS)+wid*64;
  const bf16*ksrc=Kl+wid*512+lane*8;
  const bf16*vsrc=Vl+wid*512+lane*8;
  const unsigned kdst=lds0+LDS_K+wid*1024, vdst=lds0+LDS_V+wid*1024;
  #define DMA_K(t,slot) glds16(ksrc+(long)(t)*4096,(unsigned)__builtin_amdgcn_readfirstlane(kdst+(slot)))
  #define DMA_V(t,slot) glds16(vsrc+(long)(t)*4096,(unsigned)__builtin_amdgcn_readfirstlane(vdst+(slot)))
  const int vb0=(int)(lds0+LDS_V)+((lane>>4)&1)*32+(lane&3)*8+(4*hi+((lane&15)>>2))*64;
  const char*Kbase=shm+LDS_K; bf16x8 kf[8];
  const lds_cptr shm3=(lds_cptr)shm; const lds_cptr kp0=shm3+LDS_K+hi*1024+r32*16; const lds_cptr vp0=shm3+LDS_V+((lane>>4)&1)*32+(lane&3)*8+(4*hi+((lane&15)>>2))*64;
  DMA_K(0,0);DMA_V(0,0);DMA_K(1,SLOTB);
  bf16x8 qr[4];
  {
    float xq[4][8]; float ss=0.f;
    #pragma unroll
    for(int d0=0;d0<4;++d0){ const u32x4 w=*reinterpret_cast<const u32x4*>(&Qw[(long)r32*QP+d0*16+hi*8]); const unsigned ww[4]={w.x,w.y,w.z,w.w};
      #pragma unroll
      for(int c=0;c<4;++c){ xq[d0][2*c]=__uint_as_float(ww[c]<<16); xq[d0][2*c+1]=__uint_as_float(ww[c]&0xffff0000u); ss+=xq[d0][2*c]*xq[d0][2*c]+xq[d0][2*c+1]*xq[d0][2*c+1]; } }
    { auto rr=__builtin_amdgcn_permlane32_swap(__float_as_uint(ss),__float_as_uint(ss),false,false); ss=__uint_as_float(rr[0])+__uint_as_float(rr[1]); }
    const float rstd=__builtin_amdgcn_rsqf(ss*(1.f/64.f)+1e-6f)*C2;
    #pragma unroll
    for(int d0=0;d0<4;++d0){ const float*gp=gq+d0*16+hi*8;
      #pragma unroll
      for(int j=0;j<8;++j)xq[d0][j]*=rstd*gp[j]; }
    if(tab){ const int tpos=(tq0+wid*QBLK+r32)&16383; const float*tr_=tab+((tpos>>6)*16+hi*8)*2; const float*tc_=tab+((tpos&63)*16+hi*8)*2;
      #pragma unroll
      for(int j=0;j<8;++j){ const float cr=tr_[2*j],sr=tr_[2*j+1],cc=tc_[2*j],sc=tc_[2*j+1];
        const float a0=xq[0][j],b0=xq[1][j],a1=xq[2][j],b1=xq[3][j];
        xq[0][j]=a0*cr-b0*sr; xq[1][j]=a0*sr+b0*cr; xq[2][j]=a1*cc-b1*sc; xq[3][j]=a1*sc+b1*cc; } }
    #pragma unroll
    for(int d0=0;d0<4;++d0){ u32x4 p; p.x=cvtpk_s(xq[d0][0],xq[d0][1]); p.y=cvtpk_s(xq[d0][2],xq[d0][3]); p.z=cvtpk_s(xq[d0][4],xq[d0][5]); p.w=cvtpk_s(xq[d0][6],xq[d0][7]); qr[d0]=__builtin_bit_cast(bf16x8,p); } }
  float mhat=0.f,l_reg=0.f;f32x16 o[2];o[0]=f32x16{};o[1]=f32x16{};f32x16 negm=f32x16{};asm volatile("":"+v"(negm));
  #define CMASK(P0,P1,t) do{}while(0)
  bool resc=false;
  #define START(P0,P1) do{ resc=false; \
    if(!FIXREF){ const float rm=rowmax(P0,P1); const float dl=rm; mhat=fadd_s(mhat,dl); \
      _Pragma("unroll") for(int r=0;r<16;++r){P0[r]=fsub_s(P0[r],dl);P1[r]=fsub_s(P1[r],dl);} \
      _Pragma("unroll") for(int r=0;r<16;++r)negm[r]=-mhat; asm volatile("":"+v"(negm)); } \
    _Pragma("unroll") for(int r=0;r<16;++r)P0[r]=__builtin_amdgcn_exp2f(P0[r]); }while(0)
  #define RESC() do{ if(resc){ asm volatile("s_waitcnt lgkmcnt(0)":::"memory"); \
      _Pragma("unroll") for(int d_=0;d_<2;++d_) _Pragma("unroll") for(int r=0;r<16;++r)o[d_][r]*=wsf[crow(r,hi)]; } }while(0)
  f32x16 pA0,pA1,pB0,pB1;
  int sl_prev=0,sl_cur=0,sl_next=SLOTB;
  #define ROT() do{sl_prev=sl_cur;sl_cur=sl_next;sl_next=(sl_next==(NSLOT-1)*SLOTB)?0:sl_next+SLOTB;}while(0)
  DMA_K(2,2*SLOTB);
  WAIT_BAR(3);
  qkt(pA0,pA1,Kbase,qr,negm,r32,hi);asm volatile("s_nop 15\n\ts_nop 7":"+v"(pA0),"+v"(pA1));CMASK(pA0,pA1,0);
  START(pA0,pA1);
  _Pragma("unroll") for(int r=0;r<16;++r)pA1[r]=__builtin_amdgcn_exp2f(pA1[r]);
  WAIT_BAR(0);
  DMA_K(3,0);DMA_V(1,SLOTB);
  ROT();
  kload8(kf,kp0+sl_cur);
  WAIT_BAR(2);
  s16x4 vlo[8],vhi[8]; u32x4 pw0,pw1,pw2,pw3;
  #define PKW(P,B) cvtpk_s(P[B],P[B+1])
  #define PAF(k) __builtin_bit_cast(bf16x8,pw##k)
  #define VFR(i) (bf16x8){vlo[i][0],vlo[i][1],vlo[i][2],vlo[i][3],vhi[i][0],vhi[i][1],vhi[i][2],vhi[i][3]}
  #define PIN(x) asm volatile("":"+v"(x))
  #define MX3(a,b,c) __builtin_fmaxf(__builtin_fmaxf((a),(b)),(c))
  #define GAPA(MF,A0,A1,A2,A3,W0,W1,PW) do{ MF; sacc+=A0; sacc+=A1; sacc+=A2; sacc+=A3; PIN(sacc); W0; W1; PIN(PW); SBAR(); }while(0)
  #define EX(v) __builtin_amdgcn_exp2f(v)
  #define GAPB(MF,X,B) do{ MF; X[B]=EX(X[B]); X[B+1]=EX(X[B+1]); X[B+2]=EX(X[B+2]); X[B+3]=EX(X[B+3]); PIN(X); SBAR(); }while(0)
  #define VRD(i) do{ vlo[i]=vtr(vp_+(((i)>>2)*4096+((i)&3)*1024)); vhi[i]=vtr(vp_+(((i)>>2)*4096+((i)&3)*1024+512)); }while(0)
  #define KRD(G,j) do{ if(G){ kload2(kf,kp0+sl_next,j); SBAR(); } }while(0)
  #define STEP(C0,C1,P0,P1,t,GK,GV,GL) do{ SBAR(); \
    const lds_cptr vp_=vp0+sl_prev; \
    VRD(0); SBAR(); float sacc=(P0[0]+P0[1]); \
    GAPA(C0=__builtin_amdgcn_mfma_f32_32x32x16_bf16(kf[0],qr[0],negm,0,0,0), P0[2],P0[3],P0[4],P0[5],     pw0[0]=PKW(P0,0), pw0[1]=PKW(P0,2), pw0); \
    VRD(4); SBAR(); GAPA(C1=__builtin_amdgcn_mfma_f32_32x32x16_bf16(kf[1],qr[0],negm,0,0,0), P0[6],P0[7],P0[8],P0[9],     pw0[2]=PKW(P0,4), pw0[3]=PKW(P0,6), pw0); \
    VRD(1); SBAR(); GAPA(C0=__builtin_amdgcn_mfma_f32_32x32x16_bf16(kf[2],qr[1],C0,0,0,0),   P0[10],P0[11],P0[12],P0[13], pw1[0]=PKW(P0,8), pw1[1]=PKW(P0,10), pw1); \
    VRD(5); SBAR(); GAPA(C1=__builtin_amdgcn_mfma_f32_32x32x16_bf16(kf[3],qr[1],C1,0,0,0),   P0[14],P0[15],P1[0],P1[1],   pw1[2]=PKW(P0,12),pw1[3]=PKW(P0,14), pw1); \
    VRD(2); SBAR(); GAPA(C0=__builtin_amdgcn_mfma_f32_32x32x16_bf16(kf[4],qr[2],C0,0,0,0),   P1[2],P1[3],P1[4],P1[5],     pw2[0]=PKW(P1,0), pw2[1]=PKW(P1,2), pw2); \
    VRD(6); SBAR(); GAPA(C1=__builtin_amdgcn_mfma_f32_32x32x16_bf16(kf[5],qr[2],C1,0,0,0),   P1[6],P1[7],P1[8],P1[9],     pw2[2]=PKW(P1,4), pw2[3]=PKW(P1,6), pw2); \
    VRD(3); SBAR(); GAPA(C0=__builtin_amdgcn_mfma_f32_32x32x16_bf16(kf[6],qr[3],C0,0,0,0),   P1[10],P1[11],P1[12],P1[13], pw3[0]=PKW(P1,8), pw3[1]=PKW(P1,10), pw3); \
    VRD(7); SBAR(); GAPA(C1=__builtin_amdgcn_mfma_f32_32x32x16_bf16(kf[7],qr[3],C1,0,0,0),   P1[14],P1[15],0.f,0.f,       pw3[2]=PKW(P1,12),pw3[3]=PKW(P1,14), pw3); \
    l_reg+=sacc; \
    if(GK){DMA_K((t)+3,sl_cur);} if(GV){DMA_V((t)+1,sl_next);} \
    CMASK(C0,C1,t); \
    if(!FIXREF){ float a=MX3(C0[0],C0[1],C1[0]),b=MX3(C0[2],C0[3],C1[1]); a=MX3(a,C1[2],C1[3]); \
      _Pragma("unroll") for(int r=4;r<16;r+=4){a=MX3(a,C0[r],C0[r+1]);b=MX3(b,C0[r+2],C0[r+3]);a=MX3(a,C1[r],C1[r+1]);b=MX3(b,C1[r+2],C1[r+3]);} \
      float rm=__builtin_fmaxf(a,b); { auto rr=__builtin_amdgcn_permlane32_swap(__float_as_uint(rm),__float_as_uint(rm),false,false); rm=__builtin_fmaxf(__uint_as_float(rr[0]),__uint_as_float(rr[1])); } \
      resc=false; \
      if(__builtin_expect(__any(rm>(float)THRL),0)){ const float dl=__builtin_fmaxf(rm,0.f); mhat+=dl; \
        _Pragma("unroll") for(int r=0;r<16;++r){C0[r]-=dl;C1[r]-=dl;} \
        _Pragma("unroll") for(int r=0;r<16;++r)negm[r]=-mhat; asm volatile("":"+v"(negm)); \
        const float f=__builtin_amdgcn_exp2f(-dl); l_reg*=f; if(hi==0)wsf[r32]=f; resc=true; } } \
    SBAR(); \
    GAPB(o[0]=__builtin_amdgcn_mfma_f32_32x32x16_bf16(PAF(0),VFR(0),o[0],0,0,0), C0,0); \
    GAPB(o[1]=__builtin_amdgcn_mfma_f32_32x32x16_bf16(PAF(0),VFR(4),o[1],0,0,0), C0,4); \
    KRD(GL,0); GAPB(o[0]=__builtin_amdgcn_mfma_f32_32x32x16_bf16(PAF(1),VFR(1),o[0],0,0,0), C0,8); \
    KRD(GL,1); GAPB(o[1]=__builtin_amdgcn_mfma_f32_32x32x16_bf16(PAF(1),VFR(5),o[1],0,0,0), C0,12); \
    KRD(GL,2); GAPB(o[0]=__builtin_amdgcn_mfma_f32_32x32x16_bf16(PAF(2),VFR(2),o[0],0,0,0), C1,0); \
    KRD(GL,3); GAPB(o[1]=__builtin_amdgcn_mfma_f32_32x32x16_bf16(PAF(2),VFR(6),o[1],0,0,0), C1,4); \
    GAPB(o[0]=__builtin_amdgcn_mfma_f32_32x32x16_bf16(PAF(3),VFR(3),o[0],0,0,0), C1,8); \
    GAPB(o[1]=__builtin_amdgcn_mfma_f32_32x32x16_bf16(PAF(3),VFR(7),o[1],0,0,0), C1,12); \
    }while(0)
  int t=1;
  #undef CMASK
  #define CMASK(P0,P1,t) do{}while(0)
  for(;t+5<NT;t+=2){
    STEP(pB0,pB1,pA0,pA1,t,true,true,true);     WAIT_BAR(2); RESC(); ROT();
    STEP(pA0,pA1,pB0,pB1,t+1,true,true,true);   WAIT_BAR(2); RESC(); ROT();
  }
  #undef CMASK
  #define CMASK(P0,P1,t) do{}while(0)
  #define ENDW(tt) do{ if((tt)+3<NT){WAIT_BAR(2);} else if((tt)+2<NT){WAIT_BAR(1);} else {WAIT_BAR(0);} }while(0)
  for(;t+1<NT;t+=2){
    STEP(pB0,pB1,pA0,pA1,t,(t+3<NT),(t+1<NT),(t+1<NT));       ENDW(t);   RESC(); ROT();
    STEP(pA0,pA1,pB0,pB1,t+1,(t+4<NT),(t+2<NT),(t+2<NT));     ENDW(t+1); RESC(); ROT();
  }
  STEP(pB0,pB1,pA0,pA1,NT-1,false,false,false); RESC();
  { float sacc=pB0[0]+pB0[1]; _Pragma("unroll") for(int r=2;r<16;++r)sacc+=pB0[r]; _Pragma("unroll") for(int r=0;r<16;++r)sacc+=pB1[r]; l_reg+=sacc;
    pw0=(u32x4){PKW(pB0,0),PKW(pB0,2),PKW(pB0,4),PKW(pB0,6)};pw1=(u32x4){PKW(pB0,8),PKW(pB0,10),PKW(pB0,12),PKW(pB0,14)};pw2=(u32x4){PKW(pB1,0),PKW(pB1,2),PKW(pB1,4),PKW(pB1,6)};pw3=(u32x4){PKW(pB1,8),PKW(pB1,10),PKW(pB1,12),PKW(pB1,14)};
    SBAR(); pv(o,vb0+sl_cur,PAF(0),PAF(1),PAF(2),PAF(3)); }
  #undef PKW
  #undef PAF
  #undef VFR
  #undef PIN
  #undef MX3
  #undef GAPA
  #undef GAPB
  #undef EX
  #undef VRD
  #undef KRD
  #undef STEP
  #undef ENDW
  {auto rr=__builtin_amdgcn_permlane32_swap(__float_as_uint(l_reg),__float_as_uint(l_reg),false,false);l_reg=__uint_as_float(rr[0])+__uint_as_float(rr[1]);}
  if(hi==0)wsf[32+r32]=l_reg;asm volatile("s_waitcnt lgkmcnt(0)":::"memory");
  float rli[16];
  #pragma unroll
  for(int r=0;r<16;++r)rli[r]=__builtin_amdgcn_rcpf(wsf[32+crow(r,hi)]);
  bf16*Ow=Ow0+(long)(wid*QBLK)*OP;
  { bf16*stg=(bf16*)(shm+LDS_OST)+wid*2048;
    #pragma unroll
    for(int r=0;r<16;++r){const int orow=crow(r,hi);
      #pragma unroll
      for(int d0=0;d0<2;++d0)stg[orow*64+d0*32+r32]=__float2bfloat16(o[d0][r]*rli[r]);}
    asm volatile("s_waitcnt lgkmcnt(0)":::"memory");
    #pragma unroll
    for(int i=0;i<4;++i){const int row=i*8+(lane>>3),ch=lane&7; const u32x4 v=*(const u32x4*)(stg+row*64+ch*8); ATTN_STORE16(Ow+(long)row*OP+ch*8,v);} }
  asm volatile("s_waitcnt lgkmcnt(0)\n\ts_barrier":::"memory");
  #undef DMA_K
  #undef DMA_V
  #undef CMASK
  #undef START
  #undef RESC
  #undef ROT
}
constexpr int ATTN_LDS_BYTES=LDS_BYTES;
#undef SBAR
#undef WAIT_BAR
}
#ifndef REP_SYNC
#define REP_SYNC 1
#endif
#ifndef REP_PRO
#define REP_PRO 1
#endif
#ifndef REP_S2
#define REP_S2 1
#endif
#ifndef REP_NORM
#define REP_NORM 1
#endif
#ifndef REP_G1
#define REP_G1 1
#endif
#ifndef REP_S1
#define REP_S1 1
#endif
#ifndef REP_S3
#define REP_S3 1
#endif
#ifndef REP_ATT
#define REP_ATT 1
#endif
#ifndef REP_POST0
#define REP_POST0 1
#endif
#define LAS __attribute__((address_space(3)))
typedef unsigned short u16;
typedef float f32x4 __attribute__((ext_vector_type(4)));
typedef float f32x2 __attribute__((ext_vector_type(2)));
typedef unsigned u32x4 __attribute__((ext_vector_type(4)));
typedef unsigned u32x2 __attribute__((ext_vector_type(2)));

constexpr int M_LAT = 32768, M_CTXR = 512, M_ALL = 33280, DM_ = 1024, NPAD = 2560, IN_W = 2336, FF_ = 4096;
constexpr int C_RQ = 0, C_RK = 128, C_RV = 256, C_RG = 512, C_GQ = 768, C_GK = 896, C_GV = 1024, C_GG = 1280, C_AQ = 1536, C_AK = 2048, C_AV = 2176, C_Z = 2304;
constexpr int SRC_GA = 1536;
constexpr float NEPS = 1e-6f;
constexpr int N_ITEM1 = 8320;
constexpr int N_ITEM3 = 4160;
constexpr size_t MiB = 1u << 20, KiB = 1u << 10;
constexpr size_t WS_MOD = 0;
constexpr size_t WS_BAR = 256 * KiB, WS_BAR_BYTES = 16 * KiB;
constexpr size_t WS_TAB = 512 * KiB;
constexpr size_t WS_CTXRES = 1 * MiB;
constexpr size_t WS_DEC = 3 * MiB;
constexpr size_t WS_W = 5 * MiB, W_LAYER = 23 * MiB, W_IN = 0, W_OUT = 5 * MiB, W_1 = 7 * MiB, W_2 = 15 * MiB;
constexpr size_t WS_XNY = 51 * MiB;
constexpr size_t WS_P = 116 * MiB;
constexpr size_t WS_QB = WS_P + (size_t)M_ALL * NPAD * 2;
constexpr size_t WS_KB = WS_QB + (size_t)M_ALL * 512 * 2;
constexpr size_t WS_VB = WS_KB + (size_t)M_ALL * 128 * 2;
constexpr size_t WS_G = WS_VB + (size_t)M_ALL * 128 * 2;
constexpr size_t WS_AS = WS_G + (size_t)M_ALL * 256 * 4;
constexpr size_t WS_END1 = WS_AS + (size_t)N_ITEM1 * 2048 * 4;
constexpr size_t WS_H = WS_P;
constexpr size_t WS_END2 = WS_H + (size_t)M_ALL * FF_ * 2;
constexpr size_t WS_YA = 430 * MiB;
static_assert(WS_YA >= WS_END1 && WS_YA >= WS_END2 && WS_YA + (size_t)M_ALL * 1024 * 2 <= 512 * MiB, "YA");
static_assert(WS_END1 <= 512 * MiB && WS_END2 <= 512 * MiB, "d_ws map");
constexpr int LDS_BYTES = 147456;

__device__ __forceinline__ float bf2f(unsigned h) { return __uint_as_float(h << 16); }
__device__ __forceinline__ float bflo(unsigned w) { return __uint_as_float(w << 16); }
__device__ __forceinline__ float bfhi(unsigned w) { return __uint_as_float(w & 0xffff0000u); }
__device__ __forceinline__ unsigned pk2(float lo, float hi) { return pg8::cvt_pk_bf16(lo, hi); }
template <int X> __device__ __forceinline__ float xor_lane(float v) { static_assert(X >= 1 && X <= 16, "xor_lane"); return __int_as_float(__builtin_amdgcn_ds_swizzle(__float_as_int(v), (X << 10) | 0x1F)); }
__device__ __forceinline__ float sum_halves(float v) { auto rr = __builtin_amdgcn_permlane32_swap(__float_as_uint(v), __float_as_uint(v), false, false); return __uint_as_float(rr[0]) + __uint_as_float(rr[1]); }
__device__ __forceinline__ float other_half(float v) { auto rr = __builtin_amdgcn_permlane32_swap(__float_as_uint(v), __float_as_uint(v), false, false); return (rr[0] == __float_as_uint(v)) ? __uint_as_float(rr[1]) : __uint_as_float(rr[0]); }
__device__ __forceinline__ float wave_sum(float v) {
    v += xor_lane<1>(v); v += xor_lane<2>(v); v += xor_lane<4>(v); v += xor_lane<8>(v); v += xor_lane<16>(v);
    return sum_halves(v);
}
__device__ __forceinline__ float logsig(float z) { return fminf(z, 0.f) - __logf(1.f + __expf(-fabsf(z))); }
#define LDS_WAIT() asm volatile("s_waitcnt lgkmcnt(0)" ::: "memory")

__device__ __forceinline__ void p0_transpose_item(const float* W, int K, int N, u16* WT, LAS float* scr, int item, int lane, int row_off = 0) {
    const int nblk = N / 32, kb = item / nblk, nb = item % nblk, k0 = 64 * kb, n0 = 32 * nb;
#pragma unroll 8
    for (int i = 0; i < 32; ++i) { const int kk = 2 * i + (lane >> 5); scr[kk * 33 + (lane & 31)] = W[(size_t)(k0 + kk) * N + n0 + (lane & 31)]; }
    LDS_WAIT(); asm volatile("" ::: "memory");
    const int c = lane & 7;
#pragma unroll
    for (int j = 0; j < 4; ++j) { const int n = (lane >> 3) + 8 * j; const LAS float* s = scr + (8 * c) * 33 + n;
        u32x4 o; o.x = pk2(s[0 * 33], s[1 * 33]); o.y = pk2(s[2 * 33], s[3 * 33]); o.z = pk2(s[4 * 33], s[5 * 33]); o.w = pk2(s[6 * 33], s[7 * 33]);
        *(u32x4*)(WT + (size_t)(n0 + n + row_off) * K + k0 + 8 * c) = o; }
    LDS_WAIT(); asm volatile("" ::: "memory");
}

#define XB_TMO      128
#define XB_XCNT(j)  (256  + 64 * (j))
#define XB_XSUB(j)  (1280 + 64 * (j))
#define XB_XGEN(j)  (2304 + 64 * (j))
#define XB_TOP      3328
#define XB_TOPGEN   3392
#define XCD_BAR_WORDS 3456
#define XB_SPIN_CAP (1u << 18)

__device__ __forceinline__ unsigned xb_ld(unsigned* p)              { return __hip_atomic_load(p, __ATOMIC_RELAXED, __HIP_MEMORY_SCOPE_AGENT); }
__device__ __forceinline__ unsigned xb_add(unsigned* p, unsigned v) { return __hip_atomic_fetch_add(p, v, __ATOMIC_RELAXED, __HIP_MEMORY_SCOPE_AGENT); }
__device__ __forceinline__ unsigned xb_xcc_id() { return (unsigned)__builtin_amdgcn_s_getreg((3 << 11) | 20) & 0xFu; }
#define XB_SPIN(cond, bar) do { unsigned _sp = 0; while (cond) { __builtin_amdgcn_s_sleep(1); \
    if ((++_sp & 255u) == 0u) { if (xb_ld(&(bar)[XB_TMO])) break; if (_sp > XB_SPIN_CAP) { atomicAdd(&(bar)[XB_TMO], 1u); break; } } } } while (0)

struct XcdBarrier {
    unsigned* bar; unsigned x;
    volatile LAS unsigned* st;
};

__device__ __forceinline__ XcdBarrier xcd_barrier_post(unsigned* bar, volatile LAS unsigned* st) {
    XcdBarrier b; b.bar = bar; b.x = xb_xcc_id(); b.st = st;
    if (threadIdx.x == 0) (void)xb_add(&bar[XB_XCNT(b.x)], 1u);
    return b;
}
__device__ __forceinline__ void xcd_barrier_complete(unsigned* bar, unsigned x, unsigned& nloc, unsigned& nx) {
    const unsigned G = gridDim.x * gridDim.y * gridDim.z;
    unsigned sum, cnt, mine, sp = 0u;
    for (;;) {
        sum = 0u; cnt = 0u; mine = 0u;
#pragma unroll
        for (unsigned j = 0; j < 16; ++j) { const unsigned c = xb_ld(&bar[XB_XCNT(j)]); sum += c; cnt += (c > 0u) ? 1u : 0u; mine = (j == x) ? c : mine; }
        if (sum == G) break;
        __builtin_amdgcn_s_sleep(1);
        if ((++sp & 255u) == 0u) { if (xb_ld(&bar[XB_TMO])) break; if (sp > XB_SPIN_CAP) { atomicAdd(&bar[XB_TMO], 1u); break; } }
    }
    nloc = mine > 0u ? mine : 1u; nx = cnt > 0u ? cnt : 1u;
}

__device__ __forceinline__ void xcd_barrier(const XcdBarrier& b) {
    asm volatile("s_waitcnt vmcnt(0)" ::: "memory");
    __syncthreads();
    if (threadIdx.x == 0) {
        unsigned* bar = b.bar;
        __builtin_amdgcn_s_waitcnt(0);
        unsigned nloc = b.st[0], nx = b.st[1];
        if (nloc == 0u) { xcd_barrier_complete(bar, b.x, nloc, nx); b.st[0] = nloc; b.st[1] = nx; }
        const unsigned old = xb_add(&bar[XB_XSUB(b.x)], 1u);
        const unsigned gen = old / nloc;
        if (old + 1u == (gen + 1u) * nloc) {
            __builtin_amdgcn_fence(__ATOMIC_RELEASE, "agent");
            asm volatile("s_waitcnt vmcnt(0)" ::: "memory");
            const unsigned og = xb_add(&bar[XB_TOP], 1u);
            const unsigned tg = og / nx;
            if (og + 1u == (tg + 1u) * nx) xb_add(&bar[XB_TOPGEN], 1u);
            else XB_SPIN(xb_ld(&bar[XB_TOPGEN]) == tg, bar);
            __builtin_amdgcn_fence(__ATOMIC_ACQUIRE, "agent");
            xb_add(&bar[XB_XGEN(b.x)], 1u);
            asm volatile("s_waitcnt vmcnt(0)" ::: "memory");
        } else {
            XB_SPIN(xb_ld(&bar[XB_XGEN(b.x)]) == gen, bar);
            __builtin_amdgcn_fence(__ATOMIC_ACQUIRE, "agent");
            asm volatile("s_waitcnt vmcnt(0)" ::: "memory");
        }
    }
    __syncthreads();
}


typedef short mbf16x8 __attribute__((ext_vector_type(8)));
template <int MODE> __device__ __forceinline__ void mini_gemm_ctx(const u16* A, const u16* Bt, int N, int K, u16* Ob, int ldo, int act, const float* gate, LAS unsigned char* L, int vb, int G_, int wave, int lane) {
    const int ncg = (N + 63) >> 6, ntiles = 8 * ncg, kslice = K >> 3;
    const int fr = lane & 15, fq = lane >> 4;
    LAS f32x4* red = (LAS f32x4*)L;
    for (int tile = vb; tile < ntiles; tile += G_) {
        const int r0 = (tile & 7) * 64, n0 = (tile >> 3) * 64;
        f32x4 acc[4][4];
#pragma unroll
        for (int a = 0; a < 4; ++a)
#pragma unroll
            for (int c = 0; c < 4; ++c) acc[a][c] = (f32x4){0.f, 0.f, 0.f, 0.f};
        const u16* ap = A + (size_t)(r0 + fr) * K + wave * kslice + 8 * fq; const u16* bp = Bt + (size_t)(n0 + fr) * K + wave * kslice + 8 * fq;
#pragma unroll 1
        for (int kc = 0; kc < kslice; kc += 64) {
            mbf16x8 fa[4][2], fb[4][2];
#pragma unroll
            for (int s = 0; s < 2; ++s)
#pragma unroll
                for (int q = 0; q < 4; ++q) { fa[q][s] = *(const mbf16x8*)(ap + (size_t)(16 * q) * K + kc + 32 * s); fb[q][s] = *(const mbf16x8*)(bp + (size_t)(16 * q) * K + kc + 32 * s); }
#pragma unroll
            for (int s = 0; s < 2; ++s)
#pragma unroll
                for (int mi = 0; mi < 4; ++mi)
#pragma unroll
                    for (int ni = 0; ni < 4; ++ni) acc[mi][ni] = __builtin_amdgcn_mfma_f32_16x16x32_bf16(fa[mi][s], fb[ni][s], acc[mi][ni], 0, 0, 0);
        }
#pragma unroll
        for (int ti = 0; ti < 16; ++ti) red[(wave * 16 + ti) * 64 + lane] = acc[ti >> 2][ti & 3];
        __syncthreads();
#pragma unroll
        for (int q = 0; q < 2; ++q) { const int ti = 2 * wave + q, mi = ti >> 2, ni = ti & 3;
            f32x4 s = red[ti * 64 + lane];
#pragma unroll
            for (int w = 1; w < 8; ++w) s += red[(w * 16 + ti) * 64 + lane];
            const int c = n0 + 16 * ni + fr;
            if (c < N) {
                const float gv = (MODE == 1) ? gate[c] : 1.f;
#pragma unroll
                for (int i = 0; i < 4; ++i) { const int r = r0 + 16 * mi + 4 * fq + i; float v = s[i] * gv;
                    if (act) { v = fmaxf(v, 0.f); v = v * v; } Ob[(size_t)r * ldo + c] = (u16)(pk2(v, 0.f) & 0xffffu); }
            }
        }
        __syncthreads();
    }
}

struct Args { const float* in[17]; float* out; unsigned char* ws; };

__global__ void __launch_bounds__(512, 2) fwd_megakernel(Args args) {
    extern __shared__ __attribute__((aligned(16))) unsigned char lds[];
    cg::grid_group grid = cg::this_grid();
    LAS unsigned char* L = (LAS unsigned char*)lds;
    const int G_ = gridDim.x, bx = blockIdx.x, NGW = G_ * 8;
#define PHASE_IDS int tid_l = threadIdx.x; asm volatile("" : "+v"(tid_l)); const int tid = tid_l, lane = tid & 63, wave = __builtin_amdgcn_readfirstlane(tid >> 6), gw = bx * 8 + wave; (void)gw; (void)lane;
    const int vcu = (G_ % 8 == 0) ? (bx % 8) * (G_ / 8) + bx / 8 : bx;
#define PHASE_PTRS \
    const __attribute__((address_space(4))) Args* ka_ = (const __attribute__((address_space(4))) Args*)__builtin_amdgcn_kernarg_segment_ptr(); asm volatile("" : "+s"(ka_)); \
    unsigned char* ws = ka_->ws; \
    const float* in_x = ka_->in[0]; const float* in_c = ka_->in[1]; const float* in_ctx = ka_->in[2]; const float* in_cctx = ka_->in[3]; \
    const float* in_modw = ka_->in[4]; const float* in_modb = ka_->in[5]; const float* in_ang = ka_->in[6]; const float* in_mng = ka_->in[7]; \
    const float* in_win = ka_->in[8]; const float* in_wout = ka_->in[9]; const float* in_retl = ka_->in[10]; const float* in_ggw = ka_->in[11]; \
    const float* in_ggb = ka_->in[12]; const float* in_qkg = ka_->in[13]; const float* in_w1 = ka_->in[14]; const float* in_w2 = ka_->in[15]; const float* in_fng = ka_->in[16]; \
    float* xlat = ka_->out; float* xctx = (float*)(ws + WS_CTXRES); \
    float* MOD = (float*)(ws + WS_MOD); float* DEC = (float*)(ws + WS_DEC); \
    u16* XNY = (u16*)(ws + WS_XNY); u16* P = (u16*)(ws + WS_P); u16* QB = (u16*)(ws + WS_QB); u16* KB = (u16*)(ws + WS_KB); u16* VB = (u16*)(ws + WS_VB); \
    float* GT = (float*)(ws + WS_G); float* AS = (float*)(ws + WS_AS); u16* HB = (u16*)(ws + WS_H); \
    (void)in_x; (void)in_c; (void)in_ctx; (void)in_cctx; (void)in_modw; (void)in_modb; (void)in_ang; (void)in_mng; (void)in_win; (void)in_wout; (void)in_retl; (void)in_ggw; (void)in_ggb; (void)in_qkg; (void)in_w1; (void)in_w2; (void)in_fng; \
    (void)xlat; (void)xctx; (void)MOD; (void)DEC; (void)XNY; (void)P; (void)QB; (void)KB; (void)VB; (void)GT; (void)AS; (void)HB;
    volatile LAS unsigned* MISC = (volatile LAS unsigned*)(L + LDS_BYTES - 256);
    if (threadIdx.x < 16) MISC[threadIdx.x] = 0u;
    __syncthreads();
    XcdBarrier bar = xcd_barrier_post((unsigned*)(args.ws + WS_BAR), MISC + 8);
    for (int rep_ = 0; rep_ < REP_PRO; ++rep_) {
    PHASE_IDS
    PHASE_PTRS
    if (bx < 192) {
        LAS float* sl = (LAS float*)L;
        for (int i = tid; i < 3072; i += 512) { const int cond = i >> 10, k = i & 1023; const float cv = cond < 2 ? in_c[cond * 1024 + k] : in_cctx[k]; sl[i] = cv / (1.f + expf(-cv)); }
        __syncthreads();
        const int layer = bx / 96, cn = tid & 63, col = (bx % 96) * 64 + cn, kg = tid >> 6;
        const float* wp = in_modw + (size_t)layer * 1024 * 6144 + (size_t)(kg * 128) * 6144 + col;
        float a0 = 0.f, a1 = 0.f, a2 = 0.f;
#pragma unroll 16
        for (int q = 0; q < 128; ++q) { const float w = wp[(size_t)q * 6144]; const int k = kg * 128 + q; a0 += sl[k] * w; a1 += sl[1024 + k] * w; a2 += sl[2048 + k] * w; }
        LAS float* red = sl + 3072;
        red[(kg * 3 + 0) * 64 + cn] = a0; red[(kg * 3 + 1) * 64 + cn] = a1; red[(kg * 3 + 2) * 64 + cn] = a2;
        __syncthreads();
        if (tid < 192) { const int cond = tid >> 6, c2 = tid & 63; float s = 0.f;
#pragma unroll
            for (int g = 0; g < 8; ++g) s += red[(g * 3 + cond) * 64 + c2];
            const int cc = (bx % 96) * 64 + c2; MOD[(size_t)(layer * 3 + cond) * 6144 + cc] = s + in_modb[layer * 6144 + cc]; }
        __syncthreads();
    }
    for (int i = bx * 512 + tid; i < 4096; i += G_ * 512) {
        const int pos = i >> 4, j = i & 15; const float invf = exp2f(-(float)j * 0.8304820237218406f); float sn, cs; sincosf((float)pos * invf, &sn, &cs);
        ((f32x2*)(ws + WS_TAB))[i] = (f32x2){cs, sn}; }
    {
        LAS float* scr = (LAS float*)(L + wave * 16384);
        for (int it = gw; it < 11552; it += NGW) {
            const int l = it / 5776; int r = it % 5776; unsigned char* wl = ws + WS_W + (size_t)l * W_LAYER;
            if (r < 1168) { const int nb = r % 73; if (nb != 48) p0_transpose_item(in_win + (size_t)l * 1024 * IN_W, 1024, IN_W, (u16*)(wl + W_IN), scr, r, lane, nb > 48 ? -32 : 0); continue; } r -= 1168;
            if (r < 512) { p0_transpose_item(in_wout + (size_t)l * 1024 * 1024, 1024, 1024, (u16*)(wl + W_OUT), scr, r, lane); continue; } r -= 512;
            if (r < 2048) { p0_transpose_item(in_w1 + (size_t)l * 1024 * 4096, 1024, 4096, (u16*)(wl + W_1), scr, r, lane); continue; } r -= 2048;
            p0_transpose_item(in_w2 + (size_t)l * 4096 * 1024, 4096, 1024, (u16*)(wl + W_2), scr, r, lane);
        }
        for (int idx = bx * 512 + tid; idx < 2 * 256 * 128; idx += G_ * 512) {
            const int l = idx >> 15, rem = idx & 32767, n = rem >> 7, k0 = (rem & 127) * 8, dirn = n >> 7, np = n & 127;
            const float* gwp = in_ggw + (size_t)l * 4096 + dirn * 2048 + np; const float* wp = in_win + (size_t)l * 1024 * IN_W + (size_t)k0 * IN_W + SRC_GA + dirn * 16;
            float o[8];
#pragma unroll
            for (int q = 0; q < 8; ++q) { float s = 0.f;
#pragma unroll
                for (int i = 0; i < 16; ++i) s += wp[(size_t)q * IN_W + i] * gwp[i * 128];
                o[q] = s; }
            u32x4 w; w.x = pk2(o[0], o[1]); w.y = pk2(o[2], o[3]); w.z = pk2(o[4], o[5]); w.w = pk2(o[6], o[7]);
            *(u32x4*)((u16*)(ws + WS_W + (size_t)l * W_LAYER + W_IN) + (size_t)(C_Z + n) * 1024 + k0) = w; }
    }
    __syncthreads();
    }
    if (args.ws == nullptr) grid.sync();
    xcd_barrier(bar);

    for (int step = 0; step < 20; ++step) {
        const int layer = step / 10, ph = step % 10;
        PHASE_IDS
        PHASE_PTRS
        unsigned char* wl = ws + WS_W + (size_t)layer * W_LAYER;
        const float* modl = MOD + (size_t)layer * 3 * 6144;
        if (ph == 0 || ph == 7) {
            for (int rep_ = 0; rep_ < REP_NORM; ++rep_) {

            const bool from_in = (layer == 0) || (ph == 0);
            const float* sl_ = from_in ? in_x : xlat; const float* sc_ = from_in ? in_ctx : xctx;
            const u16* ya = (layer == 0 && ph == 0) ? nullptr : (const u16*)(ws + WS_YA);
            const u16* yb = (layer == 1 && ph == 0) ? XNY : nullptr;
            const bool wx = (layer == 1 && ph == 0);
            const float* gvec = (ph == 0 ? in_ang : in_mng) + layer * 1024;
            const int sh_off = (ph == 0) ? 0 : 3072, sc_off = sh_off + 1024;
            const int Mn = (layer == 1 && ph == 7) ? M_LAT : M_ALL;
            for (int m = gw; m < Mn; m += NGW) {
                const float* src = (m < M_LAT) ? sl_ + (size_t)m * 1024 : sc_ + (size_t)(m - M_LAT) * 1024;
                const int cond = (m < M_LAT) ? (m >> 14) : 2;
                f32x4 v[4]; float ss = 0.f;
#pragma unroll
                for (int j = 0; j < 4; ++j) v[j] = *(const f32x4*)(src + 4 * lane + 256 * j);
                if (ya) {
#pragma unroll
                    for (int j = 0; j < 4; ++j) { const u32x2 y = *(const u32x2*)(ya + (size_t)m * 1024 + 4 * lane + 256 * j); v[j] = v[j] + (f32x4){bflo(y.x), bfhi(y.x), bflo(y.y), bfhi(y.y)}; } }
                if (yb) {
#pragma unroll
                    for (int j = 0; j < 4; ++j) { const u32x2 y = *(const u32x2*)(yb + (size_t)m * 1024 + 4 * lane + 256 * j); v[j] = v[j] + (f32x4){bflo(y.x), bfhi(y.x), bflo(y.y), bfhi(y.y)}; } }
#pragma unroll
                for (int j = 0; j < 4; ++j) ss += (v[j].x * v[j].x + v[j].y * v[j].y) + (v[j].z * v[j].z + v[j].w * v[j].w);
                if (wx) { float* dst = (m < M_LAT) ? xlat + (size_t)m * 1024 : xctx + (size_t)(m - M_LAT) * 1024;
#pragma unroll
                    for (int j = 0; j < 4; ++j) *(f32x4*)(dst + 4 * lane + 256 * j) = v[j]; }
                const float rstd = 1.0f / sqrtf(wave_sum(ss) * (1.f / 1024.f) + NEPS);
                const float* mc = modl + cond * 6144;
#pragma unroll
                for (int j = 0; j < 4; ++j) { const int col = 4 * lane + 256 * j;
                    const f32x4 gv = *(const f32x4*)(gvec + col), sc = *(const f32x4*)(mc + sc_off + col), sh = *(const f32x4*)(mc + sh_off + col);
                    const f32x4 hv = (v[j] * rstd) * gv * (sc + 1.0f) + sh;
                    u32x2 o; o.x = pk2(hv.x, hv.y); o.y = pk2(hv.z, hv.w); *(u32x2*)(XNY + (size_t)m * 1024 + col) = o; }
            }
            __syncthreads(); }
        } else if (ph == 1 || ph == 8 || ph == 6 || ph == 9) {
            for (int rep_ = 0; rep_ < REP_G1; ++rep_) {

            const u16* Aop = (ph == 9) ? HB : XNY; const int Kop = (ph == 9) ? FF_ : 1024;
            const u16* Bop = (const u16*)(wl + (ph == 1 ? W_IN : ph == 8 ? W_1 : ph == 6 ? W_OUT : W_2));
            const int Nmain = (ph == 1) ? NPAD : (ph == 8 ? FF_ : 1024), Nctx = Nmain;
            u16* Oop = (ph == 1) ? P : (ph == 8 ? HB : (ph == 6 ? (u16*)(ws + WS_YA) : XNY));
            const float* gate = (ph == 6) ? modl + 2048 : (ph == 9 ? modl + 5120 : (const float*)nullptr);
            if (ph == 1 || layer == 0) {
                if (gate) mini_gemm_ctx<1>(Aop + (size_t)M_LAT * Kop, Bop, Nctx, Kop, Oop + (size_t)M_LAT * Nmain, Nmain, 0, gate + 2 * 6144, L, vcu, G_, wave, lane);
                else mini_gemm_ctx<0>(Aop + (size_t)M_LAT * Kop, Bop, Nctx, Kop, Oop + (size_t)M_LAT * Nmain, Nmain, ph == 8 ? 1 : 0, nullptr, L, vcu, G_, wave, lane);
            }
            pg8::Gemm g{Aop, Bop, M_LAT, Nmain, Kop};
            pg8::StaticOrder S; S.init(g.M, g.N, G_, bx);
            pg8::EpiStoreBf16 E{Oop, Nmain, ph == 8 ? 1 : 0, gate};
            pg8::gemm_phase<pg8::EpiStoreBf16, pg8::StaticOrder, true, true>(L, g, S, E);
            __syncthreads(); }
        } else if (ph == 2) {
            LAS float* gw_s = (LAS float*)L; LAS float* gb_s = gw_s + 4096; LAS float* qg_s = gb_s + 256;
            if (tid < 256) gb_s[tid] = in_ggb[layer * 256 + tid];
            if (tid < 128) qg_s[tid] = in_qkg[layer * 128 + tid];
            __syncthreads();
            const float C2 = 0.125f * 1.4426950408889634f, KSC = 0.17677669529663687f;
            const f32x2* TAB = (const f32x2*)(ws + WS_TAB);
            const int r_head = lane >> 4, r_pi = lane & 15, r_j = r_pi & 7; const bool r_isrow = r_pi < 8; const int r_da = r_isrow ? r_j : 16 + r_j, r_db = r_da + 8;
            const int a_sub = lane & 7, a_hh = lane >> 3; const bool a_isrow = a_sub < 4; const int a_jb = a_isrow ? 4 * a_sub : 4 * a_sub - 16, a_da = a_isrow ? 4 * a_sub : 4 * a_sub + 16, a_db = a_da + 16;
            struct PostRaw { unsigned rq0, rq1, rk0, rk1; u32x2 gz; u32x2 aq0, aq1, ak0, ak1; u32x4 av; f32x2 t2; f32x4 t0, t1; };
#define POST_LOAD(R, mm) do { const u16* rp_ = P + (size_t)(mm) * NPAD; const int t_ = (mm) & 16383; const bool lat_ = (mm) < M_LAT; \
                R.rq0 = rp_[C_RQ + r_head * 32 + r_da]; R.rq1 = rp_[C_RQ + r_head * 32 + r_db]; R.rk0 = rp_[C_RK + r_head * 32 + r_da]; R.rk1 = rp_[C_RK + r_head * 32 + r_db]; \
                R.gz = *(const u32x2*)(rp_ + C_Z + 4 * lane); \
                R.aq0 = (u32x2){0u, 0u}; R.aq1 = (u32x2){0u, 0u}; \
                R.ak0 = *(const u32x2*)(rp_ + C_AK + (a_hh & 1) * 64 + a_da); R.ak1 = *(const u32x2*)(rp_ + C_AK + (a_hh & 1) * 64 + a_db); \
                R.av = *(const u32x4*)(rp_ + C_AV + (lane & 15) * 8); \
                R.t2 = (f32x2){1.f, 0.f}; R.t0 = (f32x4){1.f, 0.f, 1.f, 0.f}; R.t1 = (f32x4){1.f, 0.f, 1.f, 0.f}; \
                if (lat_) { R.t2 = TAB[(r_isrow ? (t_ >> 6) : (t_ & 63)) * 16 + 2 * r_j]; const f32x4* tp_ = (const f32x4*)(TAB + (a_isrow ? (t_ >> 6) : (t_ & 63)) * 16 + a_jb); R.t0 = tp_[0]; R.t1 = tp_[1]; } } while (0)
            PostRaw cur{};
            POST_LOAD(cur, gw);
            for (int m = gw; m < M_ALL; m += NGW) {
                PostRaw nxt = cur; const int mn = m + NGW;
                if (mn < M_ALL) POST_LOAD(nxt, mn);
                u16* rowp = P + (size_t)m * NPAD;
                const int kvb = m < M_LAT ? (m >> 14) : ((m - M_LAT) >> 8), kvt = m < M_LAT ? ((m & 16383) >> 6) : 256 + (((m - M_LAT) & 255) >> 6), kvr = m & 63;
                const size_t kvbase = ((size_t)(kvb * 2) * 260 + kvt) * 4096;
                {   const float cs = cur.t2.x, sn = cur.t2.y;
                    const float qa = bf2f(cur.rq0), qb_ = bf2f(cur.rq1), ka = bf2f(cur.rk0), kb_ = bf2f(cur.rk1);
                    const unsigned qo = pk2(qa * cs - qb_ * sn, qa * sn + qb_ * cs), ko = pk2((ka * cs - kb_ * sn) * KSC, (ka * sn + kb_ * cs) * KSC);
                    u16* qs = rowp + C_RQ + r_head * 32; u16* ks_ = rowp + C_RK + r_head * 32;
                    qs[r_da] = (u16)(qo & 0xffffu); qs[r_db] = (u16)(qo >> 16); ks_[r_da] = (u16)(ko & 0xffffu); ks_[r_db] = (u16)(ko >> 16);
                }
                {   const f32x4 bv = *(const LAS f32x4*)(gb_s + 4 * lane);
                    f32x4 g; g.x = logsig(bflo(cur.gz.x) + bv.x) * (1.f / 16.f); g.y = logsig(bfhi(cur.gz.x) + bv.y) * (1.f / 16.f); g.z = logsig(bflo(cur.gz.y) + bv.z) * (1.f / 16.f); g.w = logsig(bfhi(cur.gz.y) + bv.w) * (1.f / 16.f);
                    *(f32x4*)(GT + (size_t)m * 256 + 4 * lane) = g; }
                {   const float cs[4] = {cur.t0.x, cur.t0.z, cur.t1.x, cur.t1.z}, sn[4] = {cur.t0.y, cur.t0.w, cur.t1.y, cur.t1.w};
#pragma unroll
                    for (int pass = 1; pass < 2; ++pass) {
                        const int hd = pass == 0 ? a_hh : (a_hh & 1);
                        const u32x2 wa = pass == 0 ? cur.aq0 : cur.ak0, wb = pass == 0 ? cur.aq1 : cur.ak1;
                        float xa[4] = {bflo(wa.x), bfhi(wa.x), bflo(wa.y), bfhi(wa.y)}, xb[4] = {bflo(wb.x), bfhi(wb.x), bflo(wb.y), bfhi(wb.y)};
                        float ss = 0.f;
#pragma unroll
                        for (int e = 0; e < 4; ++e) ss += xa[e] * xa[e] + xb[e] * xb[e];
                        ss += xor_lane<1>(ss); ss += xor_lane<2>(ss); ss += xor_lane<4>(ss);
                        const float rstd = rsqrtf(ss * (1.f / 64.f) + NEPS); const float osc = pass == 0 ? C2 : 1.f;
                        float oa[4], ob[4];
#pragma unroll
                        for (int e = 0; e < 4; ++e) { const float ya = xa[e] * rstd * qg_s[pass * 64 + a_da + e], yb = xb[e] * rstd * qg_s[pass * 64 + a_db + e];
                            oa[e] = (ya * cs[e] - yb * sn[e]) * osc; ob[e] = (ya * sn[e] + yb * cs[e]) * osc; }
                        u32x2 pa, pb; pa.x = pk2(oa[0], oa[1]); pa.y = pk2(oa[2], oa[3]); pb.x = pk2(ob[0], ob[1]); pb.y = pk2(ob[2], ob[3]);
                        if (pass == 0) { u16* dp = QB + (size_t)m * 512 + hd * 64; *(u32x2*)(dp + a_da) = pa; *(u32x2*)(dp + a_db) = pb; }
                        else if (lane < 16) { u16* dp = KB + kvbase + (size_t)hd * (260 * 4096) + kvr * 8;
                            *(u32x2*)(dp + (a_da >> 3) * 512 + (a_da & 7)) = pa; *(u32x2*)(dp + (a_db >> 3) * 512 + (a_db & 7)) = pb; }
                    }
                    if (lane < 16) { const int cc = (lane & 7) * 8, vw_ = (cc >> 5) * 4 + (kvr >> 4), vl_ = (kvr & 15) * 4 + ((cc & 31) >> 3);
                        *(u32x4*)(VB + kvbase + (size_t)(lane >> 3) * (260 * 4096) + (vw_ * 64 + vl_) * 8) = cur.av; }
                }
                cur = nxt;
            }
#undef POST_LOAD
        } else if (ph == 3) {
            for (int rep_ = 0; rep_ < REP_S1; ++rep_) {

            LAS unsigned char* Lw = L + wave * 18048;
            LAS float* Bc = (LAS float*)Lw; LAS u16* KT = (LAS u16*)Lw;
            LAS u16* VT = (LAS u16*)(Lw + 8704); LAS float* tot = (LAS float*)(Lw + 8704 + 9216);
            const int nn = lane & 15, kk = lane >> 4;
            for (int item = gw; item < N_ITEM1; item += NGW) {
                const int cidx = item % 260, t = item / 260, h = t & 3, b = (t >> 2) & 1, dir = (t >> 3) & 1, grp = t >> 4;
                const int row0 = cidx < 4 ? M_LAT + b * 256 + cidx * 64 : b * 16384 + (cidx - 4) * 64;
                const u16* Pr = P + (size_t)(row0 + lane) * NPAD;
                const int kcol = (grp ? C_GK : C_RK) + h * 32, vcol = (grp ? C_GV : C_RV) + h * 64;
                u32x4 kr[4], vr[8];
                {   const u16* Pk = P + (size_t)(row0 + (lane >> 2)) * NPAD + kcol + 8 * (lane & 3);
#pragma unroll
                    for (int q = 0; q < 4; ++q) kr[q] = *(const u32x4*)(Pk + (size_t)(16 * q) * NPAD); }
                {   const u16* Pv = P + (size_t)(row0 + (lane >> 3)) * NPAD + vcol + 8 * (lane & 7);
#pragma unroll
                    for (int q = 0; q < 8; ++q) vr[q] = *(const u32x4*)(Pv + (size_t)(8 * q) * NPAD); }
                float lg = 0.f;
                if (grp == 0) lg = logsig(in_retl[layer * 8 + dir * 4 + h]);
                else {
                    const int d = lane & 31, half = lane >> 5; float* gp = GT + (size_t)row0 * 256 + dir * 128 + h * 32 + d; float run = 0.f;
                    float gv[32];
#pragma unroll
                    for (int i = 0; i < 32; ++i) gv[i] = gp[(size_t)(32 * half + i) * 256];
                    if (dir == 0) {
#pragma unroll
                        for (int i = 0; i < 32; ++i) { run += gv[i]; gv[i] = run; }
                    } else {
#pragma unroll
                        for (int i = 31; i >= 0; --i) { run += gv[i]; gv[i] = run; }
                    }
                    const float other = other_half(run);
                    const float addv = (dir == 0) ? (half == 1 ? other : 0.f) : (half == 0 ? other : 0.f);
#pragma unroll
                    for (int i = 0; i < 32; ++i) { const float full = gv[i] + addv; Bc[(32 * half + i) * 34 + d] = full; gp[(size_t)(32 * half + i) * 256] = full; }
                    if (half == 0) tot[d] = run + other;
                    LDS_WAIT(); asm volatile("" ::: "memory");
                }
                float fv[4][8];
                if (grp == 0) {
#pragma unroll
                    for (int q = 0; q < 4; ++q) { const int r = 16 * q + (lane >> 2); const float f = __expf((dir == 0 ? (float)(63 - r) : (float)r) * lg);
#pragma unroll
                        for (int e = 0; e < 8; ++e) fv[q][e] = f; }
                } else {
                    const f32x4 t0_ = *(const LAS f32x4*)(tot + 8 * (lane & 3)), t1_ = *(const LAS f32x4*)(tot + 8 * (lane & 3) + 4);
                    const float tt[8] = {t0_.x, t0_.y, t0_.z, t0_.w, t1_.x, t1_.y, t1_.z, t1_.w};
#pragma unroll
                    for (int q = 0; q < 4; ++q) { const LAS float* bp = Bc + (16 * q + (lane >> 2)) * 34 + 8 * (lane & 3);
#pragma unroll
                        for (int e = 0; e < 8; e += 2) { const f32x2 bc = *(const LAS f32x2*)(bp + e); fv[q][e] = __expf(tt[e] - bc.x); fv[q][e + 1] = __expf(tt[e + 1] - bc.y); } }
                    LDS_WAIT(); asm volatile("" ::: "memory");
                }
#pragma unroll
                for (int q = 0; q < 4; ++q) { const unsigned w[4] = {kr[q].x, kr[q].y, kr[q].z, kr[q].w}; u32x2 o0, o1;
                    o0.x = pk2(bflo(w[0]) * fv[q][0], bfhi(w[0]) * fv[q][1]); o0.y = pk2(bflo(w[1]) * fv[q][2], bfhi(w[1]) * fv[q][3]);
                    o1.x = pk2(bflo(w[2]) * fv[q][4], bfhi(w[2]) * fv[q][5]); o1.y = pk2(bflo(w[3]) * fv[q][6], bfhi(w[3]) * fv[q][7]);
                    LAS u32x2* wp = (LAS u32x2*)(KT + (16 * q + (lane >> 2)) * 36 + 8 * (lane & 3)); wp[0] = o0; wp[1] = o1; }
#pragma unroll
                for (int q = 0; q < 8; ++q) { LAS u32x2* wp = (LAS u32x2*)(VT + (8 * q + (lane >> 3)) * 68 + 8 * (lane & 7));
                    wp[0] = (u32x2){vr[q].x, vr[q].y}; wp[1] = (u32x2){vr[q].z, vr[q].w}; }
                LDS_WAIT(); asm volatile("" ::: "memory");
                f32x4 acc[4][2];
#pragma unroll
                for (int a = 0; a < 4; ++a) { acc[a][0] = (f32x4){0.f, 0.f, 0.f, 0.f}; acc[a][1] = (f32x4){0.f, 0.f, 0.f, 0.f}; }
#pragma unroll
                for (int ks = 0; ks < 2; ++ks) {
                    typedef short trk4_t __attribute__((ext_vector_type(4)));
                    const LAS u16* bp_ = KT + (32 * ks + 8 * kk + (nn >> 2)) * 36 + 4 * (nn & 3);
                    const trk4_t l0_ = __builtin_amdgcn_ds_read_tr16_b64_v4i16((LAS trk4_t*)bp_), h0_ = __builtin_amdgcn_ds_read_tr16_b64_v4i16((LAS trk4_t*)(bp_ + 4 * 36));
                    const trk4_t l1_ = __builtin_amdgcn_ds_read_tr16_b64_v4i16((LAS trk4_t*)(bp_ + 16)), h1_ = __builtin_amdgcn_ds_read_tr16_b64_v4i16((LAS trk4_t*)(bp_ + 16 + 4 * 36));
                    const mbf16x8 b0 = (mbf16x8){l0_[0], l0_[1], l0_[2], l0_[3], h0_[0], h0_[1], h0_[2], h0_[3]}, b1 = (mbf16x8){l1_[0], l1_[1], l1_[2], l1_[3], h1_[0], h1_[1], h1_[2], h1_[3]};
#pragma unroll
                    for (int mt = 0; mt < 4; ++mt) {
                        typedef short tr4_t __attribute__((ext_vector_type(4)));
                        const LAS u16* ap_ = VT + (32 * ks + 8 * kk + (nn >> 2)) * 68 + 16 * mt + 4 * (nn & 3);
                        const tr4_t lo_ = __builtin_amdgcn_ds_read_tr16_b64_v4i16((LAS tr4_t*)ap_), hi_ = __builtin_amdgcn_ds_read_tr16_b64_v4i16((LAS tr4_t*)(ap_ + 4 * 68));
                        const mbf16x8 a = (mbf16x8){lo_[0], lo_[1], lo_[2], lo_[3], hi_[0], hi_[1], hi_[2], hi_[3]};
                        acc[mt][0] = __builtin_amdgcn_mfma_f32_16x16x32_bf16(a, b0, acc[mt][0], 0, 0, 0); acc[mt][1] = __builtin_amdgcn_mfma_f32_16x16x32_bf16(a, b1, acc[mt][1], 0, 0, 0); }
                }
                float* o = AS + (size_t)item * 2048;
#pragma unroll
                for (int mt = 0; mt < 4; ++mt)
#pragma unroll
                    for (int nt = 0; nt < 2; ++nt)
#pragma unroll
                        for (int r = 0; r < 4; ++r) o[(16 * mt + 4 * kk + r) * 32 + 16 * nt + nn] = acc[mt][nt][r];
                if (lane < 32) DEC[(size_t)item * 32 + lane] = grp == 0 ? __expf(64.f * lg) : __expf(tot[lane]);
                LDS_WAIT(); asm volatile("" ::: "memory");
            }
            __syncthreads(); }
        } else if (ph == 4) {
            const int gt_ = bx * 512 + tid;
            for (int rep_ = 0; rep_ < REP_S2; ++rep_)
            if (gt_ < 32 * 2048) {
                const int seq = gt_ >> 11, elem = gt_ & 2047, d = elem & 31, dir = (seq >> 3) & 1;
                float* base = AS + (size_t)seq * 260 * 2048 + elem; const float* dbase = DEC + (size_t)seq * 260 * 32 + d;
                float S = 0.f;
                for (int n0 = 0; n0 < 260; n0 += 52) {
                    float a[52], dc[52];
#pragma unroll
                    for (int q = 0; q < 52; ++q) { const int n = n0 + q; const int ci = dir == 0 ? n : (n < 4 ? 3 - n : 263 - n); a[q] = base[(size_t)ci * 2048]; dc[q] = dbase[(size_t)ci * 32]; }
#pragma unroll
                    for (int q = 0; q < 52; ++q) { const int n = n0 + q; const int ci = dir == 0 ? n : (n < 4 ? 3 - n : 263 - n); (rep_ + 1 < REP_S2 ? base + 17039360 : base)[(size_t)ci * 2048] = S; S = dc[q] * S + a[q]; }
                }
            }
        } else if (ph == 5) {
            for (int rep_ = 0; rep_ < REP_S3; ++rep_) {
                const int slot = wave >> 2, w4 = wave & 3, t4 = tid & 255;
                LAS u16* KFs = (LAS u16*)(L + slot * 32768); LAS u16* KBs = KFs + 64 * 40; LAS u16* VT = KBs + 64 * 40; LAS u16* ST = VT + 64 * 72;
                const int nn = lane & 15, kk = lane >> 4;
                for (int pr = bx; pr < N_ITEM3 / 2; pr += G_) {
                    const int item = pr * 2 + slot;
                    const int cidx = item % 260, t = item / 260, h = t & 3, b = (t >> 2) & 1, grp = t >> 3;
                    const int row0 = cidx < 4 ? M_LAT + b * 256 + cidx * 64 : b * 16384 + (cidx - 4) * 64;
                    const u16* Pr = P + (size_t)row0 * NPAD;
                    const int qcol = (grp ? C_GQ : C_RQ) + h * 32, kcol = (grp ? C_GK : C_RK) + h * 32, vcol = (grp ? C_GV : C_RV) + h * 64, gcol = (grp ? C_GG : C_RG) + h * 64;
                    const size_t itF = (size_t)((((grp * 2 + 0) * 2 + b) * 4 + h) * 260 + cidx), itB = (size_t)((((grp * 2 + 1) * 2 + b) * 4 + h) * 260 + cidx);
                    const float lgf = logsig(in_retl[layer * 8 + h]), lgb = logsig(in_retl[layer * 8 + 4 + h]);
                    const int jr = t4 >> 2, d0 = (t4 & 3) * 8, iq = 16 * w4 + nn;
                    const u32x4 qw = *(const u32x4*)(Pr + (size_t)iq * NPAD + qcol + 8 * kk);
                    const u32x4 kw = *(const u32x4*)(Pr + (size_t)jr * NPAD + kcol + d0);
                    const u32x4 va = *(const u32x4*)(Pr + (size_t)jr * NPAD + vcol + (t4 & 3) * 16), vb = *(const u32x4*)(Pr + (size_t)jr * NPAD + vcol + (t4 & 3) * 16 + 8);
                    const f32x4 sf0 = *(const f32x4*)(AS + itF * 2048 + t4 * 8), sf1 = *(const f32x4*)(AS + itF * 2048 + t4 * 8 + 4);
                    const f32x4 sb0 = *(const f32x4*)(AS + itB * 2048 + t4 * 8), sb1 = *(const f32x4*)(AS + itB * 2048 + t4 * 8 + 4);
                    u16 graw[4][4];
#pragma unroll
                    for (int r = 0; r < 4; ++r)
#pragma unroll
                        for (int et = 0; et < 4; ++et) graw[r][et] = Pr[(size_t)(16 * w4 + 4 * kk + r) * NPAD + gcol + nn + 16 * et];
                    f32x4 bq[4], bk[4];
#pragma unroll
                    for (int s = 0; s < 4; ++s) { bq[s] = (f32x4){0.f, 0.f, 0.f, 0.f}; bk[s] = (f32x4){0.f, 0.f, 0.f, 0.f}; }
                    if (grp == 1) { const float* gq = GT + (size_t)(row0 + iq) * 256 + h * 32 + 8 * kk; const float* gk = GT + (size_t)(row0 + jr) * 256 + h * 32 + d0;
                        bq[0] = *(const f32x4*)gq; bq[1] = *(const f32x4*)(gq + 4); bq[2] = *(const f32x4*)(gq + 128); bq[3] = *(const f32x4*)(gq + 132);
                        bk[0] = *(const f32x4*)gk; bk[1] = *(const f32x4*)(gk + 4); bk[2] = *(const f32x4*)(gk + 128); bk[3] = *(const f32x4*)(gk + 132); }
                    else { const float ef = (float)(iq + 1) * lgf, eb = (float)(64 - iq) * lgb, kf = (float)(jr + 1) * lgf, kb = (float)(64 - jr) * lgb;
                        bq[0] = bq[1] = (f32x4){ef, ef, ef, ef}; bq[2] = bq[3] = (f32x4){eb, eb, eb, eb}; bk[0] = bk[1] = (f32x4){kf, kf, kf, kf}; bk[2] = bk[3] = (f32x4){kb, kb, kb, kb}; }
                    mbf16x8 qfr_f, qfr_b;
                    {   const float qs = grp ? 0.17677669529663687f : 1.f;
                        const float qx[8] = {bflo(qw.x) * qs, bfhi(qw.x) * qs, bflo(qw.y) * qs, bfhi(qw.y) * qs, bflo(qw.z) * qs, bfhi(qw.z) * qs, bflo(qw.w) * qs, bfhi(qw.w) * qs};
                        u32x4 pf, pb;
                        pf.x = pk2(qx[0] * __expf(bq[0].x), qx[1] * __expf(bq[0].y)); pf.y = pk2(qx[2] * __expf(bq[0].z), qx[3] * __expf(bq[0].w));
                        pf.z = pk2(qx[4] * __expf(bq[1].x), qx[5] * __expf(bq[1].y)); pf.w = pk2(qx[6] * __expf(bq[1].z), qx[7] * __expf(bq[1].w));
                        pb.x = pk2(qx[0] * __expf(bq[2].x), qx[1] * __expf(bq[2].y)); pb.y = pk2(qx[2] * __expf(bq[2].z), qx[3] * __expf(bq[2].w));
                        pb.z = pk2(qx[4] * __expf(bq[3].x), qx[5] * __expf(bq[3].y)); pb.w = pk2(qx[6] * __expf(bq[3].z), qx[7] * __expf(bq[3].w));
                        qfr_f = __builtin_bit_cast(mbf16x8, pf); qfr_b = __builtin_bit_cast(mbf16x8, pb); }
                    {   const float kx[8] = {bflo(kw.x), bfhi(kw.x), bflo(kw.y), bfhi(kw.y), bflo(kw.z), bfhi(kw.z), bflo(kw.w), bfhi(kw.w)};
                        u32x4 pf, pb;
                        pf.x = pk2(kx[0] * __expf(-bk[0].x), kx[1] * __expf(-bk[0].y)); pf.y = pk2(kx[2] * __expf(-bk[0].z), kx[3] * __expf(-bk[0].w));
                        pf.z = pk2(kx[4] * __expf(-bk[1].x), kx[5] * __expf(-bk[1].y)); pf.w = pk2(kx[6] * __expf(-bk[1].z), kx[7] * __expf(-bk[1].w));
                        pb.x = pk2(kx[0] * __expf(-bk[2].x), kx[1] * __expf(-bk[2].y)); pb.y = pk2(kx[2] * __expf(-bk[2].z), kx[3] * __expf(-bk[2].w));
                        pb.z = pk2(kx[4] * __expf(-bk[3].x), kx[5] * __expf(-bk[3].y)); pb.w = pk2(kx[6] * __expf(-bk[3].z), kx[7] * __expf(-bk[3].w));
                        *(LAS u32x4*)(KFs + jr * 40 + d0) = pf; *(LAS u32x4*)(KBs + jr * 40 + d0) = pb;
                        u32x4 s0, s1; s0.x = pk2(sf0.x, sf0.y); s0.y = pk2(sf0.z, sf0.w); s0.z = pk2(sf1.x, sf1.y); s0.w = pk2(sf1.z, sf1.w);
                        s1.x = pk2(sb0.x, sb0.y); s1.y = pk2(sb0.z, sb0.w); s1.z = pk2(sb1.x, sb1.y); s1.w = pk2(sb1.z, sb1.w);
                        *(LAS u32x4*)(ST + jr * 72 + d0) = s0; *(LAS u32x4*)(ST + jr * 72 + 32 + d0) = s1;
                        const int c0 = (t4 & 3) * 16; const unsigned vw[8] = {va.x, va.y, va.z, va.w, vb.x, vb.y, vb.z, vb.w};
#pragma unroll
                        for (int q = 0; q < 8; ++q) { VT[(c0 + 2 * q) * 72 + jr] = (u16)(vw[q] & 0xffffu); VT[(c0 + 2 * q + 1) * 72 + jr] = (u16)(vw[q] >> 16); } }
                    __syncthreads();
                    const f32x4 z4 = (f32x4){0.f, 0.f, 0.f, 0.f};
                    f32x4 sc[4];
#pragma unroll
                    for (int jt = 0; jt < 4; ++jt) {
                        const mbf16x8 kf_ = *(const LAS mbf16x8*)(KFs + (16 * jt + nn) * 40 + 8 * kk), kb_ = *(const LAS mbf16x8*)(KBs + (16 * jt + nn) * 40 + 8 * kk);
                        if (jt < w4) sc[jt] = __builtin_amdgcn_mfma_f32_16x16x32_bf16(kf_, qfr_f, z4, 0, 0, 0);
                        else if (jt > w4) sc[jt] = __builtin_amdgcn_mfma_f32_16x16x32_bf16(kb_, qfr_b, z4, 0, 0, 0);
                        else { const f32x4 a = __builtin_amdgcn_mfma_f32_16x16x32_bf16(kf_, qfr_f, z4, 0, 0, 0), c = __builtin_amdgcn_mfma_f32_16x16x32_bf16(kb_, qfr_b, z4, 0, 0, 0);
#pragma unroll
                            for (int r = 0; r < 4; ++r) sc[jt][r] = (4 * kk + r <= nn) ? a[r] : c[r]; }
                    }
                    f32x4 O[4];
#pragma unroll
                    for (int et = 0; et < 4; ++et) O[et] = z4;
#pragma unroll
                    for (int p2 = 0; p2 < 2; ++p2) {
                        u32x4 pa; pa.x = pk2(sc[2 * p2][0], sc[2 * p2][1]); pa.y = pk2(sc[2 * p2][2], sc[2 * p2][3]); pa.z = pk2(sc[2 * p2 + 1][0], sc[2 * p2 + 1][1]); pa.w = pk2(sc[2 * p2 + 1][2], sc[2 * p2 + 1][3]);
                        const mbf16x8 af = __builtin_bit_cast(mbf16x8, pa);
#pragma unroll
                        for (int et = 0; et < 4; ++et) { const LAS u16* vp = VT + (16 * et + nn) * 72 + 32 * p2 + 4 * kk;
                            const u32x2 lo = *(const LAS u32x2*)vp, hi = *(const LAS u32x2*)(vp + 16); u32x4 pbv; pbv.x = lo.x; pbv.y = lo.y; pbv.z = hi.x; pbv.w = hi.y;
                            O[et] = __builtin_amdgcn_mfma_f32_16x16x32_bf16(af, __builtin_bit_cast(mbf16x8, pbv), O[et], 0, 0, 0); }
                    }
#pragma unroll
                    for (int et = 0; et < 4; ++et) { const LAS u16* sp = ST + (16 * et + nn) * 72 + 8 * kk;
                        O[et] = __builtin_amdgcn_mfma_f32_16x16x32_bf16(qfr_f, *(const LAS mbf16x8*)sp, O[et], 0, 0, 0);
                        O[et] = __builtin_amdgcn_mfma_f32_16x16x32_bf16(qfr_b, *(const LAS mbf16x8*)(sp + 32), O[et], 0, 0, 0); }
#pragma unroll
                    for (int r = 0; r < 4; ++r) { const int i = 16 * w4 + 4 * kk + r;
                        float x0 = O[0][r], x1 = O[1][r], x2 = O[2][r], x3 = O[3][r];
                        if (grp == 0) { float sm = (x0 + x1) + (x2 + x3); sm += xor_lane<1>(sm); sm += xor_lane<2>(sm); sm += xor_lane<4>(sm); sm += xor_lane<8>(sm);
                            const float mean = sm * (1.f / 64.f); x0 -= mean; x1 -= mean; x2 -= mean; x3 -= mean; }
                        float sq = (x0 * x0 + x1 * x1) + (x2 * x2 + x3 * x3); sq += xor_lane<1>(sq); sq += xor_lane<2>(sq); sq += xor_lane<4>(sq); sq += xor_lane<8>(sq);
                        const float rs = rsqrtf(sq * (1.f / 64.f) + NEPS);
                        const float xs[4] = {x0 * rs, x1 * rs, x2 * rs, x3 * rs};
                        u16* yp = XNY + (size_t)(row0 + i) * 1024 + grp * 256 + h * 64 + nn;
#pragma unroll
                        for (int et = 0; et < 4; ++et) { const float gate = bf2f(graw[r][et]); const float sg = gate * __builtin_amdgcn_rcpf(1.f + __expf(-gate)); yp[16 * et] = (u16)(pk2(sg * xs[et], 0.f) & 0xffffu); } }
                    __syncthreads();
                }
            }
            if (__builtin_amdgcn_readfirstlane(threadIdx.x) >= 256) __builtin_amdgcn_s_setprio(1);
            for (int rep_ = 0; rep_ < REP_ATT; ++rep_) {
                const int per = (1024 + G_ - 1) / G_;
                float gq_ = fabsf(in_qkg[layer * 128 + lane]), gk_ = fabsf(in_qkg[layer * 128 + 64 + lane]);
                gq_ = fmaxf(gq_, xor_lane<1>(gq_)); gq_ = fmaxf(gq_, xor_lane<2>(gq_)); gq_ = fmaxf(gq_, xor_lane<4>(gq_)); gq_ = fmaxf(gq_, xor_lane<8>(gq_)); gq_ = fmaxf(gq_, xor_lane<16>(gq_)); gq_ = fmaxf(gq_, other_half(gq_));
                gk_ = fmaxf(gk_, xor_lane<1>(gk_)); gk_ = fmaxf(gk_, xor_lane<2>(gk_)); gk_ = fmaxf(gk_, xor_lane<4>(gk_)); gk_ = fmaxf(gk_, xor_lane<8>(gk_)); gk_ = fmaxf(gk_, xor_lane<16>(gk_)); gk_ = fmaxf(gk_, other_half(gk_));
                const bool fixref = __builtin_amdgcn_readfirstlane((8.f * 1.4426950408889634f * 1.05f) * gq_ * gk_ < 40.f ? 1 : 0) != 0;
                for (int i = 0; i <= per; ++i) {
                    const u16 *Qw0 = P, *Kl = KB, *Vl = VB; u16* Ow0 = XNY; int NT = 4, tq0 = 0; bool rope = false;
                    if (i < per) { const int U = vcu * per + i; if (U >= 1024) continue;
                        const int bkv = U >> 8, g = (U >> 6) & 3, qb = U & 63, b = bkv >> 1, kvh = bkv & 1, h = kvh * 4 + g; const size_t qrow0 = (size_t)b * 16384 + (size_t)qb * 256;
                        Qw0 = P + qrow0 * NPAD + C_AQ + h * 64; tq0 = (int)qrow0; rope = true; Kl = KB + (size_t)(b * 2 + kvh) * (260 * 4096); Vl = VB + (size_t)(b * 2 + kvh) * (260 * 4096);
                        Ow0 = XNY + qrow0 * 1024 + 512 + h * 64; NT = 260;
                    } else { if (layer != 0 || vcu >= 16) break;
                        const int b = vcu >> 3, h = vcu & 7, kvh = h >> 2; const size_t qrow0 = (size_t)(M_LAT + b * 256);
                        Qw0 = P + qrow0 * NPAD + C_AQ + h * 64; tq0 = 0; rope = false; Kl = KB + ((size_t)(b * 2 + kvh) * 260 + 256) * 4096; Vl = VB + ((size_t)(b * 2 + kvh) * 260 + 256) * 4096;
                        Ow0 = XNY + qrow0 * 1024 + 512 + h * 64; NT = 4; }
                    const float* gqp = in_qkg + layer * 128; const float* tabp = rope ? (const float*)(ws + WS_TAB) : (const float*)nullptr;
                    if (fixref) attn_body::attn_unit<8, true>(gqp, tabp, tq0, (const attn_body::bf16*)Qw0, (const attn_body::bf16*)Kl, (const attn_body::bf16*)Vl, NT, (attn_body::bf16*)Ow0, (char*)lds);
                    else attn_body::attn_unit<8, false>(gqp, tabp, tq0, (const attn_body::bf16*)Qw0, (const attn_body::bf16*)Kl, (const attn_body::bf16*)Vl, NT, (attn_body::bf16*)Ow0, (char*)lds);
                }
            }
            __builtin_amdgcn_s_setprio(0);
        }
        for (int rep_ = 0; rep_ < REP_SYNC; ++rep_) xcd_barrier(bar);
    }
    PHASE_IDS
    PHASE_PTRS
    for (int m = gw; m < M_LAT; m += NGW) {
        float* src = xlat + (size_t)m * 1024; f32x4 v[4]; float ss = 0.f;
        const u16* ya = (const u16*)(ws + WS_YA) + (size_t)m * 1024; const u16* yb = XNY + (size_t)m * 1024;
#pragma unroll
        for (int j = 0; j < 4; ++j) { v[j] = *(const f32x4*)(src + 4 * lane + 256 * j);
            const u32x2 y = *(const u32x2*)(ya + 4 * lane + 256 * j), z = *(const u32x2*)(yb + 4 * lane + 256 * j);
            v[j] = v[j] + (f32x4){bflo(y.x), bfhi(y.x), bflo(y.y), bfhi(y.y)} + (f32x4){bflo(z.x), bfhi(z.x), bflo(z.y), bfhi(z.y)};
            ss += (v[j].x * v[j].x + v[j].y * v[j].y) + (v[j].z * v[j].z + v[j].w * v[j].w); }
        const float rstd = 1.0f / sqrtf(wave_sum(ss) * (1.f / 1024.f) + NEPS);
#pragma unroll
        for (int j = 0; j < 4; ++j) { const f32x4 gv = *(const f32x4*)(in_fng + 4 * lane + 256 * j); *(f32x4*)(src + 4 * lane + 256 * j) = (v[j] * rstd) * gv; }
    }
}

extern "C" void kernel_launch(void* const* d_in, const int* in_sizes, int n_in, void* d_out, int out_size, void* d_ws, size_t ws_size, hipStream_t stream) {
    static int grid_blocks = 0;
    if (grid_blocks == 0) {
        if (n_in != 17 || ws_size < 512 * MiB) { fprintf(stderr, "kernel_launch: unexpected n_in %d / ws %zu\n", n_in, ws_size); grid_blocks = -1; return; }
        int dev = 0, cus = 0, per_cu = 0;
        hipGetDevice(&dev); hipDeviceGetAttribute(&cus, hipDeviceAttributeMultiprocessorCount, dev);
        if (hipFuncSetAttribute((const void*)fwd_megakernel, hipFuncAttributeMaxDynamicSharedMemorySize, LDS_BYTES) != hipSuccess) { fprintf(stderr, "kernel_launch: hipFuncSetAttribute failed\n"); }
        if (hipOccupancyMaxActiveBlocksPerMultiprocessor(&per_cu, (const void*)fwd_megakernel, 512, LDS_BYTES) != hipSuccess || per_cu < 1) { fprintf(stderr, "kernel_launch: occupancy query gave %d\n", per_cu); per_cu = 1; }
        (void)hipGetLastError();
        if (per_cu > 1) per_cu = 1;
        grid_blocks = cus * per_cu;
    }
    if (grid_blocks < 0) return;
    Args a{};
    for (int i = 0; i < 17; ++i) a.in[i] = (const float*)d_in[i];
    a.out = (float*)d_out; a.ws = (unsigned char*)d_ws;
    if (hipMemsetAsync((char*)d_ws + WS_BAR, 0, WS_BAR_BYTES, stream) != hipSuccess) { fprintf(stderr, "kernel_launch: memset failed\n"); return; }
    void* kargs[] = {&a};
    hipError_t e = hipLaunchCooperativeKernel((const void*)fwd_megakernel, dim3(grid_blocks), dim3(512), kargs, LDS_BYTES, stream);
    if (e != hipSuccess) fprintf(stderr, "cooperative launch failed: %s (grid %d)\n", hipGetErrorString(e), grid_blocks);
}
```

```cpp
#include <hip/hip_runtime.h>
#include <hip/hip_cooperative_groups.h>
#include <cstdio>
#include <cstdint>
namespace cg = cooperative_groups;
namespace pg8 {
#define PG8_LAS __attribute__((address_space(3)))
typedef unsigned short bf16_t;
typedef short bf16x8 __attribute__((ext_vector_type(8)));
typedef float f32x4 __attribute__((ext_vector_type(4)));
typedef unsigned u32x4 __attribute__((ext_vector_type(4)));
constexpr int BM = 256, BK = 64, HALF = 128, HTB = HALF * BK * 2  , STAGE_BYTES = 8 * HTB, NXCD = 8, WGM = 8;

__host__ __device__ __forceinline__ int lds_byte(int r, int c) { const int st = (r >> 4) * 2 + (c >> 5), rr = r & 15, cc = c & 31, ob = rr * 64 + cc * 2; return st * 1024 + (ob ^ (((ob >> 9) & 1) << 5)); }
__host__ __device__ __forceinline__ void stage_rc(int b, int& R, int& C) { const int st = b / 1024, sb = b % 1024, swz = sb ^ (((sb >> 9) & 1) << 5); R = (st >> 1) * 16 + swz / 64; C = (st & 1) * 32 + (swz % 64) / 2; }
__host__ __device__ __forceinline__ int perm32(int rho) { const int n = rho >> 4, i = rho & 15; return 8 * (i >> 2) + 4 * n + (i & 3); }

struct Unit { int pm, pn; };
struct Gemm { const bf16_t* A; const bf16_t* Bt; int M, N, K; };

struct StaticOrder {
    int nM, nN, nwg, G, c;
    __host__ __device__ void init(int M, int N, int G_, int c_) { nM = M / BM; nN = N / BM; nwg = nM * nN; G = G_; c = c_; }
    __host__ __device__ bool next(int i, Unit& u) const {
        const long L = (long)i * G + c; if (L >= nwg) return false;
        int wgid = (int)L; { const int q = nwg / NXCD, r = nwg % NXCD, xcd = wgid % NXCD, off = wgid / NXCD; wgid = (xcd < r ? xcd * (q + 1) : r * (q + 1) + (xcd - r) * q) + off; }
        const int nig = WGM * nN, gid = wgid / nig, fm = gid * WGM, gsz = (nM - fm) < WGM ? (nM - fm) : WGM;
        u.pm = fm + ((wgid % nig) % gsz); u.pn = (wgid % nig) / gsz; return true;
    }
    __device__ __forceinline__ void a_ready(const Unit&) const {}
    __device__ __forceinline__ void done(const Unit&) const {}
};

__device__ __forceinline__ unsigned cvt_pk_bf16(float lo, float hi) { unsigned r; asm volatile("v_cvt_pk_bf16_f32 %0, %1, %2" : "=v"(r) : "v"(lo), "v"(hi)); return r; }
typedef float f32x2 __attribute__((ext_vector_type(2)));
struct EpiStoreBf16 {
    static constexpr bool PERM = true, AFTER_DRAIN = false;
    bf16_t* O; int ldc; int act; const float* gate;
    __device__ __forceinline__ void operator()(const f32x4 (&acc)[2][2][4][2], const Unit& u, int wr, int wc, int fr, int fq) const {
        const int row0 = u.pm * BM + wr * 64 + fr; const int col0 = u.pn * BM + wc * 32 + 8 * fq;
        f32x4 gv[2][2];
        if (gate) { const float* g = gate + (u.pm >> 6) * 6144 + col0;
#pragma unroll
            for (int bj = 0; bj < 2; ++bj) { gv[bj][0] = *(const f32x4*)(g + bj * HALF); gv[bj][1] = *(const f32x4*)(g + bj * HALF + 4); } }
#pragma unroll
        for (int ai = 0; ai < 2; ++ai)
#pragma unroll
            for (int m = 0; m < 4; ++m) { bf16_t* rowp = O + (size_t)(row0 + ai * HALF + m * 16) * ldc + col0;
#pragma unroll
                for (int bj = 0; bj < 2; ++bj) { f32x4 v0 = acc[ai][bj][m][0], v1 = acc[ai][bj][m][1];
                    if (gate) { v0 = v0 * gv[bj][0]; v1 = v1 * gv[bj][1]; }
                    if (act == 1) {
#pragma unroll
                        for (int e = 0; e < 4; ++e) { float a = fmaxf(v0[e], 0.f), b = fmaxf(v1[e], 0.f); v0[e] = a * a; v1[e] = b * b; } }
                    u32x4 w; w.x = cvt_pk_bf16(v0[0], v0[1]); w.y = cvt_pk_bf16(v0[2], v0[3]); w.z = cvt_pk_bf16(v1[0], v1[1]); w.w = cvt_pk_bf16(v1[2], v1[3]);
                    *(u32x4*)(rowp + bj * HALF) = w; } }
    }
};
struct EpiResid {
    static constexpr bool PERM = false, AFTER_DRAIN = false;
    float* xlat; float* xctx; const float* gt; float* dummy;
    __device__ __forceinline__ void operator()(const f32x4 (&acc)[2][2][4][2], const Unit& u, int wr, int wc, int fr, int fq) const {
        const int cond = (u.pm < 128) ? (u.pm >> 6) : 2; const float* g = gt + cond * 6144;
        const int col0 = u.pn * BM + wc * 32 + 4 * fq;
        f32x4 gv[2][2];
#pragma unroll
        for (int bj = 0; bj < 2; ++bj)
#pragma unroll
            for (int n = 0; n < 2; ++n) gv[bj][n] = *(const f32x4*)(g + col0 + bj * HALF + n * 16);
#pragma unroll
        for (int ai = 0; ai < 2; ++ai)
#pragma unroll
            for (int m = 0; m < 4; ++m) { const int r = u.pm * BM + ai * HALF + wr * 64 + m * 16 + fr;
                float* rowp = (r < 32768) ? (xlat + (size_t)r * 1024) : (xctx + (size_t)(r - 32768) * 1024);
#pragma unroll
                for (int bj = 0; bj < 2; ++bj)
#pragma unroll
                    for (int n = 0; n < 2; ++n) { float* p = rowp + col0 + bj * HALF + n * 16; f32x4 x = *(const f32x4*)p; x = x + gv[bj][n] * acc[ai][bj][m][n]; float* q = dummy ? (dummy + (size_t)(r & 16383) * 1024 + col0 + bj * HALF + n * 16) : p; *(f32x4*)q = x; } }
    }
};
template <class Epi, class Sched, bool ALIGN_EPI = false, bool SP2 = false>
__device__ __forceinline__ void gemm_phase(PG8_LAS unsigned char* lds, const Gemm g, const Sched& S, const Epi& E) {
    int tid_l = threadIdx.x; asm volatile("" : "+v"(tid_l));
    const int tid = tid_l, wid = __builtin_amdgcn_readfirstlane(tid >> 6), lane = tid & 63, wr = wid >> 2, wc = wid & 3, fr = lane & 15, fq = lane >> 4;
    const int K = g.K, nt = K / BK;
    unsigned voffA[2], voffB[2];
#pragma unroll
    for (int i = 0; i < 2; ++i) { int R, C; stage_rc(tid * 16 + i * 8192, R, C); const int Rb = Epi::PERM ? ((R & ~31) + perm32(R & 31)) : R;
        voffA[i] = (unsigned)(R * K + C) * 2u; voffB[i] = (unsigned)(Rb * K + C) * 2u; }
    const size_t kstep = (size_t)(BK * 2);
    const size_t hstep = (size_t)HALF * K * 2;
    const size_t tstep = 2 * hstep;
    const unsigned ldsw = (unsigned)wid * 1024u;
    const int aoff = lds_byte(wr * 64 + fr, fq * 8), boff = lds_byte(wc * 32 + fr, fq * 8);
#define PG8_SA(b, h) (((b) * 2 + (h)) * HTB)
#define PG8_SB(b, h) ((4 + (b) * 2 + (h)) * HTB)
#define PG8_STAGE(bufoff, gbase, voff) do { _Pragma("unroll") for (int _i = 0; _i < 2; ++_i) \
        __builtin_amdgcn_global_load_lds((const unsigned*)((const char*)(gbase) + (voff)[_i]), (PG8_LAS unsigned*)(lds + (bufoff) + ldsw + _i * 8192), 16, 0, 0); } while (0)
#define PG8_LDA(dst, b, h) do { _Pragma("unroll") for (int m = 0; m < 4; ++m) _Pragma("unroll") for (int k = 0; k < 2; ++k) dst[m][k] = *(const PG8_LAS bf16x8*)(lds + PG8_SA(b, h) + aoff + m * 2048 + k * 1024); } while (0)
#define PG8_LDB(dst, b, h) do { _Pragma("unroll") for (int n = 0; n < 2; ++n) _Pragma("unroll") for (int k = 0; k < 2; ++k) dst[n][k] = *(const PG8_LAS bf16x8*)(lds + PG8_SB(b, h) + boff + n * 2048 + k * 1024); } while (0)
#define PG8_MMA(ai, bj, At, Bt) do { __builtin_amdgcn_s_setprio(1); _Pragma("unroll") for (int m = 0; m < 4; ++m) _Pragma("unroll") for (int n = 0; n < 2; ++n) _Pragma("unroll") for (int k = 0; k < 2; ++k) \
        acc[ai][bj][m][n] = __builtin_amdgcn_mfma_f32_16x16x32_bf16(Bt[n][k], At[m][k], acc[ai][bj][m][n], 0, 0, 0); __builtin_amdgcn_s_setprio(0); } while (0)
#define PG8_WAIT_V(n) asm volatile("s_waitcnt vmcnt(" #n ")" ::: "memory")
#define PG8_WAIT_L(n) asm volatile("s_waitcnt lgkmcnt(" #n ")" ::: "memory")
#define PG8_BAR __builtin_amdgcn_s_barrier()
#define PG8_SCHED __builtin_amdgcn_sched_barrier(0)
    Unit cur, nxt; int ui = 0;
    if (!S.next(0, cur)) return;
    f32x4 acc[2][2][4][2];
#pragma unroll
    for (int a = 0; a < 2; ++a)
#pragma unroll
        for (int b = 0; b < 2; ++b)
#pragma unroll
            for (int m = 0; m < 4; ++m)
#pragma unroll
                for (int n = 0; n < 2; ++n) acc[a][b][m][n] = (f32x4){0.f, 0.f, 0.f, 0.f};
    bf16x8 At[4][2], B0[2][2], B1[2][2];
    const char* cA = (const char*)g.A + (size_t)cur.pm * tstep; const char* cB = (const char*)g.Bt + (size_t)cur.pn * tstep;
    S.a_ready(cur);
    if constexpr (SP2) {
        PG8_STAGE(PG8_SB(0, 0), cB, voffB); PG8_STAGE(PG8_SB(0, 1), cB + hstep, voffB); PG8_STAGE(PG8_SA(0, 0), cA, voffA); PG8_STAGE(PG8_SA(0, 1), cA + hstep, voffA);
        if (wr == 1) PG8_BAR;
        PG8_WAIT_V(2); PG8_BAR;
        PG8_STAGE(PG8_SB(1, 0), cB + kstep, voffB); PG8_STAGE(PG8_SA(1, 0), cA + kstep, voffA); PG8_STAGE(PG8_SB(1, 1), cB + hstep + kstep, voffB);
        PG8_WAIT_V(6); PG8_BAR;
    } else {
        PG8_STAGE(PG8_SB(0, 0), cB, voffB); PG8_STAGE(PG8_SA(0, 0), cA, voffA); PG8_STAGE(PG8_SB(0, 1), cB + hstep, voffB); PG8_STAGE(PG8_SA(0, 1), cA + hstep, voffA);
        if (wr == 1) PG8_BAR;
        PG8_WAIT_V(4); PG8_BAR;
        PG8_STAGE(PG8_SB(1, 0), cB + kstep, voffB); PG8_STAGE(PG8_SA(1, 0), cA + kstep, voffA); PG8_STAGE(PG8_SB(1, 1), cB + hstep + kstep, voffB);
        PG8_WAIT_V(6); PG8_BAR;
    }
    for (;;) {
        const bool has_next = S.next(ui + 1, nxt);
        const char* nA = has_next ? (const char*)g.A + (size_t)nxt.pm * tstep : cA; const char* nB = has_next ? (const char*)g.Bt + (size_t)nxt.pn * tstep : cB;
        for (int t = 0; t < nt; t += 2) {
            const bool last = (t == nt - 2);
            const char* a1 = cA + (size_t)(t + 1) * kstep;
            const char* a2 = last ? nA : cA + (size_t)(t + 2) * kstep; const char* b2 = last ? nB : cB + (size_t)(t + 2) * kstep;
            const char* a3 = a2 + kstep; const char* b3 = b2 + kstep;
            if (last && has_next) S.a_ready(nxt);
            if constexpr (SP2) {
            PG8_LDB(B0, 0, 0); PG8_LDB(B1, 0, 1); PG8_SCHED; PG8_LDA(At, 0, 0); PG8_STAGE(PG8_SA(1, 1), a1 + hstep, voffA);
            PG8_WAIT_V(8); PG8_WAIT_L(0); PG8_BAR; PG8_MMA(0, 0, At, B0); PG8_MMA(0, 1, At, B1); PG8_BAR; PG8_SCHED;
            PG8_LDA(At, 0, 1); PG8_STAGE(PG8_SB(0, 0), b2, voffB); PG8_STAGE(PG8_SB(0, 1), b2 + hstep, voffB); PG8_STAGE(PG8_SA(0, 0), a2, voffA);
            PG8_WAIT_V(8); PG8_WAIT_L(0); PG8_BAR; PG8_MMA(1, 0, At, B0); PG8_MMA(1, 1, At, B1); PG8_BAR; PG8_SCHED;
            PG8_LDB(B0, 1, 0); PG8_LDB(B1, 1, 1); PG8_SCHED; PG8_LDA(At, 1, 0); PG8_STAGE(PG8_SA(0, 1), a2 + hstep, voffA);
            PG8_WAIT_V(8); PG8_WAIT_L(0); PG8_BAR; PG8_MMA(0, 0, At, B0); PG8_MMA(0, 1, At, B1); PG8_BAR; PG8_SCHED;
            PG8_LDA(At, 1, 1); PG8_STAGE(PG8_SB(1, 0), b3, voffB); PG8_STAGE(PG8_SB(1, 1), b3 + hstep, voffB); PG8_STAGE(PG8_SA(1, 0), a3, voffA);
            PG8_WAIT_V(8); PG8_WAIT_L(0); PG8_BAR; PG8_MMA(1, 0, At, B0); PG8_MMA(1, 1, At, B1); PG8_BAR; PG8_SCHED;
            } else {
            PG8_LDB(B0, 0, 0); PG8_SCHED; PG8_LDA(At, 0, 0); PG8_STAGE(PG8_SA(1, 1), a1 + hstep, voffA);
            PG8_WAIT_L(8); PG8_BAR; PG8_WAIT_L(0); PG8_MMA(0, 0, At, B0); PG8_BAR; PG8_SCHED;
            PG8_LDB(B1, 0, 1); PG8_STAGE(PG8_SB(0, 0), b2, voffB);
            PG8_BAR; PG8_WAIT_L(0); PG8_MMA(0, 1, At, B1); PG8_BAR;
            PG8_LDA(At, 0, 1); PG8_STAGE(PG8_SA(0, 0), a2, voffA);
            PG8_BAR; PG8_WAIT_L(0); PG8_MMA(1, 0, At, B0); PG8_BAR; PG8_SCHED;
            PG8_STAGE(PG8_SB(0, 1), b2 + hstep, voffB);
            PG8_WAIT_V(6); PG8_BAR; PG8_MMA(1, 1, At, B1); PG8_BAR;
            PG8_LDB(B0, 1, 0); PG8_SCHED; PG8_LDA(At, 1, 0); PG8_STAGE(PG8_SA(0, 1), a2 + hstep, voffA);
            PG8_WAIT_L(8); PG8_BAR; PG8_WAIT_L(0); PG8_MMA(0, 0, At, B0); PG8_BAR; PG8_SCHED;
            PG8_LDB(B1, 1, 1); PG8_STAGE(PG8_SB(1, 0), b3, voffB);
            PG8_BAR; PG8_WAIT_L(0); PG8_MMA(0, 1, At, B1); PG8_BAR;
            PG8_LDA(At, 1, 1); PG8_STAGE(PG8_SA(1, 0), a3, voffA);
            PG8_BAR; PG8_WAIT_L(0); PG8_MMA(1, 0, At, B0); PG8_BAR; PG8_SCHED;
            PG8_STAGE(PG8_SB(1, 1), b3 + hstep, voffB);
            PG8_WAIT_V(6); PG8_BAR; PG8_MMA(1, 1, At, B1); PG8_BAR;
            }
        }
        if constexpr (ALIGN_EPI) { if (wr == 0) PG8_BAR; }
        if constexpr (!Epi::AFTER_DRAIN) { E(acc, cur, wr, wc, fr, fq); S.done(cur); }
        if (!has_next) break;
#pragma unroll
        for (int a = 0; a < 2; ++a)
#pragma unroll
            for (int b = 0; b < 2; ++b)
#pragma unroll
                for (int m = 0; m < 4; ++m)
#pragma unroll
                    for (int n = 0; n < 2; ++n) acc[a][b][m][n] = (f32x4){0.f, 0.f, 0.f, 0.f};
        cur = nxt; cA = nA; cB = nB; ++ui;
        if constexpr (ALIGN_EPI) { if (wr == 1) PG8_BAR; }
    }
    PG8_WAIT_V(0);
    if constexpr (!ALIGN_EPI) { if (wr == 0) PG8_BAR; }
    PG8_BAR;
    if constexpr (Epi::AFTER_DRAIN) { E.fused(acc, cur, wr, wc, fr, fq, lds, wid, lane); S.done(cur); }
#undef PG8_SA
#undef PG8_SB
#undef PG8_STAGE
#undef PG8_LDA
#undef PG8_LDB
#undef PG8_MMA
#undef PG8_WAIT_V
#undef PG8_WAIT_L
#undef PG8_BAR
#undef PG8_SCHED
}
}
#include <hip/hip_bf16.h>
#include <cmath>
namespace attn_body {
using bf16=__hip_bfloat16;
using bf16x8=__attribute__((ext_vector_type(8)))short;
using s16x4=__attribute__((ext_vector_type(4)))short;
using f32x16=__attribute__((ext_vector_type(16)))float;
using u32x4=__attribute__((ext_vector_type(4)))unsigned;
constexpr int D=64,QP=2560,KP=128,OP=1024;
constexpr int NW=8,QBLK=32,QB=QBLK*NW,KVBLK=64;
constexpr int ATTN_UNIT_ROWS=QB;
__device__ __forceinline__ int crow(int r,int hi){return (r&3)+8*(r>>2)+4*hi;}
#define SBAR() __builtin_amdgcn_sched_barrier(0)
__device__ __forceinline__ void cmask(f32x16&p0,f32x16&p1,int jb,int qrel,int hi){
  const float NEG=-INFINITY; int kb=64*jb+4*hi;
  #pragma unroll
  for(int r=0;r<16;++r){int kv=kb+(r&3)+8*(r>>2); if(kv>qrel)p0[r]=NEG; if(kv+32>qrel)p1[r]=NEG;}
}

constexpr int NSLOT=3, SLOTB=8192;
constexpr int LDS_K=0, LDS_V=NSLOT*SLOTB, LDS_WS=2*NSLOT*SLOTB, LDS_OST=LDS_WS+NW*64*4, LDS_BYTES=LDS_OST+NW*4096;
constexpr float C2=0.125f*1.4426950408889634f;
__device__ __forceinline__ void glds16(const void*gsrc,unsigned lds_dst){unsigned keep;
  asm volatile("s_mov_b32 %0, m0\n\ts_mov_b32 m0, %2\n\ts_nop 0\n\tglobal_load_lds_dwordx4 %1, off\n\ts_mov_b32 m0, %0":"=&s"(keep):"v"(gsrc),"s"(lds_dst):"memory");}
__device__ __forceinline__ float max3f(float a,float b,float c){float r;asm("v_max3_f32 %0, %1, %2, %3":"=v"(r):"v"(a),"v"(b),"v"(c));return r;}
__device__ __forceinline__ float max2f(float a,float b){float r;asm("v_max_f32_e32 %0, %1, %2":"=v"(r):"v"(a),"v"(b));return r;}
__device__ __forceinline__ float fadd_s(float a,float b){float r;asm("v_add_f32_e32 %0, %1, %2":"=v"(r):"v"(a),"v"(b));return r;}
__device__ __forceinline__ float fsub_s(float a,float b){float r;asm("v_sub_f32_e32 %0, %1, %2":"=v"(r):"v"(a),"v"(b));return r;}
typedef float f32x2_t __attribute__((ext_vector_type(2))); typedef __bf16 bf16x2_t __attribute__((ext_vector_type(2)));
__device__ __forceinline__ unsigned cvtpk_s(float lo,float hi){f32x2_t v={lo,hi};bf16x2_t b=__builtin_convertvector(v,bf16x2_t);return __builtin_bit_cast(unsigned,b);}
#define WAIT_BAR(N) asm volatile("s_waitcnt vmcnt(" #N ") lgkmcnt(0)\n\ts_barrier":::"memory")

__device__ __forceinline__ void qkt(f32x16&p0,f32x16&p1,const char*Kslot,const bf16x8*qr,const f32x16&negm,int r32,int hi){
  const char*kb=Kslot+hi*1024+r32*16;
  #pragma unroll
  for(int d0=0;d0<4;++d0){
    const bf16x8 b0=*reinterpret_cast<const bf16x8*>(kb+d0*2048);
    const bf16x8 b1=*reinterpret_cast<const bf16x8*>(kb+d0*2048+512);
    if(d0==0){p0=__builtin_amdgcn_mfma_f32_32x32x16_bf16(b0,qr[0],negm,0,0,0);p1=__builtin_amdgcn_mfma_f32_32x32x16_bf16(b1,qr[0],negm,0,0,0);}
    else{p0=__builtin_amdgcn_mfma_f32_32x32x16_bf16(b0,qr[d0],p0,0,0,0);p1=__builtin_amdgcn_mfma_f32_32x32x16_bf16(b1,qr[d0],p1,0,0,0);}}
}
typedef __attribute__((address_space(3))) const char* lds_cptr;
typedef short v4i16_t __attribute__((ext_vector_type(4)));
__device__ __forceinline__ void kload8(bf16x8*kf,lds_cptr kp){
  kf[0]=*(const __attribute__((address_space(3))) bf16x8*)(kp);      kf[1]=*(const __attribute__((address_space(3))) bf16x8*)(kp+512);
  kf[2]=*(const __attribute__((address_space(3))) bf16x8*)(kp+2048); kf[3]=*(const __attribute__((address_space(3))) bf16x8*)(kp+2560);
  kf[4]=*(const __attribute__((address_space(3))) bf16x8*)(kp+4096); kf[5]=*(const __attribute__((address_space(3))) bf16x8*)(kp+4608);
  kf[6]=*(const __attribute__((address_space(3))) bf16x8*)(kp+6144); kf[7]=*(const __attribute__((address_space(3))) bf16x8*)(kp+6656);
}
__device__ __forceinline__ void kload2(bf16x8*kf,lds_cptr kp,int j){ kf[2*j]=*(const __attribute__((address_space(3))) bf16x8*)(kp+j*2048); kf[2*j+1]=*(const __attribute__((address_space(3))) bf16x8*)(kp+j*2048+512); }
__device__ __forceinline__ s16x4 vtr(lds_cptr p){ return __builtin_bit_cast(s16x4,__builtin_amdgcn_ds_read_tr16_b64_v4i16((__attribute__((address_space(3))) v4i16_t*)p)); }
__device__ __forceinline__ float rowmax(const f32x16&p0,const f32x16&p1){
  float a=max3f(p0[0],p0[1],p1[0]),b=max3f(p0[2],p0[3],p1[1]);a=max3f(a,p1[2],p1[3]);
  #pragma unroll
  for(int r=4;r<16;r+=4){a=max3f(a,p0[r],p0[r+1]);b=max3f(b,p0[r+2],p0[r+3]);a=max3f(a,p1[r],p1[r+1]);b=max3f(b,p1[r+2],p1[r+3]);}
  const float m=max2f(a,b);
  auto rr=__builtin_amdgcn_permlane32_swap(__float_as_uint(m),__float_as_uint(m),false,false);
  return max2f(__uint_as_float(rr[0]),__uint_as_float(rr[1]));
}
__device__ __forceinline__ void pv(f32x16*o,int vb,bf16x8 pa0,bf16x8 pa1,bf16x8 pa2,bf16x8 pa3){
  #pragma unroll
  for(int d0=0;d0<2;++d0){s16x4 lo[4],hi[4];
    #pragma unroll
    for(int ks=0;ks<4;++ks){
      asm volatile("ds_read_b64_tr_b16 %0,%1 offset:%c2":"=&v"(lo[ks]):"v"(vb),"i"(d0*4096+ks*1024):"memory");
      asm volatile("ds_read_b64_tr_b16 %0,%1 offset:%c2":"=&v"(hi[ks]):"v"(vb),"i"(d0*4096+ks*1024+512):"memory");}
    asm volatile("s_waitcnt lgkmcnt(0)":::"memory");SBAR();
    #define PK(k) (bf16x8){lo[k][0],lo[k][1],lo[k][2],lo[k][3],hi[k][0],hi[k][1],hi[k][2],hi[k][3]}
    o[d0]=__builtin_amdgcn_mfma_f32_32x32x16_bf16(pa0,PK(0),o[d0],0,0,0);
    o[d0]=__builtin_amdgcn_mfma_f32_32x32x16_bf16(pa1,PK(1),o[d0],0,0,0);
    o[d0]=__builtin_amdgcn_mfma_f32_32x32x16_bf16(pa2,PK(2),o[d0],0,0,0);
    o[d0]=__builtin_amdgcn_mfma_f32_32x32x16_bf16(pa3,PK(3),o[d0],0,0,0);
    #undef PK
  }
}

#ifndef ATTN_STORE16
#define ATTN_STORE16(p,v) (*(u32x4*)(p)=(v))
#endif
template<int THRL,bool FIXREF> __device__ __forceinline__ void attn_unit(const float*gq,const float*tab,const int tq0,const bf16*Qw0,const bf16*__restrict__ Kl,const bf16*__restrict__ Vl,const int NT,bf16*Ow0,char*shm){
  int tid_l=threadIdx.x; asm volatile("":"+v"(tid_l)); const int tid=tid_l,lane=tid&63,r32=lane&31,hi=lane>>5; const int wid=__builtin_amdgcn_readfirstlane(tid>>6);
  const bf16*Qw=Qw0+(long)(wid*QBLK)*QP;
  const unsigned lds0=(unsigned)(uintptr_t)shm;
  float*wsf=(float*)(shm+LDS_WS)+wid*64;
  const bf16*ksrc=Kl+wid*512+lane*8;
  const bf16*vsrc=Vl+wid*512+lane*8;
  const unsigned kdst=lds0+LDS_K+wid*1024, vdst=lds0+LDS_V+wid*1024;
  #define DMA_K(t,slot) glds16(ksrc+(long)(t)*4096,(unsigned)__builtin_amdgcn_readfirstlane(kdst+(slot)))
  #define DMA_V(t,slot) glds16(vsrc+(long)(t)*4096,(unsigned)__builtin_amdgcn_readfirstlane(vdst+(slot)))
  const int vb0=(int)(lds0+LDS_V)+((lane>>4)&1)*32+(lane&3)*8+(4*hi+((lane&15)>>2))*64;
  const char*Kbase=shm+LDS_K; bf16x8 kf[8];
  const lds_cptr shm3=(lds_cptr)shm; const lds_cptr kp0=shm3+LDS_K+hi*1024+r32*16; const lds_cptr vp0=shm3+LDS_V+((lane>>4)&1)*32+(lane&3)*8+(4*hi+((lane&15)>>2))*64;
  DMA_K(0,0);DMA_V(0,0);DMA_K(1,SLOTB);
  bf16x8 qr[4];
  {
    float xq[4][8]; float ss=0.f;
    #pragma unroll
    for(int d0=0;d0<4;++d0){ const u32x4 w=*reinterpret_cast<const u32x4*>(&Qw[(long)r32*QP+d0*16+hi*8]); const unsigned ww[4]={w.x,w.y,w.z,w.w};
      #pragma unroll
      for(int c=0;c<4;++c){ xq[d0][2*c]=__uint_as_float(ww[c]<<16); xq[d0][2*c+1]=__uint_as_float(ww[c]&0xffff0000u); ss+=xq[d0][2*c]*xq[d0][2*c]+xq[d0][2*c+1]*xq[d0][2*c+1]; } }
    { auto rr=__builtin_amdgcn_permlane32_swap(__float_as_uint(ss),__float_as_uint(ss),false,false); ss=__uint_as_float(rr[0])+__uint_as_float(rr[1]); }
    const float rstd=__builtin_amdgcn_rsqf(ss*(1.f/64.f)+1e-6f)*C2;
    #pragma unroll
    for(int d0=0;d0<4;++d0){ const float*gp=gq+d0*16+hi*8;
      #pragma unroll
      for(int j=0;j<8;++j)xq[d0][j]*=rstd*gp[j]; }
    if(tab){ const int tpos=(tq0+wid*QBLK+r32)&16383; const float*tr_=tab+((tpos>>6)*16+hi*8)*2; const float*tc_=tab+((tpos&63)*16+hi*8)*2;
      #pragma unroll
      for(int j=0;j<8;++j){ const float cr=tr_[2*j],sr=tr_[2*j+1],cc=tc_[2*j],sc=tc_[2*j+1];
        const float a0=xq[0][j],b0=xq[1][j],a1=xq[2][j],b1=xq[3][j];
        xq[0][j]=a0*cr-b0*sr; xq[1][j]=a0*sr+b0*cr; xq[2][j]=a1*cc-b1*sc; xq[3][j]=a1*sc+b1*cc; } }
    #pragma unroll
    for(int d0=0;d0<4;++d0){ u32x4 p; p.x=cvtpk_s(xq[d0][0],xq[d0][1]); p.y=cvtpk_s(xq[d0][2],xq[d0][3]); p.z=cvtpk_s(xq[d0][4],xq[d0][5]); p.w=cvtpk_s(xq[d0][6],xq[d0][7]); qr[d0]=__builtin_bit_cast(bf16x8,p); } }
  float mhat=0.f,l_reg=0.f;f32x16 o[2];o[0]=f32x16{};o[1]=f32x16{};f32x16 negm=f32x16{};asm volatile("":"+v"(negm));
  #define CMASK(P0,P1,t) do{}while(0)
  bool resc=false;
  #define START(P0,P1) do{ resc=false; \
    if(!FIXREF){ const float rm=rowmax(P0,P1); const float dl=rm; mhat=fadd_s(mhat,dl); \
      _Pragma("unroll") for(int r=0;r<16;++r){P0[r]=fsub_s(P0[r],dl);P1[r]=fsub_s(P1[r],dl);} \
      _Pragma("unroll") for(int r=0;r<16;++r)negm[r]=-mhat; asm volatile("":"+v"(negm)); } \
    _Pragma("unroll") for(int r=0;r<16;++r)P0[r]=__builtin_amdgcn_exp2f(P0[r]); }while(0)
  #define RESC() do{ if(resc){ asm volatile("s_waitcnt lgkmcnt(0)":::"memory"); \
      _Pragma("unroll") for(int d_=0;d_<2;++d_) _Pragma("unroll") for(int r=0;r<16;++r)o[d_][r]*=wsf[crow(r,hi)]; } }while(0)
  f32x16 pA0,pA1,pB0,pB1;
  int sl_prev=0,sl_cur=0,sl_next=SLOTB;
  #define ROT() do{sl_prev=sl_cur;sl_cur=sl_next;sl_next=(sl_next==(NSLOT-1)*SLOTB)?0:sl_next+SLOTB;}while(0)
  DMA_K(2,2*SLOTB);
  WAIT_BAR(3);
  qkt(pA0,pA1,Kbase,qr,negm,r32,hi);asm volatile("s_nop 15\n\ts_nop 7":"+v"(pA0),"+v"(pA1));CMASK(pA0,pA1,0);
  START(pA0,pA1);
  _Pragma("unroll") for(int r=0;r<16;++r)pA1[r]=__builtin_amdgcn_exp2f(pA1[r]);
  WAIT_BAR(0);
  DMA_K(3,0);DMA_V(1,SLOTB);
  ROT();
  kload8(kf,kp0+sl_cur);
  WAIT_BAR(2);
  s16x4 vlo[8],vhi[8]; u32x4 pw0,pw1,pw2,pw3;
  #define PKW(P,B) cvtpk_s(P[B],P[B+1])
  #define PAF(k) __builtin_bit_cast(bf16x8,pw##k)
  #define VFR(i) (bf16x8){vlo[i][0],vlo[i][1],vlo[i][2],vlo[i][3],vhi[i][0],vhi[i][1],vhi[i][2],vhi[i][3]}
  #define PIN(x) asm volatile("":"+v"(x))
  #define MX3(a,b,c) __builtin_fmaxf(__builtin_fmaxf((a),(b)),(c))
  #define GAPA(MF,A0,A1,A2,A3,W0,W1,PW) do{ MF; sacc+=A0; sacc+=A1; sacc+=A2; sacc+=A3; PIN(sacc); W0; W1; PIN(PW); SBAR(); }while(0)
  #define EX(v) __builtin_amdgcn_exp2f(v)
  #define GAPB(MF,X,B) do{ MF; X[B]=EX(X[B]); X[B+1]=EX(X[B+1]); X[B+2]=EX(X[B+2]); X[B+3]=EX(X[B+3]); PIN(X); SBAR(); }while(0)
  #define VRD(i) do{ vlo[i]=vtr(vp_+(((i)>>2)*4096+((i)&3)*1024)); vhi[i]=vtr(vp_+(((i)>>2)*4096+((i)&3)*1024+512)); }while(0)
  #define KRD(G,j) do{ if(G){ kload2(kf,kp0+sl_next,j); SBAR(); } }while(0)
  #define STEP(C0,C1,P0,P1,t,GK,GV,GL) do{ SBAR(); \
    const lds_cptr vp_=vp0+sl_prev; \
    VRD(0); SBAR(); float sacc=(P0[0]+P0[1]); \
    GAPA(C0=__builtin_amdgcn_mfma_f32_32x32x16_bf16(kf[0],qr[0],negm,0,0,0), P0[2],P0[3],P0[4],P0[5],     pw0[0]=PKW(P0,0), pw0[1]=PKW(P0,2), pw0); \
    VRD(4); SBAR(); GAPA(C1=__builtin_amdgcn_mfma_f32_32x32x16_bf16(kf[1],qr[0],negm,0,0,0), P0[6],P0[7],P0[8],P0[9],     pw0[2]=PKW(P0,4), pw0[3]=PKW(P0,6), pw0); \
    VRD(1); SBAR(); GAPA(C0=__builtin_amdgcn_mfma_f32_32x32x16_bf16(kf[2],qr[1],C0,0,0,0),   P0[10],P0[11],P0[12],P0[13], pw1[0]=PKW(P0,8), pw1[1]=PKW(P0,10), pw1); \
    VRD(5); SBAR(); GAPA(C1=__builtin_amdgcn_mfma_f32_32x32x16_bf16(kf[3],qr[1],C1,0,0,0),   P0[14],P0[15],P1[0],P1[1],   pw1[2]=PKW(P0,12),pw1[3]=PKW(P0,14), pw1); \
    VRD(2); SBAR(); GAPA(C0=__builtin_amdgcn_mfma_f32_32x32x16_bf16(kf[4],qr[2],C0,0,0,0),   P1[2],P1[3],P1[4],P1[5],     pw2[0]=PKW(P1,0), pw2[1]=PKW(P1,2), pw2); \
    VRD(6); SBAR(); GAPA(C1=__builtin_amdgcn_mfma_f32_32x32x16_bf16(kf[5],qr[2],C1,0,0,0),   P1[6],P1[7],P1[8],P1[9],     pw2[2]=PKW(P1,4), pw2[3]=PKW(P1,6), pw2); \
    VRD(3); SBAR(); GAPA(C0=__builtin_amdgcn_mfma_f32_32x32x16_bf16(kf[6],qr[3],C0,0,0,0),   P1[10],P1[11],P1[12],P1[13], pw3[0]=PKW(P1,8), pw3[1]=PKW(P1,10), pw3); \
    VRD(7); SBAR(); GAPA(C1=__builtin_amdgcn_mfma_f32_32x32x16_bf16(kf[7],qr[3],C1,0,0,0),   P1[14],P1[15],0.f,0.f,       pw3[2]=PKW(P1,12),pw3[3]=PKW(P1,14), pw3); \
    l_reg+=sacc; \
    if(GK){DMA_K((t)+3,sl_cur);} if(GV){DMA_V((t)+1,sl_next);} \
    CMASK(C0,C1,t); \
    if(!FIXREF){ float a=MX3(C0[0],C0[1],C1[0]),b=MX3(C0[2],C0[3],C1[1]); a=MX3(a,C1[2],C1[3]); \
      _Pragma("unroll") for(int r=4;r<16;r+=4){a=MX3(a,C0[r],C0[r+1]);b=MX3(b,C0[r+2],C0[r+3]);a=MX3(a,C1[r],C1[r+1]);b=MX3(b,C1[r+2],C1[r+3]);} \
      float rm=__builtin_fmaxf(a,b); { auto rr=__builtin_amdgcn_permlane32_swap(__float_as_uint(rm),__float_as_uint(rm),false,false); rm=__builtin_fmaxf(__uint_as_float(rr[0]),__uint_as_float(rr[1])); } \
      resc=false; \
      if(__builtin_expect(__any(rm>(float)THRL),0)){ const float dl=__builtin_fmaxf(rm,0.f); mhat+=dl; \
        _Pragma("unroll") for(int r=0;r<16;++r){C0[r]-=dl;C1[r]-=dl;} \
        _Pragma("unroll") for(int r=0;r<16;++r)negm[r]=-mhat; asm volatile("":"+v"(negm)); \
        const float f=__builtin_amdgcn_exp2f(-dl); l_reg*=f; if(hi==0)wsf[r32]=f; resc=true; } } \
    SBAR(); \
    GAPB(o[0]=__builtin_amdgcn_mfma_f32_32x32x16_bf16(PAF(0),VFR(0),o[0],0,0,0), C0,0); \
    GAPB(o[1]=__builtin_amdgcn_mfma_f32_32x32x16_bf16(PAF(0),VFR(4),o[1],0,0,0), C0,4); \
    KRD(GL,0); GAPB(o[0]=__builtin_amdgcn_mfma_f32_32x32x16_bf16(PAF(1),VFR(1),o[0],0,0,0), C0,8); \
    KRD(GL,1); GAPB(o[1]=__builtin_amdgcn_mfma_f32_32x32x16_bf16(PAF(1),VFR(5),o[1],0,0,0), C0,12); \
    KRD(GL,2); GAPB(o[0]=__builtin_amdgcn_mfma_f32_32x32x16_bf16(PAF(2),VFR(2),o[0],0,0,0), C1,0); \
    KRD(GL,3); GAPB(o[1]=__builtin_amdgcn_mfma_f32_32x32x16_bf16(PAF(2),VFR(6),o[1],0,0,0), C1,4); \
    GAPB(o[0]=__builtin_amdgcn_mfma_f32_32x32x16_bf16(PAF(3),VFR(3),o[0],0,0,0), C1,8); \
    GAPB(o[1]=__builtin_amdgcn_mfma_f32_32x32x16_bf16(PAF(3),VFR(7),o[1],0,0,0), C1,12); \
    }while(0)
  int t=1;
  #undef CMASK
  #define CMASK(P0,P1,t) do{}while(0)
  for(;t+5<NT;t+=2){
    STEP(pB0,pB1,pA0,pA1,t,true,true,true);     WAIT_BAR(2); RESC(); ROT();
    STEP(pA0,pA1,pB0,pB1,t+1,true,true,true);   WAIT_BAR(2); RESC(); ROT();
  }
  #undef CMASK
  #define CMASK(P0,P1,t) do{}while(0)
  #define ENDW(tt) do{ if((tt)+3<NT){WAIT_BAR(2);} else if((tt)+2<NT){WAIT_BAR(1);} else {WAIT_BAR(0);} }while(0)
  for(;t+1<NT;t+=2){
    STEP(pB0,pB1,pA0,pA1,t,(t+3<NT),(t+1<NT),(t+1<NT));       ENDW(t);   RESC(); ROT();
    STEP(pA0,pA1,pB0,pB1,t+1,(t+4<NT),(t+2<NT),(t+2<NT));     ENDW(t+1); RESC(); ROT();
  }
  STEP(pB0,pB1,pA0,pA1,NT-1,false,false,false); RESC();
  { float sacc=pB0[0]+pB0[1]; _Pragma("unroll") for(int r=2;r<16;++r)sacc+=pB0[r]; _Pragma("unroll") for(int r=0;r<16;++r)sacc+=pB1[r]; l_reg+=sacc;
    pw0=(u32x4){PKW(pB0,0),PKW(pB0,2),PKW(pB0,4),PKW(pB0,6)};pw1=(u32x4){PKW(pB0,8),PKW(pB0,10),PKW(pB0,12),PKW(pB0,14)};pw2=(u32x4){PKW(pB1,0),PKW(pB1,2),PKW(pB1,4),PKW(pB1,6)};pw3=(u32x4){PKW(pB1,8),PKW(pB1,10),PKW(pB1,12),PKW(pB1,14)};
    SBAR(); pv(o,vb0+sl_cur,PAF(0),PAF(1),PAF(2),PAF(3)); }
  #undef PKW
  #undef PAF
  #undef VFR
  #undef PIN
  #undef MX3
  #undef GAPA
  #undef GAPB
  #undef EX
  #undef VRD
  #undef KRD
  #undef STEP
  #undef ENDW
  {auto rr=__builtin_amdgcn_permlane32_swap(__float_as_uint(l_reg),__float_as_uint(l_reg),false,false);l_reg=__uint_as_float(rr[0])+__uint_as_float(rr[1]);}
  if(hi==0)wsf[32+r32]=l_reg;asm volatile("s_waitcnt lgkmcnt(0)":::"memory");
  float rli[16];
  #pragma unroll
  for(int r=0;r<16;++r)rli[r]=__builtin_amdgcn_rcpf(wsf[32+crow(r,hi)]);
  bf16*Ow=Ow0+(long)(wid*QBLK)*OP;
  { bf16*stg=(bf16*)(shm+LDS_OST)+wid*2048;
    #pragma unroll
    for(int r=0;r<16;++r){const int orow=crow(r,hi);
      #pragma unroll
      for(int d0=0;d0<2;++d0)stg[orow*64+d0*32+r32]=__float2bfloat16(o[d0][r]*rli[r]);}
    asm volatile("s_waitcnt lgkmcnt(0)":::"memory");
    #pragma unroll
    for(int i=0;i<4;++i){const int row=i*8+(lane>>3),ch=lane&7; const u32x4 v=*(const u32x4*)(stg+row*64+ch*8); ATTN_STORE16(Ow+(long)row*OP+ch*8,v);} }
  asm volatile("s_waitcnt lgkmcnt(0)\n\ts_barrier":::"memory");
  #undef DMA_K
  #undef DMA_V
  #undef CMASK
  #undef START
  #undef RESC
  #undef ROT
}
constexpr int ATTN_LDS_BYTES=LDS_BYTES;
#undef SBAR
#undef WAIT_BAR
}
#ifndef REP_SYNC
#define REP_SYNC 1
#endif
#ifndef REP_PRO
#define REP_PRO 1
#endif
#ifndef REP_S2
#define REP_S2 1
#endif
#ifndef REP_NORM
#define REP_NORM 1
#endif
#ifndef REP_G1
#define REP_G1 1
#endif
#ifndef REP_S1
#define REP_S1 1
#endif
#ifndef REP_S3
#define REP_S3 1
#endif
#ifndef REP_ATT
#define REP_ATT 1
#endif
#ifndef REP_POST0
#define REP_POST0 1
#endif
#define LAS __attribute__((address_space(3)))
typedef unsigned short u16;
typedef float f32x4 __attribute__((ext_vector_type(4)));
typedef float f32x2 __attribute__((ext_vector_type(2)));
typedef unsigned u32x4 __attribute__((ext_vector_type(4)));
typedef unsigned u32x2 __attribute__((ext_vector_type(2)));

constexpr int M_LAT = 32768, M_CTXR = 512, M_ALL = 33280, DM_ = 1024, NPAD = 2560, IN_W = 2336, FF_ = 4096;
constexpr int C_RQ = 0, C_RK = 128, C_RV = 256, C_RG = 512, C_GQ = 768, C_GK = 896, C_GV = 1024, C_GG = 1280, C_AQ = 1536, C_AK = 2048, C_AV = 2176, C_Z = 2304;
constexpr int SRC_GA = 1536;
constexpr float NEPS = 1e-6f;
constexpr int N_ITEM1 = 8320;
constexpr int N_ITEM3 = 4160;
constexpr size_t MiB = 1u << 20, KiB = 1u << 10;
constexpr size_t WS_MOD = 0;
constexpr size_t WS_BAR = 256 * KiB, WS_BAR_BYTES = 16 * KiB;
constexpr size_t WS_TAB = 512 * KiB;
constexpr size_t WS_CTXRES = 1 * MiB;
constexpr size_t WS_DEC = 3 * MiB;
constexpr size_t WS_W = 5 * MiB, W_LAYER = 23 * MiB, W_IN = 0, W_OUT = 5 * MiB, W_1 = 7 * MiB, W_2 = 15 * MiB;
constexpr size_t WS_XNY = 51 * MiB;
constexpr size_t WS_P = 116 * MiB;
constexpr size_t WS_QB = WS_P + (size_t)M_ALL * NPAD * 2;
constexpr size_t WS_KB = WS_QB + (size_t)M_ALL * 512 * 2;
constexpr size_t WS_VB = WS_KB + (size_t)M_ALL * 128 * 2;
constexpr size_t WS_G = WS_VB + (size_t)M_ALL * 128 * 2;
constexpr size_t WS_AS = WS_G + (size_t)M_ALL * 256 * 4;
constexpr size_t WS_END1 = WS_AS + (size_t)N_ITEM1 * 2048 * 4;
constexpr size_t WS_H = WS_P;
constexpr size_t WS_END2 = WS_H + (size_t)M_ALL * FF_ * 2;
constexpr size_t WS_YA = 430 * MiB;
static_assert(WS_YA >= WS_END1 && WS_YA >= WS_END2 && WS_YA + (size_t)M_ALL * 1024 * 2 <= 512 * MiB, "YA");
static_assert(WS_END1 <= 512 * MiB && WS_END2 <= 512 * MiB, "d_ws map");
constexpr int LDS_BYTES = 147456;

__device__ __forceinline__ float bf2f(unsigned h) { return __uint_as_float(h << 16); }
__device__ __forceinline__ float bflo(unsigned w) { return __uint_as_float(w << 16); }
__device__ __forceinline__ float bfhi(unsigned w) { return __uint_as_float(w & 0xffff0000u); }
__device__ __forceinline__ unsigned pk2(float lo, float hi) { return pg8::cvt_pk_bf16(lo, hi); }
template <int X> __device__ __forceinline__ float xor_lane(float v) { static_assert(X >= 1 && X <= 16, "xor_lane"); return __int_as_float(__builtin_amdgcn_ds_swizzle(__float_as_int(v), (X << 10) | 0x1F)); }
__device__ __forceinline__ float sum_halves(float v) { auto rr = __builtin_amdgcn_permlane32_swap(__float_as_uint(v), __float_as_uint(v), false, false); return __uint_as_float(rr[0]) + __uint_as_float(rr[1]); }
__device__ __forceinline__ float other_half(float v) { auto rr = __builtin_amdgcn_permlane32_swap(__float_as_uint(v), __float_as_uint(v), false, false); return (rr[0] == __float_as_uint(v)) ? __uint_as_float(rr[1]) : __uint_as_float(rr[0]); }
__device__ __forceinline__ float wave_sum(float v) {
    v += xor_lane<1>(v); v += xor_lane<2>(v); v += xor_lane<4>(v); v += xor_lane<8>(v); v += xor_lane<16>(v);
    return sum_halves(v);
}
__device__ __forceinline__ float logsig(float z) { return fminf(z, 0.f) - __logf(1.f + __expf(-fabsf(z))); }
#define LDS_WAIT() asm volatile("s_waitcnt lgkmcnt(0)" ::: "memory")

__device__ __forceinline__ void p0_transpose_item(const float* W, int K, int N, u16* WT, LAS float* scr, int item, int lane, int row_off = 0) {
    const int nblk = N / 32, kb = item / nblk, nb = item % nblk, k0 = 64 * kb, n0 = 32 * nb;
#pragma unroll 8
    for (int i = 0; i < 32; ++i) { const int kk = 2 * i + (lane >> 5); scr[kk * 33 + (lane & 31)] = W[(size_t)(k0 + kk) * N + n0 + (lane & 31)]; }
    LDS_WAIT(); asm volatile("" ::: "memory");
    const int c = lane & 7;
#pragma unroll
    for (int j = 0; j < 4; ++j) { const int n = (lane >> 3) + 8 * j; const LAS float* s = scr + (8 * c) * 33 + n;
        u32x4 o; o.x = pk2(s[0 * 33], s[1 * 33]); o.y = pk2(s[2 * 33], s[3 * 33]); o.z = pk2(s[4 * 33], s[5 * 33]); o.w = pk2(s[6 * 33], s[7 * 33]);
        *(u32x4*)(WT + (size_t)(n0 + n + row_off) * K + k0 + 8 * c) = o; }
    LDS_WAIT(); asm volatile("" ::: "memory");
}

#define XB_TMO      128
#define XB_XCNT(j)  (256  + 64 * (j))
#define XB_XSUB(j)  (1280 + 64 * (j))
#define XB_XGEN(j)  (2304 + 64 * (j))
#define XB_TOP      3328
#define XB_TOPGEN   3392
#define XCD_BAR_WORDS 3456
#define XB_SPIN_CAP (1u << 18)

__device__ __forceinline__ unsigned xb_ld(unsigned* p)              { return __hip_atomic_load(p, __ATOMIC_RELAXED, __HIP_MEMORY_SCOPE_AGENT); }
__device__ __forceinline__ unsigned xb_add(unsigned* p, unsigned v) { return __hip_atomic_fetch_add(p, v, __ATOMIC_RELAXED, __HIP_MEMORY_SCOPE_AGENT); }
__device__ __forceinline__ unsigned xb_xcc_id() { return (unsigned)__builtin_amdgcn_s_getreg((3 << 11) | 20) & 0xFu; }
#define XB_SPIN(cond, bar) do { unsigned _sp = 0; while (cond) { __builtin_amdgcn_s_sleep(1); \
    if ((++_sp & 255u) == 0u) { if (xb_ld(&(bar)[XB_TMO])) break; if (_sp > XB_SPIN_CAP) { atomicAdd(&(bar)[XB_TMO], 1u); break; } } } } while (0)

struct XcdBarrier {
    unsigned* bar; unsigned x;
    volatile LAS unsigned* st;
};

__device__ __forceinline__ XcdBarrier xcd_barrier_post(unsigned* bar, volatile LAS unsigned* st) {
    XcdBarrier b; b.bar = bar; b.x = xb_xcc_id(); b.st = st;
    if (threadIdx.x == 0) (void)xb_add(&bar[XB_XCNT(b.x)], 1u);
    return b;
}
__device__ __forceinline__ void xcd_barrier_complete(unsigned* bar, unsigned x, unsigned& nloc, unsigned& nx) {
    const unsigned G = gridDim.x * gridDim.y * gridDim.z;
    unsigned sum, cnt, mine, sp = 0u;
    for (;;) {
        sum = 0u; cnt = 0u; mine = 0u;
#pragma unroll
        for (unsigned j = 0; j < 16; ++j) { const unsigned c = xb_ld(&bar[XB_XCNT(j)]); sum += c; cnt += (c > 0u) ? 1u : 0u; mine = (j == x) ? c : mine; }
        if (sum == G) break;
        __builtin_amdgcn_s_sleep(1);
        if ((++sp & 255u) == 0u) { if (xb_ld(&bar[XB_TMO])) break; if (sp > XB_SPIN_CAP) { atomicAdd(&bar[XB_TMO], 1u); break; } }
    }
    nloc = mine > 0u ? mine : 1u; nx = cnt > 0u ? cnt : 1u;
}

__device__ __forceinline__ void xcd_barrier(const XcdBarrier& b) {
    asm volatile("s_waitcnt vmcnt(0)" ::: "memory");
    __syncthreads();
    if (threadIdx.x == 0) {
        unsigned* bar = b.bar;
        __builtin_amdgcn_s_waitcnt(0);
        unsigned nloc = b.st[0], nx = b.st[1];
        if (nloc == 0u) { xcd_barrier_complete(bar, b.x, nloc, nx); b.st[0] = nloc; b.st[1] = nx; }
        const unsigned old = xb_add(&bar[XB_XSUB(b.x)], 1u);
        const unsigned gen = old / nloc;
        if (old + 1u == (gen + 1u) * nloc) {
            __builtin_amdgcn_fence(__ATOMIC_RELEASE, "agent");
            asm volatile("s_waitcnt vmcnt(0)" ::: "memory");
            const unsigned og = xb_add(&bar[XB_TOP], 1u);
            const unsigned tg = og / nx;
            if (og + 1u == (tg + 1u) * nx) xb_add(&bar[XB_TOPGEN], 1u);
            else XB_SPIN(xb_ld(&bar[XB_TOPGEN]) == tg, bar);
            __builtin_amdgcn_fence(__ATOMIC_ACQUIRE, "agent");
            xb_add(&bar[XB_XGEN(b.x)], 1u);
            asm volatile("s_waitcnt vmcnt(0)" ::: "memory");
        } else {
            XB_SPIN(xb_ld(&bar[XB_XGEN(b.x)]) == gen, bar);
            __builtin_amdgcn_fence(__ATOMIC_ACQUIRE, "agent");
            asm volatile("s_waitcnt vmcnt(0)" ::: "memory");
        }
    }
    __syncthreads();
}


typedef short mbf16x8 __attribute__((ext_vector_type(8)));
template <int MODE> __device__ __forceinline__ void mini_gemm_ctx(const u16* A, const u16* Bt, int N, int K, u16* Ob, int ldo, int act, const float* gate, LAS unsigned char* L, int vb, int G_, int wave, int lane) {
    const int ncg = (N + 63) >> 6, ntiles = 8 * ncg, kslice = K >> 3;
    const int fr = lane & 15, fq = lane >> 4;
    LAS f32x4* red = (LAS f32x4*)L;
    for (int tile = vb; tile < ntiles; tile += G_) {
        const int r0 = (tile & 7) * 64, n0 = (tile >> 3) * 64;
        f32x4 acc[4][4];
#pragma unroll
        for (int a = 0; a < 4; ++a)
#pragma unroll
            for (int c = 0; c < 4; ++c) acc[a][c] = (f32x4){0.f, 0.f, 0.f, 0.f};
        const u16* ap = A + (size_t)(r0 + fr) * K + wave * kslice + 8 * fq; const u16* bp = Bt + (size_t)(n0 + fr) * K + wave * kslice + 8 * fq;
#pragma unroll 1
        for (int kc = 0; kc < kslice; kc += 64) {
            mbf16x8 fa[4][2], fb[4][2];
#pragma unroll
            for (int s = 0; s < 2; ++s)
#pragma unroll
                for (int q = 0; q < 4; ++q) { fa[q][s] = *(const mbf16x8*)(ap + (size_t)(16 * q) * K + kc + 32 * s); fb[q][s] = *(const mbf16x8*)(bp + (size_t)(16 * q) * K + kc + 32 * s); }
#pragma unroll
            for (int s = 0; s < 2; ++s)
#pragma unroll
                for (int mi = 0; mi < 4; ++mi)
#pragma unroll
                    for (int ni = 0; ni < 4; ++ni) acc[mi][ni] = __builtin_amdgcn_mfma_f32_16x16x32_bf16(fa[mi][s], fb[ni][s], acc[mi][ni], 0, 0, 0);
        }
#pragma unroll
        for (int ti = 0; ti < 16; ++ti) red[(wave * 16 + ti) * 64 + lane] = acc[ti >> 2][ti & 3];
        __syncthreads();
#pragma unroll
        for (int q = 0; q < 2; ++q) { const int ti = 2 * wave + q, mi = ti >> 2, ni = ti & 3;
            f32x4 s = red[ti * 64 + lane];
#pragma unroll
            for (int w = 1; w < 8; ++w) s += red[(w * 16 + ti) * 64 + lane];
            const int c = n0 + 16 * ni + fr;
            if (c < N) {
                const float gv = (MODE == 1) ? gate[c] : 1.f;
#pragma unroll
                for (int i = 0; i < 4; ++i) { const int r = r0 + 16 * mi + 4 * fq + i; float v = s[i] * gv;
                    if (act) { v = fmaxf(v, 0.f); v = v * v; } Ob[(size_t)r * ldo + c] = (u16)(pk2(v, 0.f) & 0xffffu); }
            }
        }
        __syncthreads();
    }
}

struct Args { const float* in[17]; float* out; unsigned char* ws; };

__global__ void __launch_bounds__(512, 2) fwd_megakernel(Args args) {
    extern __shared__ __attribute__((aligned(16))) unsigned char lds[];
    cg::grid_group grid = cg::this_grid();
    LAS unsigned char* L = (LAS unsigned char*)lds;
    const int G_ = gridDim.x, bx = blockIdx.x, NGW = G_ * 8;
#define PHASE_IDS int tid_l = threadIdx.x; asm volatile("" : "+v"(tid_l)); const int tid = tid_l, lane = tid & 63, wave = __builtin_amdgcn_readfirstlane(tid >> 6), gw = bx * 8 + wave; (void)gw; (void)lane;
    const int vcu = (G_ % 8 == 0) ? (bx % 8) * (G_ / 8) + bx / 8 : bx;
#define PHASE_PTRS \
    const __attribute__((address_space(4))) Args* ka_ = (const __attribute__((address_space(4))) Args*)__builtin_amdgcn_kernarg_segment_ptr(); asm volatile("" : "+s"(ka_)); \
    unsigned char* ws = ka_->ws; \
    const float* in_x = ka_->in[0]; const float* in_c = ka_->in[1]; const float* in_ctx = ka_->in[2]; const float* in_cctx = ka_->in[3]; \
    const float* in_modw = ka_->in[4]; const float* in_modb = ka_->in[5]; const float* in_ang = ka_->in[6]; const float* in_mng = ka_->in[7]; \
    const float* in_win = ka_->in[8]; const float* in_wout = ka_->in[9]; const float* in_retl = ka_->in[10]; const float* in_ggw = ka_->in[11]; \
    const float* in_ggb = ka_->in[12]; const float* in_qkg = ka_->in[13]; const float* in_w1 = ka_->in[14]; const float* in_w2 = ka_->in[15]; const float* in_fng = ka_->in[16]; \
    float* xlat = ka_->out; float* xctx = (float*)(ws + WS_CTXRES); \
    float* MOD = (float*)(ws + WS_MOD); float* DEC = (float*)(ws + WS_DEC); \
    u16* XNY = (u16*)(ws + WS_XNY); u16* P = (u16*)(ws + WS_P); u16* QB = (u16*)(ws + WS_QB); u16* KB = (u16*)(ws + WS_KB); u16* VB = (u16*)(ws + WS_VB); \
    float* GT = (float*)(ws + WS_G); float* AS = (float*)(ws + WS_AS); u16* HB = (u16*)(ws + WS_H); \
    (void)in_x; (void)in_c; (void)in_ctx; (void)in_cctx; (void)in_modw; (void)in_modb; (void)in_ang; (void)in_mng; (void)in_win; (void)in_wout; (void)in_retl; (void)in_ggw; (void)in_ggb; (void)in_qkg; (void)in_w1; (void)in_w2; (void)in_fng; \
    (void)xlat; (void)xctx; (void)MOD; (void)DEC; (void)XNY; (void)P; (void)QB; (void)KB; (void)VB; (void)GT; (void)AS; (void)HB;
    volatile LAS unsigned* MISC = (volatile LAS unsigned*)(L + LDS_BYTES - 256);
    if (threadIdx.x < 16) MISC[threadIdx.x] = 0u;
    __syncthreads();
    XcdBarrier bar = xcd_barrier_post((unsigned*)(args.ws + WS_BAR), MISC + 8);
    for (int rep_ = 0; rep_ < REP_PRO; ++rep_) {
    PHASE_IDS
    PHASE_PTRS
    if (bx < 192) {
        LAS float* sl = (LAS float*)L;
        for (int i = tid; i < 3072; i += 512) { const int cond = i >> 10, k = i & 1023; const float cv = cond < 2 ? in_c[cond * 1024 + k] : in_cctx[k]; sl[i] = cv / (1.f + expf(-cv)); }
        __syncthreads();
        const int layer = bx / 96, cn = tid & 63, col = (bx % 96) * 64 + cn, kg = tid >> 6;
        const float* wp = in_modw + (size_t)layer * 1024 * 6144 + (size_t)(kg * 128) * 6144 + col;
        float a0 = 0.f, a1 = 0.f, a2 = 0.f;
#pragma unroll 16
        for (int q = 0; q < 128; ++q) { const float w = wp[(size_t)q * 6144]; const int k = kg * 128 + q; a0 += sl[k] * w; a1 += sl[1024 + k] * w; a2 += sl[2048 + k] * w; }
        LAS float* red = sl + 3072;
        red[(kg * 3 + 0) * 64 + cn] = a0; red[(kg * 3 + 1) * 64 + cn] = a1; red[(kg * 3 + 2) * 64 + cn] = a2;
        __syncthreads();
        if (tid < 192) { const int cond = tid >> 6, c2 = tid & 63; float s = 0.f;
#pragma unroll
            for (int g = 0; g < 8; ++g) s += red[(g * 3 + cond) * 64 + c2];
            const int cc = (bx % 96) * 64 + c2; MOD[(size_t)(layer * 3 + cond) * 6144 + cc] = s + in_modb[layer * 6144 + cc]; }
        __syncthreads();
    }
    for (int i = bx * 512 + tid; i < 4096; i += G_ * 512) {
        const int pos = i >> 4, j = i & 15; const float invf = exp2f(-(float)j * 0.8304820237218406f); float sn, cs; sincosf((float)pos * invf, &sn, &cs);
        ((f32x2*)(ws + WS_TAB))[i] = (f32x2){cs, sn}; }
    {
        LAS float* scr = (LAS float*)(L + wave * 16384);
        for (int it = gw; it < 11552; it += NGW) {
            const int l = it / 5776; int r = it % 5776; unsigned char* wl = ws + WS_W + (size_t)l * W_LAYER;
            if (r < 1168) { const int nb = r % 73; if (nb != 48) p0_transpose_item(in_win + (size_t)l * 1024 * IN_W, 1024, IN_W, (u16*)(wl + W_IN), scr, r, lane, nb > 48 ? -32 : 0); continue; } r -= 1168;
            if (r < 512) { p0_transpose_item(in_wout + (size_t)l * 1024 * 1024, 1024, 1024, (u16*)(wl + W_OUT), scr, r, lane); continue; } r -= 512;
            if (r < 2048) { p0_transpose_item(in_w1 + (size_t)l * 1024 * 4096, 1024, 4096, (u16*)(wl + W_1), scr, r, lane); continue; } r -= 2048;
            p0_transpose_item(in_w2 + (size_t)l * 4096 * 1024, 4096, 1024, (u16*)(wl + W_2), scr, r, lane);
        }
        for (int idx = bx * 512 + tid; idx < 2 * 256 * 128; idx += G_ * 512) {
            const int l = idx >> 15, rem = idx & 32767, n = rem >> 7, k0 = (rem & 127) * 8, dirn = n >> 7, np = n & 127;
            const float* gwp = in_ggw + (size_t)l * 4096 + dirn * 2048 + np; const float* wp = in_win + (size_t)l * 1024 * IN_W + (size_t)k0 * IN_W + SRC_GA + dirn * 16;
            float o[8];
#pragma unroll
            for (int q = 0; q < 8; ++q) { float s = 0.f;
#pragma unroll
                for (int i = 0; i < 16; ++i) s += wp[(size_t)q * IN_W + i] * gwp[i * 128];
                o[q] = s; }
            u32x4 w; w.x = pk2(o[0], o[1]); w.y = pk2(o[2], o[3]); w.z = pk2(o[4], o[5]); w.w = pk2(o[6], o[7]);
            *(u32x4*)((u16*)(ws + WS_W + (size_t)l * W_LAYER + W_IN) + (size_t)(C_Z + n) * 1024 + k0) = w; }
    }
    __syncthreads();
    }
    if (args.ws == nullptr) grid.sync();
    xcd_barrier(bar);

    for (int step = 0; step < 20; ++step) {
        const int layer = step / 10, ph = step % 10;
        PHASE_IDS
        PHASE_PTRS
        unsigned char* wl = ws + WS_W + (size_t)layer * W_LAYER;
        const float* modl = MOD + (size_t)layer * 3 * 6144;
        if (ph == 0 || ph == 7) {
            for (int rep_ = 0; rep_ < REP_NORM; ++rep_) {

            const bool from_in = (layer == 0) || (ph == 0);
            const float* sl_ = from_in ? in_x : xlat; const float* sc_ = from_in ? in_ctx : xctx;
            const u16* ya = (layer == 0 && ph == 0) ? nullptr : (const u16*)(ws + WS_YA);
            const u16* yb = (layer == 1 && ph == 0) ? XNY : nullptr;
            const bool wx = (layer == 1 && ph == 0);
            const float* gvec = (ph == 0 ? in_ang : in_mng) + layer * 1024;
            const int sh_off = (ph == 0) ? 0 : 3072, sc_off = sh_off + 1024;
            const int Mn = (layer == 1 && ph == 7) ? M_LAT : M_ALL;
            for (int m = gw; m < Mn; m += NGW) {
                const float* src = (m < M_LAT) ? sl_ + (size_t)m * 1024 : sc_ + (size_t)(m - M_LAT) * 1024;
                const int cond = (m < M_LAT) ? (m >> 14) : 2;
                f32x4 v[4]; float ss = 0.f;
#pragma unroll
                for (int j = 0; j < 4; ++j) v[j] = *(const f32x4*)(src + 4 * lane + 256 * j);
                if (ya) {
#pragma unroll
                    for (int j = 0; j < 4; ++j) { const u32x2 y = *(const u32x2*)(ya + (size_t)m * 1024 + 4 * lane + 256 * j); v[j] = v[j] + (f32x4){bflo(y.x), bfhi(y.x), bflo(y.y), bfhi(y.y)}; } }
                if (yb) {
#pragma unroll
                    for (int j = 0; j < 4; ++j) { const u32x2 y = *(const u32x2*)(yb + (size_t)m * 1024 + 4 * lane + 256 * j); v[j] = v[j] + (f32x4){bflo(y.x), bfhi(y.x), bflo(y.y), bfhi(y.y)}; } }
#pragma unroll
                for (int j = 0; j < 4; ++j) ss += (v[j].x * v[j].x + v[j].y * v[j].y) + (v[j].z * v[j].z + v[j].w * v[j].w);
                if (wx) { float* dst = (m < M_LAT) ? xlat + (size_t)m * 1024 : xctx + (size_t)(m - M_LAT) * 1024;
#pragma unroll
                    for (int j = 0; j < 4; ++j) *(f32x4*)(dst + 4 * lane + 256 * j) = v[j]; }
                const float rstd = 1.0f / sqrtf(wave_sum(ss) * (1.f / 1024.f) + NEPS);
                const float* mc = modl + cond * 6144;
#pragma unroll
                for (int j = 0; j < 4; ++j) { const int col = 4 * lane + 256 * j;
                    const f32x4 gv = *(const f32x4*)(gvec + col), sc = *(const f32x4*)(mc + sc_off + col), sh = *(const f32x4*)(mc + sh_off + col);
                    const f32x4 hv = (v[j] * rstd) * gv * (sc + 1.0f) + sh;
                    u32x2 o; o.x = pk2(hv.x, hv.y); o.y = pk2(hv.z, hv.w); *(u32x2*)(XNY + (size_t)m * 1024 + col) = o; }
            }
            __syncthreads(); }
        } else if (ph == 1 || ph == 8 || ph == 6 || ph == 9) {
            for (int rep_ = 0; rep_ < REP_G1; ++rep_) {

            const u16* Aop = (ph == 9) ? HB : XNY; const int Kop = (ph == 9) ? FF_ : 1024;
            const u16* Bop = (const u16*)(wl + (ph == 1 ? W_IN : ph == 8 ? W_1 : ph == 6 ? W_OUT : W_2));
            const int Nmain = (ph == 1) ? NPAD : (ph == 8 ? FF_ : 1024), Nctx = Nmain;
            u16* Oop = (ph == 1) ? P : (ph == 8 ? HB : (ph == 6 ? (u16*)(ws + WS_YA) : XNY));
            const float* gate = (ph == 6) ? modl + 2048 : (ph == 9 ? modl + 5120 : (const float*)nullptr);
            if (ph == 1 || layer == 0) {
                if (gate) mini_gemm_ctx<1>(Aop + (size_t)M_LAT * Kop, Bop, Nctx, Kop, Oop + (size_t)M_LAT * Nmain, Nmain, 0, gate + 2 * 6144, L, vcu, G_, wave, lane);
                else mini_gemm_ctx<0>(Aop + (size_t)M_LAT * Kop, Bop, Nctx, Kop, Oop + (size_t)M_LAT * Nmain, Nmain, ph == 8 ? 1 : 0, nullptr, L, vcu, G_, wave, lane);
            }
            pg8::Gemm g{Aop, Bop, M_LAT, Nmain, Kop};
            pg8::StaticOrder S; S.init(g.M, g.N, G_, bx);
            pg8::EpiStoreBf16 E{Oop, Nmain, ph == 8 ? 1 : 0, gate};
            pg8::gemm_phase<pg8::EpiStoreBf16, pg8::StaticOrder, true, true>(L, g, S, E);
            __syncthreads(); }
        } else if (ph == 2) {
            LAS float* gw_s = (LAS float*)L; LAS float* gb_s = gw_s + 4096; LAS float* qg_s = gb_s + 256;
            if (tid < 256) gb_s[tid] = in_ggb[layer * 256 + tid];
            if (tid < 128) qg_s[tid] = in_qkg[layer * 128 + tid];
            __syncthreads();
            const float C2 = 0.125f * 1.4426950408889634f, KSC = 0.17677669529663687f;
            const f32x2* TAB = (const f32x2*)(ws + WS_TAB);
            const int r_head = lane >> 4, r_pi = lane & 15, r_j = r_pi & 7; const bool r_isrow = r_pi < 8; const int r_da = r_isrow ? r_j : 16 + r_j, r_db = r_da + 8;
            const int a_sub = lane & 7, a_hh = lane >> 3; const bool a_isrow = a_sub < 4; const int a_jb = a_isrow ? 4 * a_sub : 4 * a_sub - 16, a_da = a_isrow ? 4 * a_sub : 4 * a_sub + 16, a_db = a_da + 16;
            struct PostRaw { unsigned rq0, rq1, rk0, rk1; u32x2 gz; u32x2 aq0, aq1, ak0, ak1; u32x4 av; f32x2 t2; f32x4 t0, t1; };
#define POST_LOAD(R, mm) do { const u16* rp_ = P + (size_t)(mm) * NPAD; const int t_ = (mm) & 16383; const bool lat_ = (mm) < M_LAT; \
                R.rq0 = rp_[C_RQ + r_head * 32 + r_da]; R.rq1 = rp_[C_RQ + r_head * 32 + r_db]; R.rk0 = rp_[C_RK + r_head * 32 + r_da]; R.rk1 = rp_[C_RK + r_head * 32 + r_db]; \
                R.gz = *(const u32x2*)(rp_ + C_Z + 4 * lane); \
                R.aq0 = (u32x2){0u, 0u}; R.aq1 = (u32x2){0u, 0u}; \
                R.ak0 = *(const u32x2*)(rp_ + C_AK + (a_hh & 1) * 64 + a_da); R.ak1 = *(const u32x2*)(rp_ + C_AK + (a_hh & 1) * 64 + a_db); \
                R.av = *(const u32x4*)(rp_ + C_AV + (lane & 15) * 8); \
                R.t2 = (f32x2){1.f, 0.f}; R.t0 = (f32x4){1.f, 0.f, 1.f, 0.f}; R.t1 = (f32x4){1.f, 0.f, 1.f, 0.f}; \
                if (lat_) { R.t2 = TAB[(r_isrow ? (t_ >> 6) : (t_ & 63)) * 16 + 2 * r_j]; const f32x4* tp_ = (const f32x4*)(TAB + (a_isrow ? (t_ >> 6) : (t_ & 63)) * 16 + a_jb); R.t0 = tp_[0]; R.t1 = tp_[1]; } } while (0)
            PostRaw cur{};
            POST_LOAD(cur, gw);
            for (int m = gw; m < M_ALL; m += NGW) {
                PostRaw nxt = cur; const int mn = m + NGW;
                if (mn < M_ALL) POST_LOAD(nxt, mn);
                u16* rowp = P + (size_t)m * NPAD;
                const int kvb = m < M_LAT ? (m >> 14) : ((m - M_LAT) >> 8), kvt = m < M_LAT ? ((m & 16383) >> 6) : 256 + (((m - M_LAT) & 255) >> 6), kvr = m & 63;
                const size_t kvbase = ((size_t)(kvb * 2) * 260 + kvt) * 4096;
                {   const float cs = cur.t2.x, sn = cur.t2.y;
                    const float qa = bf2f(cur.rq0), qb_ = bf2f(cur.rq1), ka = bf2f(cur.rk0), kb_ = bf2f(cur.rk1);
                    const unsigned qo = pk2(qa * cs - qb_ * sn, qa * sn + qb_ * cs), ko = pk2((ka * cs - kb_ * sn) * KSC, (ka * sn + kb_ * cs) * KSC);
                    u16* qs = rowp + C_RQ + r_head * 32; u16* ks_ = rowp + C_RK + r_head * 32;
                    qs[r_da] = (u16)(qo & 0xffffu); qs[r_db] = (u16)(qo >> 16); ks_[r_da] = (u16)(ko & 0xffffu); ks_[r_db] = (u16)(ko >> 16);
                }
                {   const f32x4 bv = *(const LAS f32x4*)(gb_s + 4 * lane);
                    f32x4 g; g.x = logsig(bflo(cur.gz.x) + bv.x) * (1.f / 16.f); g.y = logsig(bfhi(cur.gz.x) + bv.y) * (1.f / 16.f); g.z = logsig(bflo(cur.gz.y) + bv.z) * (1.f / 16.f); g.w = logsig(bfhi(cur.gz.y) + bv.w) * (1.f / 16.f);
                    *(f32x4*)(GT + (size_t)m * 256 + 4 * lane) = g; }
                {   const float cs[4] = {cur.t0.x, cur.t0.z, cur.t1.x, cur.t1.z}, sn[4] = {cur.t0.y, cur.t0.w, cur.t1.y, cur.t1.w};
#pragma unroll
                    for (int pass = 1; pass < 2; ++pass) {
                        const int hd = pass == 0 ? a_hh : (a_hh & 1);
                        const u32x2 wa = pass == 0 ? cur.aq0 : cur.ak0, wb = pass == 0 ? cur.aq1 : cur.ak1;
                        float xa[4] = {bflo(wa.x), bfhi(wa.x), bflo(wa.y), bfhi(wa.y)}, xb[4] = {bflo(wb.x), bfhi(wb.x), bflo(wb.y), bfhi(wb.y)};
                        float ss = 0.f;
#pragma unroll
                        for (int e = 0; e < 4; ++e) ss += xa[e] * xa[e] + xb[e] * xb[e];
                        ss += xor_lane<1>(ss); ss += xor_lane<2>(ss); ss += xor_lane<4>(ss);
                        const float rstd = rsqrtf(ss * (1.f / 64.f) + NEPS); const float osc = pass == 0 ? C2 : 1.f;
                        float oa[4], ob[4];
#pragma unroll
                        for (int e = 0; e < 4; ++e) { const float ya = xa[e] * rstd * qg_s[pass * 64 + a_da + e], yb = xb[e] * rstd * qg_s[pass * 64 + a_db + e];
                            oa[e] = (ya * cs[e] - yb * sn[e]) * osc; ob[e] = (ya * sn[e] + yb * cs[e]) * osc; }
                        u32x2 pa, pb; pa.x = pk2(oa[0], oa[1]); pa.y = pk2(oa[2], oa[3]); pb.x = pk2(ob[0], ob[1]); pb.y = pk2(ob[2], ob[3]);
                        if (pass == 0) { u16* dp = QB + (size_t)m * 512 + hd * 64; *(u32x2*)(dp + a_da) = pa; *(u32x2*)(dp + a_db) = pb; }
                        else if (lane < 16) { u16* dp = KB + kvbase + (size_t)hd * (260 * 4096) + kvr * 8;
                            *(u32x2*)(dp + (a_da >> 3) * 512 + (a_da & 7)) = pa; *(u32x2*)(dp + (a_db >> 3) * 512 + (a_db & 7)) = pb; }
                    }
                    if (lane < 16) { const int cc = (lane & 7) * 8, vw_ = (cc >> 5) * 4 + (kvr >> 4), vl_ = (kvr & 15) * 4 + ((cc & 31) >> 3);
                        *(u32x4*)(VB + kvbase + (size_t)(lane >> 3) * (260 * 4096) + (vw_ * 64 + vl_) * 8) = cur.av; }
                }
                cur = nxt;
            }
#undef POST_LOAD
        } else if (ph == 3) {
            for (int rep_ = 0; rep_ < REP_S1; ++rep_) {

            LAS unsigned char* Lw = L + wave * 18048;
            LAS float* Bc = (LAS float*)Lw; LAS u16* KT = (LAS u16*)Lw;
            LAS u16* VT = (LAS u16*)(Lw + 8704); LAS float* tot = (LAS float*)(Lw + 8704 + 9216);
            const int nn = lane & 15, kk = lane >> 4;
            for (int item = gw; item < N_ITEM1; item += NGW) {
                const int cidx = item % 260, t = item / 260, h = t & 3, b = (t >> 2) & 1, dir = (t >> 3) & 1, grp = t >> 4;
                const int row0 = cidx < 4 ? M_LAT + b * 256 + cidx * 64 : b * 16384 + (cidx - 4) * 64;
                const u16* Pr = P + (size_t)(row0 + lane) * NPAD;
                const int kcol = (grp ? C_GK : C_RK) + h * 32, vcol = (grp ? C_GV : C_RV) + h * 64;
                u32x4 kr[4], vr[8];
                {   const u16* Pk = P + (size_t)(row0 + (lane >> 2)) * NPAD + kcol + 8 * (lane & 3);
#pragma unroll
                    for (int q = 0; q < 4; ++q) kr[q] = *(const u32x4*)(Pk + (size_t)(16 * q) * NPAD); }
                {   const u16* Pv = P + (size_t)(row0 + (lane >> 3)) * NPAD + vcol + 8 * (lane & 7);
#pragma unroll
                    for (int q = 0; q < 8; ++q) vr[q] = *(const u32x4*)(Pv + (size_t)(8 * q) * NPAD); }
                float lg = 0.f;
                if (grp == 0) lg = logsig(in_retl[layer * 8 + dir * 4 + h]);
                else {
                    const int d = lane & 31, half = lane >> 5; float* gp = GT + (size_t)row0 * 256 + dir * 128 + h * 32 + d; float run = 0.f;
                    float gv[32];
#pragma unroll
                    for (int i = 0; i < 32; ++i) gv[i] = gp[(size_t)(32 * half + i) * 256];
                    if (dir == 0) {
#pragma unroll
                        for (int i = 0; i < 32; ++i) { run += gv[i]; gv[i] = run; }
                    } else {
#pragma unroll
                        for (int i = 31; i >= 0; --i) { run += gv[i]; gv[i] = run; }
                    }
                    const float other = other_half(run);
                    const float addv = (dir == 0) ? (half == 1 ? other : 0.f) : (half == 0 ? other : 0.f);
#pragma unroll
                    for (int i = 0; i < 32; ++i) { const float full = gv[i] + addv; Bc[(32 * half + i) * 34 + d] = full; gp[(size_t)(32 * half + i) * 256] = full; }
                    if (half == 0) tot[d] = run + other;
                    LDS_WAIT(); asm volatile("" ::: "memory");
                }
                float fv[4][8];
                if (grp == 0) {
#pragma unroll
                    for (int q = 0; q < 4; ++q) { const int r = 16 * q + (lane >> 2); const float f = __expf((dir == 0 ? (float)(63 - r) : (float)r) * lg);
#pragma unroll
                        for (int e = 0; e < 8; ++e) fv[q][e] = f; }
                } else {
                    const f32x4 t0_ = *(const LAS f32x4*)(tot + 8 * (lane & 3)), t1_ = *(const LAS f32x4*)(tot + 8 * (lane & 3) + 4);
                    const float tt[8] = {t0_.x, t0_.y, t0_.z, t0_.w, t1_.x, t1_.y, t1_.z, t1_.w};
#pragma unroll
                    for (int q = 0; q < 4; ++q) { const LAS float* bp = Bc + (16 * q + (lane >> 2)) * 34 + 8 * (lane & 3);
#pragma unroll
                        for (int e = 0; e < 8; e += 2) { const f32x2 bc = *(const LAS f32x2*)(bp + e); fv[q][e] = __expf(tt[e] - bc.x); fv[q][e + 1] = __expf(tt[e + 1] - bc.y); } }
                    LDS_WAIT(); asm volatile("" ::: "memory");
                }
#pragma unroll
                for (int q = 0; q < 4; ++q) { const unsigned w[4] = {kr[q].x, kr[q].y, kr[q].z, kr[q].w}; u32x2 o0, o1;
                    o0.x = pk2(bflo(w[0]) * fv[q][0], bfhi(w[0]) * fv[q][1]); o0.y = pk2(bflo(w[1]) * fv[q][2], bfhi(w[1]) * fv[q][3]);
                    o1.x = pk2(bflo(w[2]) * fv[q][4], bfhi(w[2]) * fv[q][5]); o1.y = pk2(bflo(w[3]) * fv[q][6], bfhi(w[3]) * fv[q][7]);
                    LAS u32x2* wp = (LAS u32x2*)(KT + (16 * q + (lane >> 2)) * 36 + 8 * (lane & 3)); wp[0] = o0; wp[1] = o1; }
#pragma unroll
                for (int q = 0; q < 8; ++q) { LAS u32x2* wp = (LAS u32x2*)(VT + (8 * q + (lane >> 3)) * 68 + 8 * (lane & 7));
                    wp[0] = (u32x2){vr[q].x, vr[q].y}; wp[1] = (u32x2){vr[q].z, vr[q].w}; }
                LDS_WAIT(); asm volatile("" ::: "memory");
                f32x4 acc[4][2];
#pragma unroll
                for (int a = 0; a < 4; ++a) { acc[a][0] = (f32x4){0.f, 0.f, 0.f, 0.f}; acc[a][1] = (f32x4){0.f, 0.f, 0.f, 0.f}; }
#pragma unroll
                for (int ks = 0; ks < 2; ++ks) {
                    typedef short trk4_t __attribute__((ext_vector_type(4)));
                    const LAS u16* bp_ = KT + (32 * ks + 8 * kk + (nn >> 2)) * 36 + 4 * (nn & 3);
                    const trk4_t l0_ = __builtin_amdgcn_ds_read_tr16_b64_v4i16((LAS trk4_t*)bp_), h0_ = __builtin_amdgcn_ds_read_tr16_b64_v4i16((LAS trk4_t*)(bp_ + 4 * 36));
                    const trk4_t l1_ = __builtin_amdgcn_ds_read_tr16_b64_v4i16((LAS trk4_t*)(bp_ + 16)), h1_ = __builtin_amdgcn_ds_read_tr16_b64_v4i16((LAS trk4_t*)(bp_ + 16 + 4 * 36));
                    const mbf16x8 b0 = (mbf16x8){l0_[0], l0_[1], l0_[2], l0_[3], h0_[0], h0_[1], h0_[2], h0_[3]}, b1 = (mbf16x8){l1_[0], l1_[1], l1_[2], l1_[3], h1_[0], h1_[1], h1_[2], h1_[3]};
#pragma unroll
                    for (int mt = 0; mt < 4; ++mt) {
                        typedef short tr4_t __attribute__((ext_vector_type(4)));
                        const LAS u16* ap_ = VT + (32 * ks + 8 * kk + (nn >> 2)) * 68 + 16 * mt + 4 * (nn & 3);
                        const tr4_t lo_ = __builtin_amdgcn_ds_read_tr16_b64_v4i16((LAS tr4_t*)ap_), hi_ = __builtin_amdgcn_ds_read_tr16_b64_v4i16((LAS tr4_t*)(ap_ + 4 * 68));
                        const mbf16x8 a = (mbf16x8){lo_[0], lo_[1], lo_[2], lo_[3], hi_[0], hi_[1], hi_[2], hi_[3]};
                        acc[mt][0] = __builtin_amdgcn_mfma_f32_16x16x32_bf16(a, b0, acc[mt][0], 0, 0, 0); acc[mt][1] = __builtin_amdgcn_mfma_f32_16x16x32_bf16(a, b1, acc[mt][1], 0, 0, 0); }
                }
                float* o = AS + (size_t)item * 2048;
#pragma unroll
                for (int mt = 0; mt < 4; ++mt)
#pragma unroll
                    for (int nt = 0; nt < 2; ++nt)
#pragma unroll
                        for (int r = 0; r < 4; ++r) o[(16 * mt + 4 * kk + r) * 32 + 16 * nt + nn] = acc[mt][nt][r];
                if (lane < 32) DEC[(size_t)item * 32 + lane] = grp == 0 ? __expf(64.f * lg) : __expf(tot[lane]);
                LDS_WAIT(); asm volatile("" ::: "memory");
            }
            __syncthreads(); }
        } else if (ph == 4) {
            const int gt_ = bx * 512 + tid;
            for (int rep_ = 0; rep_ < REP_S2; ++rep_)
            if (gt_ < 32 * 2048) {
                const int seq = gt_ >> 11, elem = gt_ & 2047, d = elem & 31, dir = (seq >> 3) & 1;
                float* base = AS + (size_t)seq * 260 * 2048 + elem; const float* dbase = DEC + (size_t)seq * 260 * 32 + d;
                float S = 0.f;
                for (int n0 = 0; n0 < 260; n0 += 52) {
                    float a[52], dc[52];
#pragma unroll
                    for (int q = 0; q < 52; ++q) { const int n = n0 + q; const int ci = dir == 0 ? n : (n < 4 ? 3 - n : 263 - n); a[q] = base[(size_t)ci * 2048]; dc[q] = dbase[(size_t)ci * 32]; }
#pragma unroll
                    for (int q = 0; q < 52; ++q) { const int n = n0 + q; const int ci = dir == 0 ? n : (n < 4 ? 3 - n : 263 - n); (rep_ + 1 < REP_S2 ? base + 17039360 : base)[(size_t)ci * 2048] = S; S = dc[q] * S + a[q]; }
                }
            }
        } else if (ph == 5) {
            for (int rep_ = 0; rep_ < REP_S3; ++rep_) {
                const int slot = wave >> 2, w4 = wave & 3, t4 = tid & 255;
                LAS u16* KFs = (LAS u16*)(L + slot * 32768); LAS u16* KBs = KFs + 64 * 40; LAS u16* VT = KBs + 64 * 40; LAS u16* ST = VT + 64 * 72;
                const int nn = lane & 15, kk = lane >> 4;
                for (int pr = bx; pr < N_ITEM3 / 2; pr += G_) {
                    const int item = pr * 2 + slot;
                    const int cidx = item % 260, t = item / 260, h = t & 3, b = (t >> 2) & 1, grp = t >> 3;
                    const int row0 = cidx < 4 ? M_LAT + b * 256 + cidx * 64 : b * 16384 + (cidx - 4) * 64;
                    const u16* Pr = P + (size_t)row0 * NPAD;
                    const int qcol = (grp ? C_GQ : C_RQ) + h * 32, kcol = (grp ? C_GK : C_RK) + h * 32, vcol = (grp ? C_GV : C_RV) + h * 64, gcol = (grp ? C_GG : C_RG) + h * 64;
                    const size_t itF = (size_t)((((grp * 2 + 0) * 2 + b) * 4 + h) * 260 + cidx), itB = (size_t)((((grp * 2 + 1) * 2 + b) * 4 + h) * 260 + cidx);
                    const float lgf = logsig(in_retl[layer * 8 + h]), lgb = logsig(in_retl[layer * 8 + 4 + h]);
                    const int jr = t4 >> 2, d0 = (t4 & 3) * 8, iq = 16 * w4 + nn;
                    const u32x4 qw = *(const u32x4*)(Pr + (size_t)iq * NPAD + qcol + 8 * kk);
                    const u32x4 kw = *(const u32x4*)(Pr + (size_t)jr * NPAD + kcol + d0);
                    const u32x4 va = *(const u32x4*)(Pr + (size_t)jr * NPAD + vcol + (t4 & 3) * 16), vb = *(const u32x4*)(Pr + (size_t)jr * NPAD + vcol + (t4 & 3) * 16 + 8);
                    const f32x4 sf0 = *(const f32x4*)(AS + itF * 2048 + t4 * 8), sf1 = *(const f32x4*)(AS + itF * 2048 + t4 * 8 + 4);
                    const f32x4 sb0 = *(const f32x4*)(AS + itB * 2048 + t4 * 8), sb1 = *(const f32x4*)(AS + itB * 2048 + t4 * 8 + 4);
                    u16 graw[4][4];
#pragma unroll
                    for (int r = 0; r < 4; ++r)
#pragma unroll
                        for (int et = 0; et < 4; ++et) graw[r][et] = Pr[(size_t)(16 * w4 + 4 * kk + r) * NPAD + gcol + nn + 16 * et];
                    f32x4 bq[4], bk[4];
#pragma unroll
                    for (int s = 0; s < 4; ++s) { bq[s] = (f32x4){0.f, 0.f, 0.f, 0.f}; bk[s] = (f32x4){0.f, 0.f, 0.f, 0.f}; }
                    if (grp == 1) { const float* gq = GT + (size_t)(row0 + iq) * 256 + h * 32 + 8 * kk; const float* gk = GT + (size_t)(row0 + jr) * 256 + h * 32 + d0;
                        bq[0] = *(const f32x4*)gq; bq[1] = *(const f32x4*)(gq + 4); bq[2] = *(const f32x4*)(gq + 128); bq[3] = *(const f32x4*)(gq + 132);
                        bk[0] = *(const f32x4*)gk; bk[1] = *(const f32x4*)(gk + 4); bk[2] = *(const f32x4*)(gk + 128); bk[3] = *(const f32x4*)(gk + 132); }
                    else { const float ef = (float)(iq + 1) * lgf, eb = (float)(64 - iq) * lgb, kf = (float)(jr + 1) * lgf, kb = (float)(64 - jr) * lgb;
                        bq[0] = bq[1] = (f32x4){ef, ef, ef, ef}; bq[2] = bq[3] = (f32x4){eb, eb, eb, eb}; bk[0] = bk[1] = (f32x4){kf, kf, kf, kf}; bk[2] = bk[3] = (f32x4){kb, kb, kb, kb}; }
                    mbf16x8 qfr_f, qfr_b;
                    {   const float qs = grp ? 0.17677669529663687f : 1.f;
                        const float qx[8] = {bflo(qw.x) * qs, bfhi(qw.x) * qs, bflo(qw.y) * qs, bfhi(qw.y) * qs, bflo(qw.z) * qs, bfhi(qw.z) * qs, bflo(qw.w) * qs, bfhi(qw.w) * qs};
                        u32x4 pf, pb;
                        pf.x = pk2(qx[0] * __expf(bq[0].x), qx[1] * __expf(bq[0].y)); pf.y = pk2(qx[2] * __expf(bq[0].z), qx[3] * __expf(bq[0].w));
                        pf.z = pk2(qx[4] * __expf(bq[1].x), qx[5] * __expf(bq[1].y)); pf.w = pk2(qx[6] * __expf(bq[1].z), qx[7] * __expf(bq[1].w));
                        pb.x = pk2(qx[0] * __expf(bq[2].x), qx[1] * __expf(bq[2].y)); pb.y = pk2(qx[2] * __expf(bq[2].z), qx[3] * __expf(bq[2].w));
                        pb.z = pk2(qx[4] * __expf(bq[3].x), qx[5] * __expf(bq[3].y)); pb.w = pk2(qx[6] * __expf(bq[3].z), qx[7] * __expf(bq[3].w));
                        qfr_f = __builtin_bit_cast(mbf16x8, pf); qfr_b = __builtin_bit_cast(mbf16x8, pb); }
                    {   const float kx[8] = {bflo(kw.x), bfhi(kw.x), bflo(kw.y), bfhi(kw.y), bflo(kw.z), bfhi(kw.z), bflo(kw.w), bfhi(kw.w)};
                        u32x4 pf, pb;
                        pf.x = pk2(kx[0] * __expf(-bk[0].x), kx[1] * __expf(-bk[0].y)); pf.y = pk2(kx[2] * __expf(-bk[0].z), kx[3] * __expf(-bk[0].w));
                        pf.z = pk2(kx[4] * __expf(-bk[1].x), kx[5] * __expf(-bk[1].y)); pf.w = pk2(kx[6] * __expf(-bk[1].z), kx[7] * __expf(-bk[1].w));
                        pb.x = pk2(kx[0] * __expf(-bk[2].x), kx[1] * __expf(-bk[2].y)); pb.y = pk2(kx[2] * __expf(-bk[2].z), kx[3] * __expf(-bk[2].w));
                        pb.z = pk2(kx[4] * __expf(-bk[3].x), kx[5] * __expf(-bk[3].y)); pb.w = pk2(kx[6] * __expf(-bk[3].z), kx[7] * __expf(-bk[3].w));
                        *(LAS u32x4*)(KFs + jr * 40 + d0) = pf; *(LAS u32x4*)(KBs + jr * 40 + d0) = pb;
                        u32x4 s0, s1; s0.x = pk2(sf0.x, sf0.y); s0.y = pk2(sf0.z, sf0.w); s0.z = pk2(sf1.x, sf1.y); s0.w = pk2(sf1.z, sf1.w);
                        s1.x = pk2(sb0.x, sb0.y); s1.y = pk2(sb0.z, sb0.w); s1.z = pk2(sb1.x, sb1.y); s1.w = pk2(sb1.z, sb1.w);
                        *(LAS u32x4*)(ST + jr * 72 + d0) = s0; *(LAS u32x4*)(ST + jr * 72 + 32 + d0) = s1;
                        {   LAS u32x2* wp = (LAS u32x2*)(VT + jr * 68 + (t4 & 3) * 16);
                            wp[0] = (u32x2){va.x, va.y}; wp[1] = (u32x2){va.z, va.w}; wp[2] = (u32x2){vb.x, vb.y}; wp[3] = (u32x2){vb.z, vb.w}; } }
                    __syncthreads();
                    const f32x4 z4 = (f32x4){0.f, 0.f, 0.f, 0.f};
                    f32x4 sc[4];
#pragma unroll
                    for (int jt = 0; jt < 4; ++jt) {
                        const mbf16x8 kf_ = *(const LAS mbf16x8*)(KFs + (16 * jt + nn) * 40 + 8 * kk), kb_ = *(const LAS mbf16x8*)(KBs + (16 * jt + nn) * 40 + 8 * kk);
                        if (jt < w4) sc[jt] = __builtin_amdgcn_mfma_f32_16x16x32_bf16(kf_, qfr_f, z4, 0, 0, 0);
                        else if (jt > w4) sc[jt] = __builtin_amdgcn_mfma_f32_16x16x32_bf16(kb_, qfr_b, z4, 0, 0, 0);
                        else { const f32x4 a = __builtin_amdgcn_mfma_f32_16x16x32_bf16(kf_, qfr_f, z4, 0, 0, 0), c = __builtin_amdgcn_mfma_f32_16x16x32_bf16(kb_, qfr_b, z4, 0, 0, 0);
#pragma unroll
                            for (int r = 0; r < 4; ++r) sc[jt][r] = (4 * kk + r <= nn) ? a[r] : c[r]; }
                    }
                    f32x4 O[4];
#pragma unroll
                    for (int et = 0; et < 4; ++et) O[et] = z4;
#pragma unroll
                    for (int p2 = 0; p2 < 2; ++p2) {
                        u32x4 pa; pa.x = pk2(sc[2 * p2][0], sc[2 * p2][1]); pa.y = pk2(sc[2 * p2][2], sc[2 * p2][3]); pa.z = pk2(sc[2 * p2 + 1][0], sc[2 * p2 + 1][1]); pa.w = pk2(sc[2 * p2 + 1][2], sc[2 * p2 + 1][3]);
                        const mbf16x8 af = __builtin_bit_cast(mbf16x8, pa);
#pragma unroll
                        for (int et = 0; et < 4; ++et) {
                            typedef short trv4_t __attribute__((ext_vector_type(4)));
                            const LAS u16* vp = VT + (32 * p2 + 4 * kk + (nn >> 2)) * 68 + 16 * et + 4 * (nn & 3);
                            const trv4_t lo = __builtin_amdgcn_ds_read_tr16_b64_v4i16((LAS trv4_t*)vp), hi = __builtin_amdgcn_ds_read_tr16_b64_v4i16((LAS trv4_t*)(vp + 16 * 68));
                            O[et] = __builtin_amdgcn_mfma_f32_16x16x32_bf16(af, (mbf16x8){lo[0], lo[1], lo[2], lo[3], hi[0], hi[1], hi[2], hi[3]}, O[et], 0, 0, 0); }
                    }
#pragma unroll
                    for (int et = 0; et < 4; ++et) { const LAS u16* sp = ST + (16 * et + nn) * 72 + 8 * kk;
                        O[et] = __builtin_amdgcn_mfma_f32_16x16x32_bf16(qfr_f, *(const LAS mbf16x8*)sp, O[et], 0, 0, 0);
                        O[et] = __builtin_amdgcn_mfma_f32_16x16x32_bf16(qfr_b, *(const LAS mbf16x8*)(sp + 32), O[et], 0, 0, 0); }
#pragma unroll
                    for (int r = 0; r < 4; ++r) { const int i = 16 * w4 + 4 * kk + r;
                        float x0 = O[0][r], x1 = O[1][r], x2 = O[2][r], x3 = O[3][r];
                        if (grp == 0) { float sm = (x0 + x1) + (x2 + x3); sm += xor_lane<1>(sm); sm += xor_lane<2>(sm); sm += xor_lane<4>(sm); sm += xor_lane<8>(sm);
                            const float mean = sm * (1.f / 64.f); x0 -= mean; x1 -= mean; x2 -= mean; x3 -= mean; }
                        float sq = (x0 * x0 + x1 * x1) + (x2 * x2 + x3 * x3); sq += xor_lane<1>(sq); sq += xor_lane<2>(sq); sq += xor_lane<4>(sq); sq += xor_lane<8>(sq);
                        const float rs = rsqrtf(sq * (1.f / 64.f) + NEPS);
                        const float xs[4] = {x0 * rs, x1 * rs, x2 * rs, x3 * rs};
                        u16* yp = XNY + (size_t)(row0 + i) * 1024 + grp * 256 + h * 64 + nn;
#pragma unroll
                        for (int et = 0; et < 4; ++et) { const float gate = bf2f(graw[r][et]); const float sg = gate * __builtin_amdgcn_rcpf(1.f + __expf(-gate)); yp[16 * et] = (u16)(pk2(sg * xs[et], 0.f) & 0xffffu); } }
                    __syncthreads();
                }
            }
            if (__builtin_amdgcn_readfirstlane(threadIdx.x) >= 256) __builtin_amdgcn_s_setprio(1);
            for (int rep_ = 0; rep_ < REP_ATT; ++rep_) {
                const int per = (1024 + G_ - 1) / G_;
                float gq_ = fabsf(in_qkg[layer * 128 + lane]), gk_ = fabsf(in_qkg[layer * 128 + 64 + lane]);
                gq_ = fmaxf(gq_, xor_lane<1>(gq_)); gq_ = fmaxf(gq_, xor_lane<2>(gq_)); gq_ = fmaxf(gq_, xor_lane<4>(gq_)); gq_ = fmaxf(gq_, xor_lane<8>(gq_)); gq_ = fmaxf(gq_, xor_lane<16>(gq_)); gq_ = fmaxf(gq_, other_half(gq_));
                gk_ = fmaxf(gk_, xor_lane<1>(gk_)); gk_ = fmaxf(gk_, xor_lane<2>(gk_)); gk_ = fmaxf(gk_, xor_lane<4>(gk_)); gk_ = fmaxf(gk_, xor_lane<8>(gk_)); gk_ = fmaxf(gk_, xor_lane<16>(gk_)); gk_ = fmaxf(gk_, other_half(gk_));
                const bool fixref = __builtin_amdgcn_readfirstlane((8.f * 1.4426950408889634f * 1.05f) * gq_ * gk_ < 40.f ? 1 : 0) != 0;
                for (int i = 0; i <= per; ++i) {
                    const u16 *Qw0 = P, *Kl = KB, *Vl = VB; u16* Ow0 = XNY; int NT = 4, tq0 = 0; bool rope = false;
                    if (i < per) { const int U = vcu * per + i; if (U >= 1024) continue;
                        const int bkv = U >> 8, g = (U >> 6) & 3, qb = U & 63, b = bkv >> 1, kvh = bkv & 1, h = kvh * 4 + g; const size_t qrow0 = (size_t)b * 16384 + (size_t)qb * 256;
                        Qw0 = P + qrow0 * NPAD + C_AQ + h * 64; tq0 = (int)qrow0; rope = true; Kl = KB + (size_t)(b * 2 + kvh) * (260 * 4096); Vl = VB + (size_t)(b * 2 + kvh) * (260 * 4096);
                        Ow0 = XNY + qrow0 * 1024 + 512 + h * 64; NT = 260;
                    } else { if (layer != 0 || vcu >= 16) break;
                        const int b = vcu >> 3, h = vcu & 7, kvh = h >> 2; const size_t qrow0 = (size_t)(M_LAT + b * 256);
                        Qw0 = P + qrow0 * NPAD + C_AQ + h * 64; tq0 = 0; rope = false; Kl = KB + ((size_t)(b * 2 + kvh) * 260 + 256) * 4096; Vl = VB + ((size_t)(b * 2 + kvh) * 260 + 256) * 4096;
                        Ow0 = XNY + qrow0 * 1024 + 512 + h * 64; NT = 4; }
                    const float* gqp = in_qkg + layer * 128; const float* tabp = rope ? (const float*)(ws + WS_TAB) : (const float*)nullptr;
                    if (fixref) attn_body::attn_unit<8, true>(gqp, tabp, tq0, (const attn_body::bf16*)Qw0, (const attn_body::bf16*)Kl, (const attn_body::bf16*)Vl, NT, (attn_body::bf16*)Ow0, (char*)lds);
                    else attn_body::attn_unit<8, false>(gqp, tabp, tq0, (const attn_body::bf16*)Qw0, (const attn_body::bf16*)Kl, (const attn_body::bf16*)Vl, NT, (attn_body::bf16*)Ow0, (char*)lds);
                }
            }
            __builtin_amdgcn_s_setprio(0);
        }
        for (int rep_ = 0; rep_ < REP_SYNC; ++rep_) xcd_barrier(bar);
    }
    PHASE_IDS
    PHASE_PTRS
    for (int m = gw; m < M_LAT; m += NGW) {
        float* src = xlat + (size_t)m * 1024; f32x4 v[4]; float ss = 0.f;
        const u16* ya = (const u16*)(ws + WS_YA) + (size_t)m * 1024; const u16* yb = XNY + (size_t)m * 1024;
#pragma unroll
        for (int j = 0; j < 4; ++j) { v[j] = *(const f32x4*)(src + 4 * lane + 256 * j);
            const u32x2 y = *(const u32x2*)(ya + 4 * lane + 256 * j), z = *(const u32x2*)(yb + 4 * lane + 256 * j);
            v[j] = v[j] + (f32x4){bflo(y.x), bfhi(y.x), bflo(y.y), bfhi(y.y)} + (f32x4){bflo(z.x), bfhi(z.x), bflo(z.y), bfhi(z.y)};
            ss += (v[j].x * v[j].x + v[j].y * v[j].y) + (v[j].z * v[j].z + v[j].w * v[j].w); }
        const float rstd = 1.0f / sqrtf(wave_sum(ss) * (1.f / 1024.f) + NEPS);
#pragma unroll
        for (int j = 0; j < 4; ++j) { const f32x4 gv = *(const f32x4*)(in_fng + 4 * lane + 256 * j); *(f32x4*)(src + 4 * lane + 256 * j) = (v[j] * rstd) * gv; }
    }
}

extern "C" void kernel_launch(void* const* d_in, const int* in_sizes, int n_in, void* d_out, int out_size, void* d_ws, size_t ws_size, hipStream_t stream) {
    static int grid_blocks = 0;
    if (grid_blocks == 0) {
        if (n_in != 17 || ws_size < 512 * MiB) { fprintf(stderr, "kernel_launch: unexpected n_in %d / ws %zu\n", n_in, ws_size); grid_blocks = -1; return; }
        int dev = 0, cus = 0, per_cu = 0;
        hipGetDevice(&dev); hipDeviceGetAttribute(&cus, hipDeviceAttributeMultiprocessorCount, dev);
        if (hipFuncSetAttribute((const void*)fwd_megakernel, hipFuncAttributeMaxDynamicSharedMemorySize, LDS_BYTES) != hipSuccess) { fprintf(stderr, "kernel_launch: hipFuncSetAttribute failed\n"); }
        if (hipOccupancyMaxActiveBlocksPerMultiprocessor(&per_cu, (const void*)fwd_megakernel, 512, LDS_BYTES) != hipSuccess || per_cu < 1) { fprintf(stderr, "kernel_launch: occupancy query gave %d\n", per_cu); per_cu = 1; }
        (void)hipGetLastError();
        if (per_cu > 1) per_cu = 1;
        grid_blocks = cus * per_cu;
    }
    if (grid_blocks < 0) return;
    Args a{};
    for (int i = 0; i < 17; ++i) a.in[i] = (const float*)d_in[i];
    a.out = (float*)d_out; a.ws = (unsigned char*)d_ws;
    if (hipMemsetAsync((char*)d_ws + WS_BAR, 0, WS_BAR_BYTES, stream) != hipSuccess) { fprintf(stderr, "kernel_launch: memset failed\n"); return; }
    void* kargs[] = {&a};
    hipError_t e = hipLaunchCooperativeKernel((const void*)fwd_megakernel, dim3(grid_blocks), dim3(512), kargs, LDS_BYTES, stream);
    if (e != hipSuccess) fprintf(stderr, "cooperative launch failed: %s (grid %d)\n", hipGetErrorString(e), grid_blocks);
}
```
